# Optimizing an MI355X kernel written in HIP

```python
import jax, jax.numpy as jnp
from jax import lax
import numpy as np

D_MODEL = 2048
BATCH = 8
SEQ = 2048
DEPTH = 2

POOL_WINDOWS = (2, 4, 8, 16)
N_POOL_GROUPS = len(POOL_WINDOWS)
POOL_GROUP_WIDTH = D_MODEL // 8
POOL_WIDTH = N_POOL_GROUPS * POOL_GROUP_WIDTH
HEAD_DIM = 128
N_HEADS = D_MODEL // (2 * HEAD_DIM)
ATTN_WIDTH = N_HEADS * HEAD_DIM
Q_BLOCK = 128
N_BRANCHES = 2
BRANCH_WIDTH = POOL_WIDTH
IN_WIDTH = POOL_WIDTH + 3 * ATTN_WIDTH + N_HEADS
N_EXPERTS = 16
N_EXPERT_GROUPS = 4
EXPERTS_PER_GROUP = N_EXPERTS // N_EXPERT_GROUPS
TOP_K = 2
D_EXPERT = D_MODEL // 2
DISPATCH_BLOCK = 128
N_MOD = 6
EPS = 1e-6

kernel_name = "hybrid_pool_fox_grouped_moe_adaln"


def rmsnorm(x, g):
    x32 = x.astype(jnp.float32)
    y = x32 * lax.rsqrt(jnp.mean(x32 * x32, axis=-1, keepdims=True) + EPS)
    return (y * g.astype(jnp.float32)).astype(x.dtype)


def causal_multiscale_pool(u, w_pool, pool_scale):
    B, S, _ = u.shape
    ug_all = u.reshape(B, S, N_POOL_GROUPS, POOL_GROUP_WIDTH)
    t_idx = jnp.arange(S)
    outs = []
    for g, w in enumerate(POOL_WINDOWS):
        ug = ug_all[:, :, g].astype(jnp.float32)
        cs = jnp.cumsum(ug, axis=1)
        lagged = jnp.pad(cs, ((0, 0), (w, 0), (0, 0)))[:, :S]
        cnt = jnp.minimum(t_idx + 1, w).astype(jnp.float32)[None, :, None]
        outs.append((cs - lagged) / cnt - ug)
    pooled = jnp.stack(outs, axis=2).astype(u.dtype)
    mixed = jnp.einsum('bsgc,gcd->bsgd', pooled, w_pool)
    return mixed.reshape(B, S, POOL_WIDTH) * pool_scale


def forgetting_attention(q, k, v, f_logit):
    B, S, _ = q.shape
    def heads(a):
        return a.reshape(B, S, N_HEADS, HEAD_DIM).transpose(0, 2, 1, 3)
    q, k, v = heads(q), heads(k), heads(v)
    log_f = jax.nn.log_sigmoid(f_logit.astype(jnp.float32)).transpose(0, 2, 1)
    F = jnp.cumsum(log_f, axis=-1)
    nb = S // Q_BLOCK
    q_blocks = q.reshape(B, N_HEADS, nb, Q_BLOCK, HEAD_DIM).transpose(2, 0, 1, 3, 4)
    F_blocks = F.reshape(B, N_HEADS, nb, Q_BLOCK).transpose(2, 0, 1, 3)
    k_pos = jnp.arange(S)
    scale = HEAD_DIM ** -0.5

    def block(args):
        qb, Fq, i = args
        s = jnp.einsum('bhqd,bhkd->bhqk', qb, k, preferred_element_type=jnp.float32) * scale
        s = s + (Fq[..., None] - F[:, :, None, :])
        q_pos = i * Q_BLOCK + jnp.arange(Q_BLOCK)
        s = jnp.where(k_pos[None, :] <= q_pos[:, None], s, -jnp.inf)
        p = jax.nn.softmax(s, axis=-1)
        return jnp.einsum('bhqk,bhkd->bhqd', p.astype(v.dtype), v)

    o = lax.map(block, (q_blocks, F_blocks, jnp.arange(nb)))
    return o.transpose(1, 0, 3, 2, 4).reshape(B, S, ATTN_WIDTH)


def hybrid_mixer(h, w_in, b_forget, w_pool, pool_scale, w_branch, w_gate, b_gate, w_out):
    B, S, D = h.shape
    proj = jnp.einsum('bsd,dn->bsn', h, w_in)
    p0 = POOL_WIDTH
    u_pool = proj[..., :p0]
    q = proj[..., p0:p0 + ATTN_WIDTH]
    k = proj[..., p0 + ATTN_WIDTH:p0 + 2 * ATTN_WIDTH]
    v = proj[..., p0 + 2 * ATTN_WIDTH:p0 + 3 * ATTN_WIDTH]
    f_logit = proj[..., p0 + 3 * ATTN_WIDTH:] + b_forget
    pool_out = causal_multiscale_pool(u_pool, w_pool, pool_scale)
    attn_out = forgetting_attention(q, k, v, f_logit)
    branches = jnp.stack([pool_out, attn_out], axis=2)
    y = jnp.einsum('bsnw,nwd->bsnd', branches, w_branch)
    g = jax.nn.sigmoid(jnp.einsum('bsd,dm->bsm', h, w_gate) + b_gate).reshape(B, S, N_BRANCHES, D)
    merged = jnp.sum(g * y, axis=2)
    return jnp.einsum('bsd,de->bse', merged, w_out)


def grouped_moe(h, w_router, b_router, w_g, w_u, w_d):
    B, S, D = h.shape
    T = B * S
    hf = h.reshape(T, D)
    logits = jnp.einsum('td,de->te', hf, w_router, preferred_element_type=jnp.float32)
    probs = jax.nn.softmax(logits, axis=-1)
    sel = (probs + b_router.astype(jnp.float32)).reshape(T, N_EXPERT_GROUPS, EXPERTS_PER_GROUP)
    group_score = lax.top_k(sel, TOP_K)[0].sum(-1)
    g_star = jnp.argmax(group_score, axis=-1)
    sel_in = sel[jnp.arange(T), g_star]
    _, local = lax.top_k(sel_in, TOP_K)
    expert_idx = g_star[:, None] * EXPERTS_PER_GROUP + local
    gate = jnp.take_along_axis(probs, expert_idx, axis=1)
    gate = gate / jnp.sum(gate, axis=-1, keepdims=True)

    A = T * TOP_K
    e_flat = expert_idx.reshape(A)
    tok_flat = jnp.repeat(jnp.arange(T), TOP_K)
    w_flat = gate.reshape(A)
    order = jnp.argsort(e_flat)
    e_s, tok_s, w_s = e_flat[order], tok_flat[order], w_flat[order]
    counts = jnp.bincount(e_flat, length=N_EXPERTS)
    starts = jnp.cumsum(counts) - counts
    pcounts = (counts + DISPATCH_BLOCK - 1) // DISPATCH_BLOCK * DISPATCH_BLOCK
    pends = jnp.cumsum(pcounts)
    pstarts = pends - pcounts
    dest = pstarts[e_s] + (jnp.arange(A) - starts[e_s])
    n_blocks = (A + DISPATCH_BLOCK - 1) // DISPATCH_BLOCK + N_EXPERTS
    buf = jnp.zeros((n_blocks * DISPATCH_BLOCK, D), h.dtype).at[dest].set(hf[tok_s])
    block_expert = jnp.clip(
        jnp.searchsorted(pends, jnp.arange(n_blocks) * DISPATCH_BLOCK, side='right'), 0, N_EXPERTS - 1)

    def expert_block(args):
        xb, e = args
        a = xb @ w_g[e]
        u = xb @ w_u[e]
        return (jax.nn.silu(a) * u) @ w_d[e]

    y_buf = lax.map(expert_block, (buf.reshape(n_blocks, DISPATCH_BLOCK, D), block_expert))
    y = y_buf.reshape(-1, D)[dest] * w_s[:, None].astype(h.dtype)
    out = jax.ops.segment_sum(y, tok_s, num_segments=T)
    return out.reshape(B, S, D)


def setup_inputs(seed: int = 0) -> dict:
    key = jax.random.key(seed)
    ks = jax.random.split(key, 20)
    nrm = jax.random.normal
    D = D_MODEL
    return {
        "x": nrm(ks[0], (BATCH, SEQ, D), jnp.float32),
        "c": nrm(ks[1], (BATCH, D), jnp.float32),
        "w_ada": nrm(ks[2], (DEPTH, D, N_MOD * D), jnp.float32) * (0.5 * D ** -0.5),
        "b_ada": 0.01 * nrm(ks[3], (DEPTH, N_MOD * D), jnp.float32),
        "norm_mix": 1.0 + 0.1 * nrm(ks[4], (DEPTH, D), jnp.float32),
        "norm_moe": 1.0 + 0.1 * nrm(ks[5], (DEPTH, D), jnp.float32),
        "w_in": nrm(ks[6], (DEPTH, D, IN_WIDTH), jnp.float32) * D ** -0.5,
        "b_forget": 3.0 + 0.5 * nrm(ks[7], (DEPTH, N_HEADS), jnp.float32),
        "w_pool": nrm(ks[8], (DEPTH, N_POOL_GROUPS, POOL_GROUP_WIDTH, POOL_GROUP_WIDTH), jnp.float32) * POOL_GROUP_WIDTH ** -0.5,
        "pool_scale": 1.0 + 0.1 * nrm(ks[9], (DEPTH, POOL_WIDTH), jnp.float32),
        "w_branch": nrm(ks[10], (DEPTH, N_BRANCHES, BRANCH_WIDTH, D), jnp.float32) * BRANCH_WIDTH ** -0.5,
        "w_gate": nrm(ks[11], (DEPTH, D, N_BRANCHES * D), jnp.float32) * D ** -0.5,
        "b_gate": 0.01 * nrm(ks[12], (DEPTH, N_BRANCHES * D), jnp.float32),
        "w_out": nrm(ks[13], (DEPTH, D, D), jnp.float32) * D ** -0.5,
        "w_router": nrm(ks[14], (D, N_EXPERTS), jnp.float32) * D ** -0.5,
        "b_router": 0.01 * nrm(ks[15], (N_EXPERTS,), jnp.float32),
        "w_exp_gate": nrm(ks[16], (DEPTH, N_EXPERTS, D, D_EXPERT), jnp.float32) * D ** -0.5,
        "w_exp_up": nrm(ks[17], (DEPTH, N_EXPERTS, D, D_EXPERT), jnp.float32) * D ** -0.5,
        "w_exp_down": nrm(ks[18], (DEPTH, N_EXPERTS, D_EXPERT, D), jnp.float32) * D_EXPERT ** -0.5,
        "norm_final": 1.0 + 0.1 * nrm(ks[19], (D,), jnp.float32),
    }


def reference(x, c, w_ada, b_ada, norm_mix, norm_moe, w_in, b_forget, w_pool, pool_scale,
              w_branch, w_gate, b_gate, w_out, w_router, b_router, w_exp_gate, w_exp_up,
              w_exp_down, norm_final):
    c_act = jax.nn.silu(c)
    for l in range(DEPTH):
        mod = (jnp.einsum('bd,dm->bm', c_act, w_ada[l]) + b_ada[l])[:, None, :]
        shift_a, scale_a, gate_a, shift_m, scale_m, gate_m = jnp.split(mod, N_MOD, axis=-1)
        h = rmsnorm(x, norm_mix[l]) * (1.0 + scale_a) + shift_a
        x = x + gate_a * hybrid_mixer(h, w_in[l], b_forget[l], w_pool[l], pool_scale[l],
                                      w_branch[l], w_gate[l], b_gate[l], w_out[l])
        h = rmsnorm(x, norm_moe[l]) * (1.0 + scale_m) + shift_m
        x = x + gate_m * grouped_moe(h, w_router, b_router, w_exp_gate[l], w_exp_up[l], w_exp_down[l])
    return rmsnorm(x, norm_final)
```

```cpp
#include <hip/hip_runtime.h>
#include <stdio.h>
#include <stdint.h>

#ifndef MK_ONE_LAUNCH
#define MK_ONE_LAUNCH 1
#endif
#ifndef MOE_FP8
#define MOE_FP8 1
#endif
#ifndef G1_FP8
#define G1_FP8 2
#endif
#ifndef G3_FP8
#define G3_FP8 1
#endif
#ifndef G2_FP8
#define G2_FP8 1
#endif
#ifndef YB_FP8
#define YB_FP8 1
#endif
#ifndef GEMM_FAST
#define GEMM_FAST 1
#endif
#ifndef ATTN_FAST
#define ATTN_FAST 1
#endif

#define GAS __attribute__((address_space(1)))
#define LAS __attribute__((address_space(3)))
typedef unsigned short bf16;
typedef short bf16x8 __attribute__((ext_vector_type(8)));
typedef float f32x4 __attribute__((ext_vector_type(4)));
typedef float f32x2 __attribute__((ext_vector_type(2)));
typedef unsigned u32x4 __attribute__((ext_vector_type(4)));
typedef unsigned u32x2 __attribute__((ext_vector_type(2)));
typedef GAS unsigned gu32;
#define RLX_AGENT __ATOMIC_RELAXED, __HIP_MEMORY_SCOPE_AGENT
#define LDS_WAIT() asm volatile("s_waitcnt lgkmcnt(0)" ::: "memory")
#define VM_WAIT() asm volatile("s_waitcnt vmcnt(0)" ::: "memory")

constexpr int DM = 2048, BATCH = 8, SEQ = 2048, T = BATCH * SEQ, DEPTH = 2;
constexpr int PW = 1024, AW = 1024, NH = 8, HD = 128, INW = 4104, NE = 16, DE = 1024, NMOD = 6;
constexpr int MODW = NMOD * DM;
constexpr float EPS = 1e-6f;
constexpr int NWAVES = 8, NTHREADS = 512;
constexpr int LIST_CAP = 16384;
constexpr int MAX_RT = 144;

constexpr size_t MiB = 1u << 20;
constexpr size_t WS_CTL = 0, CTL_ZERO_BYTES = 1 * MiB;
constexpr size_t WS_MOD = 1 * MiB;
constexpr size_t WS_W = 2 * MiB, W_LAYER = 241 * MiB;
constexpr size_t WO_PG = 0, WO_POOL = 32 * MiB, WO_BR = 33 * MiB, WO_OUT = 41 * MiB, WO_GU = 49 * MiB, WO_D = 177 * MiB;
constexpr size_t WS_H = 484 * MiB;
constexpr size_t WS_U = 548 * MiB, WS_Q = 580 * MiB, WS_K = 612 * MiB, WS_V = 644 * MiB;
constexpr size_t WS_G = 676 * MiB;
constexpr size_t WS_PL = 804 * MiB, WS_PO = 836 * MiB, WS_AO = 868 * MiB;
constexpr size_t WS_MG = 900 * MiB;
constexpr size_t WS_DL = 804 * MiB;
constexpr size_t WS_ACT = 804 * MiB;
constexpr size_t WS_YB = 548 * MiB;
constexpr size_t WS_LS = 964 * MiB;
constexpr size_t WS_TOKE = 965 * MiB;
constexpr size_t WS_TOKW = WS_TOKE + 128 * 1024;
constexpr size_t WS_TOKP = WS_TOKW + 128 * 1024;
constexpr size_t WS_LIST = 966 * MiB;
constexpr size_t WS_MODP = 968 * MiB;
constexpr size_t WS_H8 = 972 * MiB;
constexpr size_t WS_XB = 1004 * MiB;
constexpr size_t WS_MG8 = 1068 * MiB;
constexpr size_t WS_END = 1100 * MiB;
constexpr int CW_BAR = 4096;
constexpr int CW_CNT = 16384;

constexpr int RING_BYTES = 131072;
constexpr int EXTRA_OFF = 135168;
constexpr int LDS_BYTES = 147456;
constexpr int X_MISC = EXTRA_OFF;
constexpr int X_TOK = EXTRA_OFF + 1024;
constexpr int X_ASG = EXTRA_OFF + 9216;

typedef __bf16 bf16x2_t __attribute__((ext_vector_type(2)));
__device__ __forceinline__ unsigned cvt_pk_bf16(float lo, float hi) { f32x2 v = {lo, hi}; bf16x2_t b = __builtin_convertvector(v, bf16x2_t); return __builtin_bit_cast(unsigned, b); }
typedef int i32x8 __attribute__((ext_vector_type(8)));
typedef int i32x4 __attribute__((ext_vector_type(4)));
__device__ __forceinline__ unsigned pk4_fp8(float a, float b, float c, float d) { int w = __builtin_amdgcn_cvt_pk_fp8_f32(a, b, 0, false); w = __builtin_amdgcn_cvt_pk_fp8_f32(c, d, w, true); return (unsigned)w; }
__device__ __forceinline__ unsigned pk4_unorm8(const f32x4 v) { unsigned w = 0;
    w = __builtin_amdgcn_cvt_pk_u8_f32(__builtin_floorf(v[0] * 255.0f + 0.5f), 0, w); w = __builtin_amdgcn_cvt_pk_u8_f32(__builtin_floorf(v[1] * 255.0f + 0.5f), 1, w);
    w = __builtin_amdgcn_cvt_pk_u8_f32(__builtin_floorf(v[2] * 255.0f + 0.5f), 2, w); w = __builtin_amdgcn_cvt_pk_u8_f32(__builtin_floorf(v[3] * 255.0f + 0.5f), 3, w); return w; }
__device__ __forceinline__ f32x4 unpk4_u8(unsigned w) { return (f32x4){(float)(w & 0xffu), (float)((w >> 8) & 0xffu), (float)((w >> 16) & 0xffu), (float)(w >> 24)}; }
__device__ __forceinline__ f32x4 unpk4_unorm8(unsigned w) { return (f32x4){(float)(w & 0xffu), (float)((w >> 8) & 0xffu), (float)((w >> 16) & 0xffu), (float)(w >> 24)} * (1.0f / 255.0f); }
__device__ __forceinline__ f32x4 unpk4_fp8(unsigned w) { const f32x2 lo = __builtin_amdgcn_cvt_pk_f32_fp8((int)w, false), hi = __builtin_amdgcn_cvt_pk_f32_fp8((int)w, true); return (f32x4){lo.x, lo.y, hi.x, hi.y}; }
constexpr float W8_SCALE = 32.0f, W8_INV = 1.0f / 32.0f;
__device__ __forceinline__ float bf_lo(unsigned w) { return __uint_as_float(w << 16); }
__device__ __forceinline__ float bf_hi(unsigned w) { return __uint_as_float(w & 0xffff0000u); }
__device__ __forceinline__ float wave_sum(float v) {
#pragma unroll
    for (int o = 1; o < 64; o <<= 1) v += __shfl_xor(v, o);
    return v;
}
template <int CTRL, int ROW_MASK> __device__ __forceinline__ float dpp_get(float v) { return __int_as_float(__builtin_amdgcn_update_dpp(0, __float_as_int(v), CTRL, ROW_MASK, 0xf, false)); }
__device__ __forceinline__ float wave_sum_u(float v) {
    v += dpp_get<0xB1, 0xf>(v);
    v += dpp_get<0x4E, 0xf>(v);
    v += dpp_get<0x141, 0xf>(v);
    v += dpp_get<0x140, 0xf>(v);
    v += dpp_get<0x142, 0xa>(v);
    v += dpp_get<0x143, 0xc>(v);
    return __int_as_float(__builtin_amdgcn_readlane(__float_as_int(v), 63));
}
__device__ __forceinline__ float wave_max(float v) {
#pragma unroll
    for (int o = 1; o < 64; o <<= 1) v = fmaxf(v, __shfl_xor(v, o));
    return v;
}
__device__ __forceinline__ float sigmoidf_(float x) { return __builtin_amdgcn_rcpf(1.0f + __builtin_amdgcn_exp2f(-1.4426950408889634f * x)); }

__device__ __forceinline__ int opaque_tid() { int t = threadIdx.x; asm volatile("" : "+v"(t)); return t; }

#define XB_TMO      128
#define XB_XCNT(j)  (256  + 64 * (j))
#define XB_XSUB(j)  (1280 + 64 * (j))
#define XB_XGEN(j)  (2304 + 64 * (j))
#define XB_TOP      3328
#define XB_TOPGEN   3392
#define XCD_BAR_WORDS 3456
#define XB_SPIN_CAP (1u << 24)
__device__ __forceinline__ unsigned xb_ld(unsigned* p)              { return __hip_atomic_load(p, __ATOMIC_RELAXED, __HIP_MEMORY_SCOPE_AGENT); }
__device__ __forceinline__ unsigned xb_add(unsigned* p, unsigned v) { return __hip_atomic_fetch_add(p, v, __ATOMIC_RELAXED, __HIP_MEMORY_SCOPE_AGENT); }
__device__ __forceinline__ unsigned xb_xcc_id() { return (unsigned)__builtin_amdgcn_s_getreg((3 << 11) | 20) & 0xFu; }
#define XB_SPIN(cond, bar) do { unsigned _sp = 0; while (cond) { __builtin_amdgcn_s_sleep(1); \
    if ((++_sp & 255u) == 0u) { if (xb_ld(&(bar)[XB_TMO])) break; if (_sp > XB_SPIN_CAP) { atomicAdd(&(bar)[XB_TMO], 1u); break; } } } } while (0)
struct XcdBarrier { unsigned* bar; unsigned x; volatile LAS unsigned* st; };
__device__ __forceinline__ XcdBarrier xcd_barrier_post(unsigned* bar, volatile LAS unsigned* st) {
    XcdBarrier b; b.bar = bar; b.x = xb_xcc_id(); b.st = st;
    if (threadIdx.x == 0) (void)xb_add(&bar[XB_XCNT(b.x)], 1u);
    return b;
}
__device__ __forceinline__ void xcd_barrier_complete(unsigned* bar, unsigned x, unsigned& nloc, unsigned& nx) {
    const unsigned G = gridDim.x * gridDim.y * gridDim.z;
    unsigned sum, cnt, mine, sp = 0u;
    for (;;) {
        sum = 0u; cnt = 0u; mine = 0u;
#pragma unroll
        for (unsigned j = 0; j < 16; ++j) { const unsigned c = xb_ld(&bar[XB_XCNT(j)]); sum += c; cnt += (c > 0u) ? 1u : 0u; mine = (j == x) ? c : mine; }
        if (sum == G) break;
        __builtin_amdgcn_s_sleep(1);
        if ((++sp & 255u) == 0u) { if (xb_ld(&bar[XB_TMO])) break; if (sp > XB_SPIN_CAP) { atomicAdd(&bar[XB_TMO], 1u); break; } }
    }
    nloc = mine > 0u ? mine : 1u; nx = cnt > 0u ? cnt : 1u;
}
__device__ __forceinline__ void xcd_barrier(const XcdBarrier& b) {
    asm volatile("s_waitcnt vmcnt(0)" ::: "memory");
    __syncthreads();
    if (threadIdx.x == 0) {
        unsigned* bar = b.bar;
        __builtin_amdgcn_s_waitcnt(0);
        unsigned nloc = b.st[0], nx = b.st[1];
        if (nloc == 0u) { xcd_barrier_complete(bar, b.x, nloc, nx); b.st[0] = nloc; b.st[1] = nx; }
        const unsigned old = xb_add(&bar[XB_XSUB(b.x)], 1u);
        const unsigned gen = old / nloc;
        if (old + 1u == (gen + 1u) * nloc) {
            __builtin_amdgcn_fence(__ATOMIC_RELEASE, "agent");
            asm volatile("s_waitcnt vmcnt(0)" ::: "memory");
            const unsigned og = xb_add(&bar[XB_TOP], 1u);
            const unsigned tg = og / nx;
            if (og + 1u == (tg + 1u) * nx) xb_add(&bar[XB_TOPGEN], 1u);
            else XB_SPIN(xb_ld(&bar[XB_TOPGEN]) == tg, bar);
            __builtin_amdgcn_fence(__ATOMIC_ACQUIRE, "agent");
            xb_add(&bar[XB_XGEN(b.x)], 1u);
            asm volatile("s_waitcnt vmcnt(0)" ::: "memory");
        } else {
            XB_SPIN(xb_ld(&bar[XB_XGEN(b.x)]) == gen, bar);
            __builtin_amdgcn_fence(__ATOMIC_ACQUIRE, "agent");
            asm volatile("s_waitcnt vmcnt(0)" ::: "memory");
        }
    }
    __syncthreads();
}

namespace pg8 {
constexpr int BM = 256, BK = 64, HALF = 128, HTB = HALF * BK * 2, STAGE_BYTES = 8 * HTB, NXCD = 8, WGM = 8;
__device__ __forceinline__ int lds_byte(int r, int c) { const int st = (r >> 4) * 2 + (c >> 5), rr = r & 15, cc = c & 31, ob = rr * 64 + cc * 2; return st * 1024 + (ob ^ (((ob >> 9) & 1) << 5)); }
__device__ __forceinline__ void stage_rc(int b, int& R, int& C) { const int st = b / 1024, sb = b % 1024, swz = sb ^ (((sb >> 9) & 1) << 5); R = (st >> 1) * 16 + swz / 64; C = (st & 1) * 32 + (swz % 64) / 2; }
__device__ __forceinline__ int perm32(int rho) { const int n = rho >> 4, i = rho & 15; return 8 * (i >> 2) + 4 * n + (i & 3); }

struct Unit { int pm, pn, ti; unsigned aoff, boff, aoff2, boff2; };
struct Gemm { const bf16* A; const bf16* Bt; };

template <int M_, int N_, int LDA, int LDB> struct StaticOrder {
    static constexpr int nM = M_ / BM, nN = N_ / BM, nwg = nM * nN;
    int G, c;
    __device__ void init(int G_, int c_) { G = G_; c = c_; }
    __device__ bool next(int i, Unit& u) const {
        const int L = i * G + c; if (L >= nwg) return false;
        int wgid = L; { constexpr int q = nwg / NXCD, r = nwg % NXCD; const int xcd = wgid % NXCD, off = wgid / NXCD; wgid = (xcd < r ? xcd * (q + 1) : r * (q + 1) + (xcd - r) * q) + off; }
        constexpr int nig = WGM * nN; const int gid = wgid / nig, fm = gid * WGM, gsz = (nM - fm) < WGM ? (nM - fm) : WGM;
        u.pm = fm + ((wgid % nig) % gsz); u.pn = (wgid % nig) / gsz; u.ti = i;
        u.aoff = (unsigned)u.pm * (unsigned)(BM * LDA * 2); u.boff = (unsigned)u.pn * (unsigned)(BM * LDB * 2); u.aoff2 = 0u; u.boff2 = 0u;
        return true;
    }
};
template <class Base> struct BranchOrder {
    Base S0; unsigned a_step, b_step;
    __device__ bool next(int i, Unit& u) const { if (!S0.next(i >> 1, u)) return false; const unsigned p = (unsigned)(i & 1); u.ti = (int)p; u.aoff += p * a_step; u.boff += p * b_step; return true; }
};
template <class Base> struct SplitOrder {
    Base S0; unsigned a2, b2;
    __device__ bool next(int i, Unit& u) const { if (!S0.next(i, u)) return false; u.aoff2 = u.aoff + a2; u.boff2 = u.boff + b2; return true; }
};
struct OneUnit {
    Unit u0;
    __device__ bool next(int i, Unit& u) const { if (i > 0) return false; u = u0; return true; }
};
struct MoeOrder {
    int G, c, NT; const LAS int* tpre; unsigned a_tile_bytes, b_exp_bytes, b_tile_bytes;
    __device__ bool next(int i, Unit& u) const {
        const int L = i * G + c; const int x = L & 7, a = L >> 3, pn = a & 7, q = a >> 3;
        const int rt = (G == 256) ? 32 * i + 4 * x + (c >> 6) : q * 8 + x;
        if (rt >= NT) return false;
        int e = 0;
#pragma unroll
        for (int j = 1; j < 16; ++j) e += (rt >= tpre[j]) ? 1 : 0;
        e = __builtin_amdgcn_readfirstlane(e);
        u.pm = rt; u.pn = pn; u.ti = i; u.aoff = (unsigned)rt * a_tile_bytes; u.boff = (unsigned)e * b_exp_bytes + (unsigned)pn * b_tile_bytes; u.aoff2 = 0u; u.boff2 = 0u;
        return true;
    }
};

#if !GEMM_FAST
template <class Epi, class Sched, bool GATHER, int LDA, int LDB, int KK>
__device__ __forceinline__ void gemm_phase(LAS unsigned char* lds, const Gemm g, const Sched& S, const Epi& E, const LAS int* tokTab) {
    const int tid = opaque_tid(), wid = __builtin_amdgcn_readfirstlane(tid >> 6), lane = tid & 63, wr = wid >> 2, wc = wid & 3, fr = lane & 15, fq = lane >> 4;
    Unit u;
    for (int i = 0; S.next(i, u); ++i) {
        f32x4 acc[2][2][4][2];
#pragma unroll
        for (int a = 0; a < 2; ++a)
#pragma unroll
            for (int b = 0; b < 2; ++b)
#pragma unroll
                for (int m = 0; m < 4; ++m)
#pragma unroll
                    for (int n = 0; n < 2; ++n) acc[a][b][m][n] = (f32x4){0.f, 0.f, 0.f, 0.f};
        const char* Ab = (const char*)g.A + u.aoff; const char* Bb = (const char*)g.Bt + u.boff;
        unsigned arow[2][4], brow[2][2];
#pragma unroll
        for (int ai = 0; ai < 2; ++ai)
#pragma unroll
            for (int m = 0; m < 4; ++m) { const int r = ai * HALF + wr * 64 + m * 16 + fr;
                arow[ai][m] = (GATHER ? (unsigned)tokTab[u.ti * 256 + r] : (unsigned)r) * (unsigned)(LDA * 2); }
#pragma unroll
        for (int bj = 0; bj < 2; ++bj)
#pragma unroll
            for (int n = 0; n < 2; ++n) { const int slot = 16 * n + fr; const int rb = bj * HALF + wc * 32 + (Epi::PERM ? perm32(slot) : slot); brow[bj][n] = (unsigned)rb * (unsigned)(LDB * 2); }
#pragma nounroll
        for (int k0 = 0; k0 < KK; k0 += 32) {
            bf16x8 Bf[2][2];
            const unsigned kb = (unsigned)(k0 + fq * 8) * 2u;
#pragma unroll
            for (int bj = 0; bj < 2; ++bj)
#pragma unroll
                for (int n = 0; n < 2; ++n) Bf[bj][n] = *(const bf16x8*)(Bb + brow[bj][n] + kb);
#pragma unroll
            for (int ai = 0; ai < 2; ++ai) {
                bf16x8 Af[4];
#pragma unroll
                for (int m = 0; m < 4; ++m) Af[m] = *(const bf16x8*)(Ab + arow[ai][m] + kb);
#pragma unroll
                for (int bj = 0; bj < 2; ++bj)
#pragma unroll
                    for (int m = 0; m < 4; ++m)
#pragma unroll
                        for (int n = 0; n < 2; ++n) acc[ai][bj][m][n] = __builtin_amdgcn_mfma_f32_16x16x32_bf16(Bf[bj][n], Af[m], acc[ai][bj][m][n], 0, 0, 0);
                asm volatile("" ::: "memory");
            }
        }
        E(acc, u, wr, wc, fr, fq);
    }
    (void)lds;
}
#else
template <class Epi, class Sched, bool GATHER, int LDA, int LDB, int KK, bool FP8 = false, int KSPLIT = 0>
__device__ __forceinline__ void gemm_phase(LAS unsigned char* lds, const Gemm g, const Sched& S, const Epi& E, const LAS int* tokTab) {
    constexpr bool ALIGN_EPI = true; constexpr int KS = KSPLIT;
    const int tid = opaque_tid(), wid = __builtin_amdgcn_readfirstlane(tid >> 6), lane = tid & 63, wr = wid >> 2, wc = wid & 3, fr = lane & 15, fq = lane >> 4;
    constexpr int nt = KK / BK;
    unsigned voffA[2], voffB[2];
#pragma unroll
    for (int i = 0; i < 2; ++i) { int R, C; stage_rc(tid * 16 + i * 8192, R, C); const int Rb = Epi::PERM ? ((R & ~31) + perm32(R & 31)) : R;
        voffA[i] = (unsigned)(R * LDA + C) * 2u; voffB[i] = (unsigned)(Rb * LDB + C) * 2u; }
    constexpr unsigned rowA = (unsigned)LDA * 2u;
    constexpr unsigned kstep = (unsigned)(BK * 2);
    constexpr unsigned hstepA = (unsigned)HALF * LDA * 2u, hstepB = (unsigned)HALF * LDB * 2u;
    const unsigned ldsw = (unsigned)wid * 1024u;
    const int aoff = lds_byte(wr * 64 + fr, fq * 8), boff = lds_byte(wc * 32 + fr, fq * 8);
#define PG8_SA(b, h) (((b) * 2 + (h)) * HTB)
#define PG8_SB(b, h) ((4 + (b) * 2 + (h)) * HTB)
#define PG8_STAGE(bufoff, gbase, uoff, voff) do { _Pragma("unroll") for (int _i = 0; _i < 2; ++_i) \
        __builtin_amdgcn_global_load_lds((const unsigned*)((const char*)(gbase) + (size_t)(unsigned)((uoff) + (voff)[_i])), (LAS unsigned*)(lds + (bufoff) + ldsw + _i * 8192), 16, 0, 0); } while (0)
#define PG8_STAGE_A(bufoff, p, hh, VA) do { if constexpr (GATHER) { PG8_STAGE(bufoff, g.A, p, VA[hh]); } else { PG8_STAGE(bufoff, g.A, (p) + (hh) * hstepA, voffA); } } while (0)
#define PG8_STAGE_B(bufoff, p) PG8_STAGE(bufoff, g.Bt, p, voffB)
#define PG8_LD32(p) __builtin_shufflevector(*(const LAS i32x4*)(p), *(const LAS i32x4*)((p) + 1024), 0, 1, 2, 3, 4, 5, 6, 7)
#define PG8_LDA(dst, b, h) do { if constexpr (FP8) { _Pragma("unroll") for (int m = 0; m < 4; ++m) dst##8[m] = PG8_LD32(lds + PG8_SA(b, h) + aoff + m * 2048); } \
        else { _Pragma("unroll") for (int m = 0; m < 4; ++m) _Pragma("unroll") for (int k = 0; k < 2; ++k) dst[m][k] = *(const LAS bf16x8*)(lds + PG8_SA(b, h) + aoff + m * 2048 + k * 1024); } } while (0)
#define PG8_LDB(dst, b, h) do { if constexpr (FP8) { _Pragma("unroll") for (int n = 0; n < 2; ++n) dst##8[n] = PG8_LD32(lds + PG8_SB(b, h) + boff + n * 2048); } \
        else { _Pragma("unroll") for (int n = 0; n < 2; ++n) _Pragma("unroll") for (int k = 0; k < 2; ++k) dst[n][k] = *(const LAS bf16x8*)(lds + PG8_SB(b, h) + boff + n * 2048 + k * 1024); } } while (0)
#define PG8_MMA(ai, bj, At, Bt) do { __builtin_amdgcn_s_setprio(1); _Pragma("unroll") for (int m = 0; m < 4; ++m) _Pragma("unroll") for (int n = 0; n < 2; ++n) { \
        if constexpr (FP8) { asm volatile("v_mfma_f32_16x16x128_f8f6f4 %0, %1, %2, %0" : "+v"(acc[ai][bj][m][n]) : "v"(Bt##8[n]), "v"(At##8[m])); }   \
        else { _Pragma("unroll") for (int k = 0; k < 2; ++k) acc[ai][bj][m][n] = __builtin_amdgcn_mfma_f32_16x16x32_bf16(Bt[n][k], At[m][k], acc[ai][bj][m][n], 0, 0, 0); } } \
        __builtin_amdgcn_s_setprio(0); } while (0)
#define PG8_WAIT_V(n) asm volatile("s_waitcnt vmcnt(" #n ")" ::: "memory")
#define PG8_WAIT_L(n) asm volatile("s_waitcnt lgkmcnt(" #n ")" ::: "memory")
#define PG8_BAR __builtin_amdgcn_s_barrier()
#define PG8_SCHED __builtin_amdgcn_sched_barrier(0)
#define PG8_AOFFS(dst, uu) do { _Pragma("unroll") for (int _i = 0; _i < 2; ++_i) { int _R, _C; stage_rc(tid * 16 + _i * 8192, _R, _C); _Pragma("unroll") for (int _h = 0; _h < 2; ++_h) \
        dst[_h][_i] = (unsigned)tokTab[(uu).ti * 256 + _h * HALF + _R] * rowA + (unsigned)_C * 2u; } } while (0)
#define PG8_TRIP(VC, V2) do { \
        PG8_LDB(B0, 0, 0); PG8_LDB(B1, 0, 1); PG8_SCHED; PG8_LDA(At, 0, 0); PG8_STAGE_A(PG8_SA(1, 1), a1, 1, VC); \
        PG8_WAIT_V(8); PG8_WAIT_L(0); PG8_BAR; PG8_MMA(0, 0, At, B0); PG8_MMA(0, 1, At, B1); PG8_BAR; PG8_SCHED; \
        PG8_LDA(At, 0, 1); PG8_STAGE_B(PG8_SB(0, 0), b2); PG8_STAGE_B(PG8_SB(0, 1), b2 + hstepB); PG8_STAGE_A(PG8_SA(0, 0), a2, 0, V2); \
        PG8_WAIT_V(8); PG8_WAIT_L(0); PG8_BAR; PG8_MMA(1, 0, At, B0); PG8_MMA(1, 1, At, B1); PG8_BAR; PG8_SCHED; \
        PG8_LDB(B0, 1, 0); PG8_LDB(B1, 1, 1); PG8_SCHED; PG8_LDA(At, 1, 0); PG8_STAGE_A(PG8_SA(0, 1), a2, 1, V2); \
        PG8_WAIT_V(8); PG8_WAIT_L(0); PG8_BAR; PG8_MMA(0, 0, At, B0); PG8_MMA(0, 1, At, B1); PG8_BAR; PG8_SCHED; \
        PG8_LDA(At, 1, 1); PG8_STAGE_B(PG8_SB(1, 0), b3); PG8_STAGE_B(PG8_SB(1, 1), b3 + hstepB); PG8_STAGE_A(PG8_SA(1, 0), a3, 0, V2); \
        PG8_WAIT_V(8); PG8_WAIT_L(0); PG8_BAR; PG8_MMA(1, 0, At, B0); PG8_MMA(1, 1, At, B1); PG8_BAR; PG8_SCHED; } while (0)
    Unit cur, nxt; int ui = 0;
    if (!S.next(0, cur)) return;
    f32x4 acc[2][2][4][2];
#pragma unroll
    for (int a = 0; a < 2; ++a)
#pragma unroll
        for (int b = 0; b < 2; ++b)
#pragma unroll
            for (int m = 0; m < 4; ++m)
#pragma unroll
                for (int n = 0; n < 2; ++n) acc[a][b][m][n] = (f32x4){0.f, 0.f, 0.f, 0.f};
    bf16x8 At[4][2], B0[2][2], B1[2][2]; i32x8 At8[4], B08[2], B18[2];
    unsigned vAc[2][2] = {{0u, 0u}, {0u, 0u}}, vAn[2][2] = {{0u, 0u}, {0u, 0u}};
    if constexpr (GATHER) { PG8_AOFFS(vAn, cur); vAc[1][0] = vAn[1][0]; vAc[1][1] = vAn[1][1]; }
    unsigned cA = cur.aoff, cB = cur.boff, cA2 = cur.aoff2, cB2 = cur.boff2;
#define PG8_KOFF(b1, b2, kt) ((KS != 0 && (kt) >= KS) ? (b2) + (unsigned)((kt) - KS) * kstep : (b1) + (unsigned)(kt) * kstep)
    PG8_STAGE_B(PG8_SB(0, 0), cB); PG8_STAGE_B(PG8_SB(0, 1), cB + hstepB); PG8_STAGE_A(PG8_SA(0, 0), cA, 0, vAn); PG8_STAGE_A(PG8_SA(0, 1), cA, 1, vAn);
    if (wr == 1) PG8_BAR;
    PG8_WAIT_V(2); PG8_BAR;
    PG8_STAGE_B(PG8_SB(1, 0), cB + kstep); PG8_STAGE_A(PG8_SA(1, 0), cA + kstep, 0, vAn); PG8_STAGE_B(PG8_SB(1, 1), cB + hstepB + kstep);
    PG8_WAIT_V(6); PG8_BAR;
    for (;;) {
        const bool has_next = S.next(ui + 1, nxt);
        const unsigned nA = has_next ? nxt.aoff : cA, nB = has_next ? nxt.boff : cB;
#pragma nounroll
        for (int t = 0; t < nt; t += 2) {
            const bool last = (t == nt - 2);
            const unsigned a1 = PG8_KOFF(cA, cA2, t + 1);
            const unsigned a2 = last ? nA : PG8_KOFF(cA, cA2, t + 2), b2 = last ? nB : PG8_KOFF(cB, cB2, t + 2);
            const unsigned a3 = a2 + kstep, b3 = b2 + kstep;
            if constexpr (GATHER) { if (last && has_next) { PG8_AOFFS(vAn, nxt); } }
            if constexpr (KS != 0) { if (t == KS) {
                if constexpr (FP8) asm volatile("s_nop 15\n\ts_nop 15" ::: "memory");
                E.mid(acc, cur, wr, wc, fr, fq); } }
            PG8_TRIP(vAc, vAn);
        }
        if constexpr (ALIGN_EPI) { if (wr == 0) PG8_BAR; }
        if constexpr (FP8) asm volatile("s_nop 15\n\ts_nop 15" ::: "memory");
        E(acc, cur, wr, wc, fr, fq);
        if (!has_next) break;
#pragma unroll
        for (int a = 0; a < 2; ++a)
#pragma unroll
            for (int b = 0; b < 2; ++b)
#pragma unroll
                for (int m = 0; m < 4; ++m)
#pragma unroll
                    for (int n = 0; n < 2; ++n) acc[a][b][m][n] = (f32x4){0.f, 0.f, 0.f, 0.f};
        cur = nxt; cA = nA; cB = nB; cA2 = cur.aoff2; cB2 = cur.boff2; ++ui;
        if constexpr (GATHER) { vAc[1][0] = vAn[1][0]; vAc[1][1] = vAn[1][1]; }
        if constexpr (ALIGN_EPI) { if (wr == 1) PG8_BAR; }
    }
    PG8_WAIT_V(0);
    if constexpr (!ALIGN_EPI) { if (wr == 0) PG8_BAR; }
    PG8_BAR;
#undef PG8_SA
#undef PG8_SB
#undef PG8_STAGE
#undef PG8_STAGE_A
#undef PG8_STAGE_B
#undef PG8_LDA
#undef PG8_LD32
#undef PG8_LDB
#undef PG8_MMA
#undef PG8_WAIT_V
#undef PG8_WAIT_L
#undef PG8_BAR
#undef PG8_SCHED
#undef PG8_AOFFS
#undef PG8_TRIP
#undef PG8_KOFF
    (void)rowA; (void)vAn;
}
#endif

typedef f32x4 Acc[2][2][4][2];
__device__ __forceinline__ u32x4 pack8(const f32x4 v0, const f32x4 v1) { u32x4 w; w.x = cvt_pk_bf16(v0[0], v0[1]); w.y = cvt_pk_bf16(v0[2], v0[3]); w.z = cvt_pk_bf16(v1[0], v1[1]); w.w = cvt_pk_bf16(v1[2], v1[3]); return w; }
__device__ __forceinline__ void unpack8(const u32x4 w, f32x4& v0, f32x4& v1) { v0 = (f32x4){bf_lo(w.x), bf_hi(w.x), bf_lo(w.y), bf_hi(w.y)}; v1 = (f32x4){bf_lo(w.z), bf_hi(w.z), bf_lo(w.w), bf_hi(w.w)}; }

struct EpiProj {
    static constexpr bool PERM = true;
    bf16* UQKV; bf16* Gt; const float* bgate; float mul; int pn_off;
    __device__ __forceinline__ void operator()(const Acc& acc, const Unit& u, int wr, int wc, int fr, int fq) const {
        const int row0 = u.pm * BM + wr * 64 + fr; const int pn = u.pn + pn_off;
        if (pn < 16) {
            bf16* base = UQKV + (size_t)(pn >> 2) * ((size_t)T * 1024) + (pn & 3) * 256 + wc * 32 + 8 * fq;
#pragma unroll
            for (int ai = 0; ai < 2; ++ai)
#pragma unroll
                for (int m = 0; m < 4; ++m) { bf16* rowp = base + (size_t)(row0 + ai * HALF + m * 16) * 1024;
#pragma unroll
                    for (int bj = 0; bj < 2; ++bj) *(u32x4*)(rowp + bj * HALF) = pack8(acc[ai][bj][m][0] * mul, acc[ai][bj][m][1] * mul); }
        } else {
            const int gc = (pn - 16) * 256 + wc * 32 + 8 * fq;
            f32x4 bv[2][2];
#pragma unroll
            for (int bj = 0; bj < 2; ++bj)
#pragma unroll
                for (int n = 0; n < 2; ++n) bv[bj][n] = *(const f32x4*)(bgate + gc + bj * HALF + 4 * n);
#pragma unroll
            for (int ai = 0; ai < 2; ++ai)
#pragma unroll
                for (int m = 0; m < 4; ++m) { unsigned char* rowp = (unsigned char*)Gt + (size_t)(row0 + ai * HALF + m * 16) * 4096 + gc;
#pragma unroll
                    for (int bj = 0; bj < 2; ++bj) { f32x4 v0 = acc[ai][bj][m][0] * mul + bv[bj][0], v1 = acc[ai][bj][m][1] * mul + bv[bj][1];
#pragma unroll
                        for (int j = 0; j < 4; ++j) { v0[j] = sigmoidf_(v0[j]); v1[j] = sigmoidf_(v1[j]); }
                        u32x2 w; w.x = pk4_unorm8(v0); w.y = pk4_unorm8(v1); *(u32x2*)(rowp + bj * HALF) = w; } }
        }
    }
};
struct EpiPool {
    static constexpr bool PERM = true;
    bf16* PO; const float* pscale; int g; unsigned char* PO8;
    __device__ __forceinline__ void operator()(const Acc& acc, const Unit& u, int wr, int wc, int fr, int fq) const {
        const int row0 = u.pm * BM + wr * 64 + fr; const int c0 = g * 256 + wc * 32 + 8 * fq;
        f32x4 sv[2][2];
#pragma unroll
        for (int bj = 0; bj < 2; ++bj)
#pragma unroll
            for (int n = 0; n < 2; ++n) sv[bj][n] = *(const f32x4*)(pscale + c0 + bj * HALF + 4 * n);
#pragma unroll
        for (int ai = 0; ai < 2; ++ai)
#pragma unroll
            for (int m = 0; m < 4; ++m) { const size_t ro = (size_t)(row0 + ai * HALF + m * 16) * 1024 + c0;
#pragma unroll
                for (int bj = 0; bj < 2; ++bj) { const f32x4 v0 = acc[ai][bj][m][0] * sv[bj][0], v1 = acc[ai][bj][m][1] * sv[bj][1];
                    if (PO8) { u32x2 w; w.x = pk4_fp8(v0[0], v0[1], v0[2], v0[3]); w.y = pk4_fp8(v1[0], v1[1], v1[2], v1[3]); *(u32x2*)(PO8 + ro + bj * HALF) = w; }
                    else *(u32x4*)(PO + ro + bj * HALF) = pack8(v0, v1); } }
    }
};
template <bool SECOND> struct EpiBranch {
    static constexpr bool PERM = true;
    bf16* MG; const bf16* Gt;
    __device__ __forceinline__ void operator()(const Acc& acc, const Unit& u, int wr, int wc, int fr, int fq) const {
        const int row0 = u.pm * BM + wr * 64 + fr; const int c0 = u.pn * BM + wc * 32 + 8 * fq;
#pragma unroll
        for (int ai = 0; ai < 2; ++ai)
#pragma unroll
            for (int m = 0; m < 4; ++m) { const size_t row = (size_t)(row0 + ai * HALF + m * 16);
#pragma unroll
                for (int bj = 0; bj < 2; ++bj) {
                    const u32x4 gw = *(const u32x4*)(Gt + row * 4096 + (SECOND ? 2048 : 0) + c0 + bj * HALF);
                    f32x4 g0, g1; unpack8(gw, g0, g1);
                    f32x4 v0 = acc[ai][bj][m][0] * g0, v1 = acc[ai][bj][m][1] * g1;
                    bf16* p = MG + row * 2048 + c0 + bj * HALF;
                    if (SECOND) { const u32x4 ow = *(const u32x4*)p; f32x4 o0, o1; unpack8(ow, o0, o1); v0 += o0; v1 += o1; }
                    *(u32x4*)p = pack8(v0, v1); } }
    }
};
struct EpiBranchRT {
    static constexpr bool PERM = true;
    bf16* MG; const bf16* Gt; unsigned char* MG8; float mul;
    __device__ __forceinline__ void operator()(const Acc& acc, const Unit& u, int wr, int wc, int fr, int fq) const {
        const int row0 = u.pm * BM + wr * 64 + fr; const int c0 = u.pn * BM + wc * 32 + 8 * fq; const bool second = u.ti != 0;
#pragma unroll
        for (int ai = 0; ai < 2; ++ai)
#pragma unroll
            for (int m = 0; m < 4; ++m) { const size_t row = (size_t)(row0 + ai * HALF + m * 16);
#pragma unroll
                for (int bj = 0; bj < 2; ++bj) {
                    const u32x2 gw = *(const u32x2*)((const unsigned char*)Gt + row * 4096 + (second ? 2048 : 0) + c0 + bj * HALF);
                    const f32x4 g0 = unpk4_unorm8(gw.x), g1 = unpk4_unorm8(gw.y);
                    f32x4 v0 = acc[ai][bj][m][0] * mul * g0, v1 = acc[ai][bj][m][1] * mul * g1;
                    bf16* p = MG + row * 2048 + c0 + bj * HALF;
                    if (second) { const u32x4 ow = *(const u32x4*)p; f32x4 o0, o1; unpack8(ow, o0, o1); v0 += o0; v1 += o1; }
                    if (second && MG8) { u32x2 w; w.x = pk4_fp8(v0[0], v0[1], v0[2], v0[3]); w.y = pk4_fp8(v1[0], v1[1], v1[2], v1[3]); *(u32x2*)(MG8 + row * 2048 + c0 + bj * HALF) = w; }
                    else *(u32x4*)p = pack8(v0, v1); } }
    }
};
struct EpiMerge {
    static constexpr bool PERM = true;
    bf16* MG; const unsigned char* G8; unsigned char* MG8; float mul;
    __device__ __forceinline__ void mid(Acc& acc, const Unit& u, int wr, int wc, int fr, int fq) const {
        const unsigned o0 = (unsigned)(u.pm * BM + wr * 64 + fr) * 4096u + (unsigned)(u.pn * BM + wc * 32 + 8 * fq);
#pragma unroll
        for (int am = 0; am < 4; ++am) { const int ai = am >> 1, m0 = (am & 1) * 2;
            u32x2 ga[2][2], gb[2][2];
#pragma unroll
            for (int mm = 0; mm < 2; ++mm) { const unsigned char* gp = G8 + (o0 + (unsigned)((ai * HALF + (m0 + mm) * 16) * 4096));
                ga[mm][0] = *(const u32x2*)(gp); gb[mm][0] = *(const u32x2*)(gp + 2048); ga[mm][1] = *(const u32x2*)(gp + HALF); gb[mm][1] = *(const u32x2*)(gp + 2048 + HALF); }
            __builtin_amdgcn_sched_barrier(0);
#pragma unroll
            for (int mm = 0; mm < 2; ++mm) { const int m = m0 + mm;
#pragma unroll
                for (int bj = 0; bj < 2; ++bj) { const u32x2 a = ga[mm][bj], b = gb[mm][bj];
                    const f32x4 g00 = unpk4_u8(a.x), g01 = unpk4_u8(a.y); f32x4 g10 = unpk4_u8(b.x), g11 = unpk4_u8(b.y);
#pragma unroll
                    for (int j = 0; j < 4; ++j) { acc[ai][bj][m][0][j] *= g00[j] * __builtin_amdgcn_rcpf(fmaxf(g10[j], 1.0f)); acc[ai][bj][m][1][j] *= g01[j] * __builtin_amdgcn_rcpf(fmaxf(g11[j], 1.0f)); } } }
            __builtin_amdgcn_sched_barrier(0);
        }
    }
    __device__ __forceinline__ void operator()(const Acc& acc, const Unit& u, int wr, int wc, int fr, int fq) const {
        const int row0 = u.pm * BM + wr * 64 + fr; const int c0 = u.pn * BM + wc * 32 + 8 * fq;
#pragma unroll
        for (int ai = 0; ai < 2; ++ai)
#pragma unroll
            for (int m = 0; m < 4; ++m) { const size_t row = (size_t)(row0 + ai * HALF + m * 16);
#pragma unroll
                for (int bj = 0; bj < 2; ++bj) { const u32x2 b = *(const u32x2*)(G8 + row * 4096 + 2048 + c0 + bj * HALF);
                    f32x4 g10 = unpk4_unorm8(b.x), g11 = unpk4_unorm8(b.y);
#pragma unroll
                    for (int j = 0; j < 4; ++j) { g10[j] = fmaxf(g10[j], 1.0f / 255.0f) * mul; g11[j] = fmaxf(g11[j], 1.0f / 255.0f) * mul; }
                    const f32x4 v0 = acc[ai][bj][m][0] * g10, v1 = acc[ai][bj][m][1] * g11;
                    if (MG8) { u32x2 w; w.x = pk4_fp8(v0[0], v0[1], v0[2], v0[3]); w.y = pk4_fp8(v1[0], v1[1], v1[2], v1[3]); *(u32x2*)(MG8 + row * 2048 + c0 + bj * HALF) = w; }
                    else *(u32x4*)(MG + row * 2048 + c0 + bj * HALF) = pack8(v0, v1); } }
    }
};
struct EpiOut {
    static constexpr bool PERM = true;
    bf16* DL; const float* gate; float mul;
    __device__ __forceinline__ void operator()(const Acc& acc, const Unit& u, int wr, int wc, int fr, int fq) const {
        const int row0 = u.pm * BM + wr * 64 + fr, c0 = u.pn * BM + wc * 32 + 8 * fq;
        const float* gp = gate + (size_t)(u.pm >> 3) * MODW + c0;
        f32x4 gv[2][2];
#pragma unroll
        for (int bj = 0; bj < 2; ++bj)
#pragma unroll
            for (int n = 0; n < 2; ++n) gv[bj][n] = *(const f32x4*)(gp + bj * HALF + 4 * n) * mul;
#pragma unroll
        for (int ai = 0; ai < 2; ++ai)
#pragma unroll
            for (int m = 0; m < 4; ++m) { bf16* rowp = DL + (size_t)(row0 + ai * HALF + m * 16) * DM + c0;
#pragma unroll
                for (int bj = 0; bj < 2; ++bj) *(u32x4*)(rowp + bj * HALF) = pack8(acc[ai][bj][m][0] * gv[bj][0], acc[ai][bj][m][1] * gv[bj][1]); }
    }
};
struct EpiSwiglu {
    static constexpr bool PERM = true;
    bf16* ACT;
    __device__ __forceinline__ void operator()(const Acc& acc, const Unit& u, int wr, int wc, int fr, int fq) const {
        const int row0 = u.pm * BM + wr * 64 + fr; const int c0 = u.pn * 128 + wc * 32 + 8 * fq;
#pragma unroll
        for (int ai = 0; ai < 2; ++ai)
#pragma unroll
            for (int m = 0; m < 4; ++m) { f32x4 v[2];
#pragma unroll
                for (int n = 0; n < 2; ++n)
#pragma unroll
                    for (int j = 0; j < 4; ++j) { const float a = acc[ai][0][m][n][j]; v[n][j] = a * sigmoidf_(a) * acc[ai][1][m][n][j]; }
                *(u32x4*)(ACT + (size_t)(row0 + ai * HALF + m * 16) * 1024 + c0) = pack8(v[0], v[1]); }
    }
};
struct EpiSwiglu8 {
    static constexpr bool PERM = true;
    unsigned char* ACT8;
    __device__ __forceinline__ void operator()(const Acc& acc, const Unit& u, int wr, int wc, int fr, int fq) const {
        const int row0 = u.pm * BM + wr * 64 + fr; const int c0 = u.pn * 128 + wc * 32 + 8 * fq;
#pragma unroll
        for (int ai = 0; ai < 2; ++ai)
#pragma unroll
            for (int m = 0; m < 4; ++m) { f32x4 v[2];
#pragma unroll
                for (int n = 0; n < 2; ++n)
#pragma unroll
                    for (int j = 0; j < 4; ++j) { const float a = acc[ai][0][m][n][j] * W8_INV; v[n][j] = a * sigmoidf_(a) * (acc[ai][1][m][n][j] * W8_INV); }
                u32x2 w; w.x = pk4_fp8(v[0][0], v[0][1], v[0][2], v[0][3]); w.y = pk4_fp8(v[1][0], v[1][1], v[1][2], v[1][3]);
                *(u32x2*)(ACT8 + (size_t)(row0 + ai * HALF + m * 16) * 1024 + c0) = w; }
    }
};
struct EpiDown {
    static constexpr bool PERM = true;
    bf16* YB; float mul;
    __device__ __forceinline__ void operator()(const Acc& acc, const Unit& u, int wr, int wc, int fr, int fq) const {
        const int row0 = u.pm * BM + wr * 64 + fr; const int c0 = u.pn * BM + wc * 32 + 8 * fq;
#pragma unroll
        for (int ai = 0; ai < 2; ++ai)
#pragma unroll
            for (int m = 0; m < 4; ++m) { bf16* rowp = YB + (size_t)(row0 + ai * HALF + m * 16) * 2048 + c0;
#pragma unroll
                for (int bj = 0; bj < 2; ++bj) { const f32x4 v0 = acc[ai][bj][m][0] * mul, v1 = acc[ai][bj][m][1] * mul;
                    if (YB_FP8) { u32x2 w; w.x = pk4_fp8(v0[0], v0[1], v0[2], v0[3]); w.y = pk4_fp8(v1[0], v1[1], v1[2], v1[3]); *(u32x2*)((unsigned char*)YB + (size_t)(row0 + ai * HALF + m * 16) * 2048 + c0 + bj * HALF) = w; }
                    else *(u32x4*)(rowp + bj * HALF) = pack8(v0, v1); } }
    }
};
}

struct Args { const float* in[20]; float* out; unsigned char* ws; int ph_lo, ph_hi; };
enum { I_X = 0, I_C, I_WADA, I_BADA, I_NMIX, I_NMOE, I_WIN, I_BF, I_WPOOL, I_PSCALE, I_WBR, I_WGATE, I_BGATE, I_WOUT, I_WROUTER, I_BROUTER, I_WEG, I_WEU, I_WED, I_NFINAL };

__device__ __forceinline__ const __attribute__((address_space(4))) char* kernarg_opaque() {
    const __attribute__((address_space(4))) char* kp = (const __attribute__((address_space(4))) char*)__builtin_amdgcn_kernarg_segment_ptr();
    asm volatile("" : "+s"(kp));
    return kp;
}
__device__ __forceinline__ const float* arg_in(int k) { return *(const float* const __attribute__((address_space(4)))*)(kernarg_opaque() + 8 * k); }
__device__ __forceinline__ int arg_i32(int byte_off) { return *(const int __attribute__((address_space(4)))*)(kernarg_opaque() + byte_off); }
#define ARG_IN(k) arg_in(k)
extern __shared__ __attribute__((aligned(16))) unsigned char lds_raw[];
struct Frame {
    LAS unsigned char* lds;
    int tid, lane, wave, vcu, G;
    float* out;
    unsigned char* ws;
};
__device__ __forceinline__ void frame_refresh(Frame& F) {
    F.lds = (LAS unsigned char*)lds_raw;
    F.tid = opaque_tid(); F.lane = F.tid & 63; F.wave = __builtin_amdgcn_readfirstlane(F.tid >> 6);
    F.G = gridDim.x; { const int bx = blockIdx.x; F.vcu = (F.G % 8 == 0) ? (bx % 8) * (F.G / 8) + bx / 8 : bx; }
    F.out = (float*)arg_in(20); F.ws = (unsigned char*)arg_in(21);
}

struct CvtItem { const float* src; bf16* dst; int srcStride, dstK, k0, n0, rowBase, mode, fp8; };
constexpr int CVT_PER_LAYER = 256 + 256 + 8 + 128 + 128 + 1024 + 1024 + 1024;
__device__ __forceinline__ CvtItem cvt_item(const Frame& F, int it) {
    const int l = it / CVT_PER_LAYER; int r = it % CVT_PER_LAYER;
    unsigned char* wl = F.ws + WS_W + (size_t)l * W_LAYER;
    CvtItem c; c.mode = 0; c.rowBase = 0; c.fp8 = 0;
    if (r < 256) { c.src = ARG_IN(I_WIN) + (size_t)l * DM * INW; c.srcStride = INW; c.dst = (bf16*)(wl + WO_PG); c.dstK = DM; c.k0 = 128 * (r >> 4); c.n0 = 256 * (r & 15); c.fp8 = (G1_FP8 == 2); return c; } r -= 256;
    if (r < 256) { c.src = ARG_IN(I_WGATE) + (size_t)l * DM * 4096; c.srcStride = 4096; c.dst = (bf16*)(wl + WO_PG + (G1_FP8 == 1 ? 16 * MiB : 0)); c.dstK = DM; c.k0 = 128 * (r >> 4); c.n0 = 256 * (r & 15); c.rowBase = (G1_FP8 == 1 ? 0 : 4096); c.fp8 = (G1_FP8 >= 1); return c; } r -= 256;
    if (r < 8) { const int g = r >> 1; c.src = ARG_IN(I_WPOOL) + ((size_t)l * 4 + g) * 65536; c.srcStride = 256; c.dst = (bf16*)(wl + WO_POOL) + (size_t)g * 65536; c.dstK = 256; c.k0 = 128 * (r & 1); c.n0 = 0; return c; } r -= 8;
    if (r < 128) { const int n = r >> 6, q = r & 63; c.src = ARG_IN(I_WBR) + ((size_t)l * 2 + n) * 1024 * 2048; c.srcStride = 2048; c.dst = G2_FP8 ? (bf16*)(wl + WO_BR + (size_t)n * 2048 * 1024) : (bf16*)(wl + WO_BR) + (size_t)n * 2048 * 1024; c.dstK = 1024; c.fp8 = G2_FP8; c.k0 = 128 * (q >> 3); c.n0 = 256 * (q & 7); return c; } r -= 128;
    if (r < 128) { c.src = ARG_IN(I_WOUT) + (size_t)l * DM * DM; c.srcStride = DM; c.dst = (bf16*)(wl + WO_OUT); c.dstK = DM; c.k0 = 128 * (r >> 3); c.n0 = 256 * (r & 7); c.fp8 = G3_FP8; return c; } r -= 128;
    if (r < 2048) { const int up = r >= 1024; if (up) r -= 1024; const int e = r >> 6, q = r & 63;
        c.src = (up ? ARG_IN(I_WEU) : ARG_IN(I_WEG)) + ((size_t)l * NE + e) * DM * DE; c.srcStride = DE; c.dst = MOE_FP8 ? (bf16*)(wl + WO_GU + (size_t)e * 2048 * 2048) : (bf16*)(wl + WO_GU) + (size_t)e * 2048 * 2048; c.dstK = DM; c.fp8 = MOE_FP8; c.k0 = 128 * (q >> 2); c.n0 = 256 * (q & 3); c.mode = up ? 2 : 1; return c; } r -= 2048;
    { const int e = r >> 6, q = r & 63; c.src = ARG_IN(I_WED) + ((size_t)l * NE + e) * DE * DM; c.srcStride = DM; c.dst = MOE_FP8 ? (bf16*)(wl + WO_D + (size_t)e * 2048 * 1024) : (bf16*)(wl + WO_D) + (size_t)e * 2048 * 1024; c.dstK = DE; c.fp8 = MOE_FP8; c.k0 = 128 * (q >> 3); c.n0 = 256 * (q & 7); return c; }
}
__device__ __forceinline__ void cvt_load(const CvtItem& c, int wave, int lane, f32x4 (&v)[16]) {
    const float* p = c.src + (size_t)(c.k0 + wave * 16) * c.srcStride + c.n0 + 4 * lane;
#pragma unroll
    for (int j = 0; j < 16; ++j) v[j] = __builtin_nontemporal_load((const f32x4*)(p + (size_t)j * c.srcStride));
}
__device__ __forceinline__ void p0_mod_task(Frame& F, int q, const LAS float* cact) {
    const int ks = q & 3, cgq = q >> 2, l = cgq / 192, col0 = (cgq % 192) * 64, kq = F.lane >> 4, cl = (F.lane & 15) * 4;
    const int kbase = ks * 512;
    const float* wp = ARG_IN(I_WADA) + ((size_t)l * DM + kbase + kq) * MODW + col0 + cl;
    f32x4 acc[8];
#pragma unroll
    for (int b = 0; b < 8; ++b) acc[b] = (f32x4){0.f, 0.f, 0.f, 0.f};
    for (int i0 = 0; i0 < 128; i0 += 8) {
        f32x4 w[8];
#pragma unroll
        for (int j = 0; j < 8; ++j) w[j] = __builtin_nontemporal_load((const f32x4*)(wp + (size_t)(4 * (i0 + j)) * MODW));
#pragma unroll
        for (int j = 0; j < 8; ++j) { const int k = kbase + 4 * (i0 + j) + kq; const f32x4 c0 = *(const LAS f32x4*)(cact + k * 8), c1 = *(const LAS f32x4*)(cact + k * 8 + 4);
#pragma unroll
            for (int b = 0; b < 4; ++b) { acc[b] += c0[b] * w[j]; acc[4 + b] += c1[b] * w[j]; } }
    }
#pragma unroll
    for (int b = 0; b < 8; ++b)
#pragma unroll
        for (int j = 0; j < 4; ++j) { float v = acc[b][j]; v += __shfl_xor(v, 16); v += __shfl_xor(v, 32); acc[b][j] = v; }
    if (kq == 0) {
        f32x4 bv = (f32x4){0.f, 0.f, 0.f, 0.f};
        if (ks == 0) bv = *(const f32x4*)(ARG_IN(I_BADA) + (size_t)l * MODW + col0 + cl);
        float* mp = (float*)(F.ws + WS_MODP) + ((size_t)ks * 2 + l) * 8 * MODW + col0 + cl;
#pragma unroll
        for (int b = 0; b < 8; ++b) *(f32x4*)(mp + (size_t)b * MODW) = acc[b] + bv;
    }
}
__device__ __forceinline__ f32x4 modp_sum(const float* modp, size_t idx) {
    constexpr size_t Q = (size_t)2 * 8 * MODW;
    const f32x4 a = *(const f32x4*)(modp + idx), b = *(const f32x4*)(modp + Q + idx), c = *(const f32x4*)(modp + 2 * Q + idx), d = *(const f32x4*)(modp + 3 * Q + idx);
    return ((a + b) + c) + d;
}
__device__ __forceinline__ void cvt_to_lds(const CvtItem& c, const f32x4 (&v)[16], LAS unsigned char* tile, int wave, int lane) {
    if (c.fp8) {
#pragma unroll
        for (int i = 0; i < 4; ++i) { u32x4 w;
            w.x = pk4_fp8(v[0][i] * W8_SCALE, v[1][i] * W8_SCALE, v[2][i] * W8_SCALE, v[3][i] * W8_SCALE); w.y = pk4_fp8(v[4][i] * W8_SCALE, v[5][i] * W8_SCALE, v[6][i] * W8_SCALE, v[7][i] * W8_SCALE);
            w.z = pk4_fp8(v[8][i] * W8_SCALE, v[9][i] * W8_SCALE, v[10][i] * W8_SCALE, v[11][i] * W8_SCALE); w.w = pk4_fp8(v[12][i] * W8_SCALE, v[13][i] * W8_SCALE, v[14][i] * W8_SCALE, v[15][i] * W8_SCALE);
            *(LAS u32x4*)(tile + (4 * lane + i) * 144 + wave * 16) = w; }
    } else {
#pragma unroll
        for (int i = 0; i < 4; ++i)
#pragma unroll
            for (int o = 0; o < 2; ++o) { u32x4 w; w.x = cvt_pk_bf16(v[8 * o + 0][i], v[8 * o + 1][i]); w.y = cvt_pk_bf16(v[8 * o + 2][i], v[8 * o + 3][i]); w.z = cvt_pk_bf16(v[8 * o + 4][i], v[8 * o + 5][i]); w.w = cvt_pk_bf16(v[8 * o + 6][i], v[8 * o + 7][i]);
                *(LAS u32x4*)(tile + (4 * lane + i) * 272 + (wave * 16 + 8 * o) * 2) = w; }
    }
}
__device__ __forceinline__ void cvt_store(const CvtItem& cc, const LAS unsigned char* tile, int tid) {
    if (cc.fp8) {
#pragma unroll
        for (int qq = 0; qq < 4; ++qq) { const int ch = tid + 512 * qq, nn = ch >> 3, c16 = ch & 7; const int n = cc.n0 + nn;
            const int drow = cc.mode == 0 ? cc.rowBase + n : 256 * (n >> 7) + (n & 127) + (cc.mode == 2 ? 128 : 0);
            const u32x4 w = *(const LAS u32x4*)(tile + nn * 144 + c16 * 16);
            *(u32x4*)((unsigned char*)cc.dst + (size_t)drow * cc.dstK + cc.k0 + c16 * 16) = w; }
    } else {
#pragma unroll
        for (int qq = 0; qq < 8; ++qq) { const int ch = tid + 512 * qq, nn = ch >> 4, c16 = ch & 15; const int n = cc.n0 + nn;
            const int drow = cc.mode == 0 ? cc.rowBase + n : 256 * (n >> 7) + (n & 127) + (cc.mode == 2 ? 128 : 0);
            const u32x4 w = *(const LAS u32x4*)(tile + nn * 272 + c16 * 16);
            *(u32x4*)(cc.dst + (size_t)drow * cc.dstK + cc.k0 + c16 * 8) = w; }
    }
}
#ifndef Q_A
#define Q_A 1344
#endif
#ifndef Q_1
#define Q_1 768
#endif
constexpr int Q_B = 1024, Q_COUNT = Q_A + Q_B, Q_FIRST = 2 * CVT_PER_LAYER - Q_COUNT, CW_QUEUE = 12800;
__device__ __forceinline__ void cvt_queue_drain(Frame& F, int which, int first, int count) {
    LAS unsigned char* tile = F.lds;
    volatile LAS int* slot = (volatile LAS int*)(F.lds + X_MISC) + 60;
    unsigned* q = (unsigned*)(F.ws + WS_CTL) + CW_QUEUE + 64 * which;
    __syncthreads();
    int t_next = 0;
    if (F.tid == 0) { const int ta = (int)__hip_atomic_fetch_add(q, 1u, __ATOMIC_RELAXED, __HIP_MEMORY_SCOPE_AGENT); t_next = (int)__hip_atomic_fetch_add(q, 1u, __ATOMIC_RELAXED, __HIP_MEMORY_SCOPE_AGENT); slot[0] = ta < count ? ta : -1; }
    __syncthreads();
    int qi = __builtin_amdgcn_readfirstlane(slot[0]);
    f32x4 v[16];
    CvtItem c = cvt_item(F, first + (qi >= 0 ? qi : 0));
    if (qi >= 0) cvt_load(c, F.wave, F.lane, v);
    while (qi >= 0) {
        if (F.tid == 0) { slot[0] = t_next < count ? t_next : -1; t_next = (int)__hip_atomic_fetch_add(q, 1u, __ATOMIC_RELAXED, __HIP_MEMORY_SCOPE_AGENT); }
        cvt_to_lds(c, v, tile, F.wave, F.lane);
        __syncthreads();
        const CvtItem cc = c;
        const int nq = __builtin_amdgcn_readfirstlane(slot[0]);
        if (nq >= 0) { c = cvt_item(F, first + nq); cvt_load(c, F.wave, F.lane, v); }
        cvt_store(cc, tile, F.tid);
        __syncthreads();
        qi = nq;
    }
}
__device__ __forceinline__ void p0_prologue(Frame& F) {
    LAS float* cact = (LAS float*)(F.lds);
    LAS unsigned char* tile = F.lds + 65536;
    {   const float* cin = ARG_IN(I_C);
#pragma unroll
        for (int h = 0; h < 2; ++h) { float cv[16];
#pragma unroll
            for (int k = 0; k < 16; ++k) cv[k] = cin[F.tid + (h * 16 + k) * NTHREADS];
            __builtin_amdgcn_sched_barrier(0);
#pragma unroll
            for (int k = 0; k < 16; ++k) { const int i = F.tid + (h * 16 + k) * NTHREADS, b = i / DM, kk = i % DM; cact[kk * 8 + b] = cv[k] * sigmoidf_(cv[k]); }
            __builtin_amdgcn_sched_barrier(0); } }
    __syncthreads();
    { const int q = F.wave * F.G + F.vcu; if (q < 1536) p0_mod_task(F, q, cact); }
    constexpr int NITEMS = Q_FIRST;
    int it = F.vcu;
    f32x4 v[16];
    CvtItem c = cvt_item(F, it < NITEMS ? it : 0);
    if (it < NITEMS) cvt_load(c, F.wave, F.lane, v);
    while (it < NITEMS) {
        cvt_to_lds(c, v, tile, F.wave, F.lane);
        __syncthreads();
        const CvtItem cc = c;
        const int nit = it + F.G;
        if (nit < NITEMS) { c = cvt_item(F, nit); cvt_load(c, F.wave, F.lane, v); }
        cvt_store(cc, tile, F.tid);
        __syncthreads();
        it = nit;
    }
}

__device__ __forceinline__ void load_expert_tables(Frame& F, int lc) {
    volatile LAS int* misc = (volatile LAS int*)(F.lds + X_MISC);
    if (F.tid < 16) {
        const int c = (int)__hip_atomic_load((unsigned*)(F.ws + WS_CTL) + CW_CNT + (lc * 16 + F.tid) * 64, RLX_AGENT);
        misc[32 + F.tid] = c;
        const int v = (c + 255) >> 8; int incl = v;
#pragma unroll
        for (int o = 1; o < 16; o <<= 1) { const int nb = __shfl_up(incl, o); if (F.tid >= o) incl += nb; }
        misc[8 + F.tid] = incl - v;
        if (F.tid == 15) misc[24] = incl;
    }
    __syncthreads();
}
template <int MODE, bool COMBINE, bool DRY = false>
__device__ __forceinline__ void rows_phase(Frame& F, int l, bool prefilled = false) {
    const int lane = F.lane;
    float* out = F.out;
    const bool xf32 = (MODE == 0 && !COMBINE) || (MODE == 1 && l == 0);
    const float* xin = ARG_IN(I_X); bf16* XB = (bf16*)(F.ws + WS_XB);
    const float* mod = (const float*)(F.ws + WS_MOD);
    bf16* H = (bf16*)(F.ws + WS_H);
    const int lprev = (MODE == 2) ? DEPTH - 1 : l - 1;
    if (COMBINE) load_expert_tables(F, lprev);
    volatile LAS int* misc = (volatile LAS int*)(F.lds + X_MISC);
    if (MODE == 0 && !prefilled) {
        LAS f32x4* wf = (LAS f32x4*)F.lds; const float* src = ARG_IN(I_WIN) + (size_t)l * DM * INW + 4096;
#pragma unroll 8
        for (int i = F.tid; i < DM * 2; i += NTHREADS) { const int c = i >> 1, g = i & 1; wf[((g * 4 + (c & 3)) * 8 + (c >> 8)) * 64 + ((c >> 2) & 63)] = *(const f32x4*)(src + (size_t)c * INW + g * 4); }
    }
    if (MODE == 1 && !prefilled) {
        LAS f32x4* wr = (LAS f32x4*)F.lds; const f32x4* src = (const f32x4*)ARG_IN(I_WROUTER);
        f32x4 tv[16];
#pragma unroll
        for (int k = 0; k < 16; ++k) tv[k] = src[F.tid + k * NTHREADS];
        __builtin_amdgcn_sched_barrier(0);
#pragma unroll
        for (int k = 0; k < 16; ++k) { const int i = F.tid + k * NTHREADS, c = i >> 2, g = i & 3; wr[((g * 4 + (c & 3)) * 8 + (c >> 8)) * 64 + ((c >> 2) & 63)] = tv[k]; }
    }
    __syncthreads();
    const int ntask = T / 8;
    constexpr bool FIRST = (MODE == 0 && !COMBINE);
    const float* modp = (const float*)(F.ws + WS_MODP);
    if (FIRST) {
        for (int wt = F.vcu * NWAVES + F.wave; wt < 2048; wt += F.G * NWAVES)
            if (lane < 24) { const size_t idx = (size_t)wt * 96 + 4 * lane; *(f32x4*)((float*)(F.ws + WS_MOD) + idx) = modp_sum(modp, idx); }
    }
    for (int wt = F.vcu * NWAVES + F.wave; wt < ntask; wt += F.G * NWAVES) {
        const int row0 = wt * 8, b = row0 / SEQ;
        f32x4 A[8], Sh[8], Gm[8];
        {
            const float* nrm = (MODE == 0) ? ARG_IN(I_NMIX) + (size_t)l * DM : (MODE == 1) ? ARG_IN(I_NMOE) + (size_t)l * DM : ARG_IN(I_NFINAL);
            const float* mb = mod + ((size_t)(MODE == 2 ? 0 : l) * 8 + b) * MODW;
#pragma unroll
            for (int j = 0; j < 8; ++j) { const int c = 256 * j + 4 * lane; const f32x4 g = *(const f32x4*)(nrm + c);
                if (MODE == 2) { A[j] = g; Sh[j] = (f32x4){0.f, 0.f, 0.f, 0.f}; }
                else if (FIRST) { const size_t mi = (size_t)b * MODW + c; const f32x4 sc = modp_sum(modp, mi + DM); Sh[j] = modp_sum(modp, mi); A[j] = g * (1.0f + sc); }
                else { const f32x4 sc = *(const f32x4*)(mb + (MODE == 0 ? 1 : 4) * DM + c); Sh[j] = *(const f32x4*)(mb + (MODE == 0 ? 0 : 3) * DM + c); A[j] = g * (1.0f + sc); }
                if (COMBINE) Gm[j] = *(const f32x4*)(mod + ((size_t)lprev * 8 + b) * MODW + 5 * DM + c); }
        }
        int te_l = 0, tp_l = 0; float tw_l = 0.f;
        if (COMBINE) { if (lane < 16) { te_l = ((const int*)(F.ws + WS_TOKE))[row0 * 2 + lane]; tw_l = ((const float*)(F.ws + WS_TOKW))[row0 * 2 + lane]; tp_l = ((const int*)(F.ws + WS_TOKP))[row0 * 2 + lane]; } }
        for (int r = 0; r < 8; ++r) {
            const int row = row0 + r;
            f32x4 x[8];
#pragma unroll
            for (int j = 0; j < 8; ++j) {
                if (xf32) x[j] = __builtin_nontemporal_load((const f32x4*)(xin + (size_t)row * DM + 256 * j + 4 * lane));
                else { const u32x2 p = __builtin_nontemporal_load((const u32x2*)(XB + (size_t)row * DM + 256 * j + 4 * lane)); x[j] = (f32x4){bf_lo(p.x), bf_hi(p.x), bf_lo(p.y), bf_hi(p.y)}; } }
            if (COMBINE) {
                const int e0 = __builtin_amdgcn_readlane(te_l, 2 * r), e1 = __builtin_amdgcn_readlane(te_l, 2 * r + 1);
                const float w0 = __int_as_float(__builtin_amdgcn_readlane(__float_as_int(tw_l), 2 * r)), w1 = __int_as_float(__builtin_amdgcn_readlane(__float_as_int(tw_l), 2 * r + 1));
                const size_t s0 = (size_t)misc[8 + e0] * 256 + __builtin_amdgcn_readlane(tp_l, 2 * r), s1 = (size_t)misc[8 + e1] * 256 + __builtin_amdgcn_readlane(tp_l, 2 * r + 1);
                const bf16* y0p = (const bf16*)(F.ws + WS_YB) + s0 * 2048; const bf16* y1p = (const bf16*)(F.ws + WS_YB) + s1 * 2048;
                unsigned yq0[8], yq1[8];
                if (YB_FP8) {
#pragma unroll
                    for (int j = 0; j < 8; ++j) { yq0[j] = __builtin_nontemporal_load((const unsigned*)((const unsigned char*)(F.ws + WS_YB) + s0 * 2048 + 256 * j + 4 * lane)); yq1[j] = __builtin_nontemporal_load((const unsigned*)((const unsigned char*)(F.ws + WS_YB) + s1 * 2048 + 256 * j + 4 * lane)); }
                    __builtin_amdgcn_sched_barrier(0);
                }
#pragma unroll
                for (int j = 0; j < 8; ++j) { f32x4 y0, y1;
                    if (YB_FP8) { y0 = unpk4_fp8(yq0[j]); y1 = unpk4_fp8(yq1[j]); }
                    else { const u32x2 p0 = *(const u32x2*)(y0p + 256 * j + 4 * lane), p1 = *(const u32x2*)(y1p + 256 * j + 4 * lane);
                        y0 = (f32x4){bf_lo(p0.x), bf_hi(p0.x), bf_lo(p0.y), bf_hi(p0.y)}; y1 = (f32x4){bf_lo(p1.x), bf_hi(p1.x), bf_lo(p1.y), bf_hi(p1.y)}; }
                    x[j] += Gm[j] * (w0 * y0 + w1 * y1); }
                if (MODE != 2) {
#pragma unroll
                    for (int j = 0; j < 8; ++j) { u32x2 w; w.x = cvt_pk_bf16(x[j].x, x[j].y); w.y = cvt_pk_bf16(x[j].z, x[j].w); *(u32x2*)(XB + (size_t)row * DM + 256 * j + 4 * lane) = w; }
                }
            }
            if (MODE == 1) {
                const bf16* dl = (const bf16*)(F.ws + WS_DL) + (size_t)row * DM;
#pragma unroll
                for (int j = 0; j < 8; ++j) { const u32x2 p = __builtin_nontemporal_load((const u32x2*)(dl + 256 * j + 4 * lane)); x[j] += (f32x4){bf_lo(p.x), bf_hi(p.x), bf_lo(p.y), bf_hi(p.y)}; }
#pragma unroll
                for (int j = 0; j < 8; ++j) { u32x2 w; w.x = cvt_pk_bf16(x[j].x, x[j].y); w.y = cvt_pk_bf16(x[j].z, x[j].w); *(u32x2*)(XB + (size_t)row * DM + 256 * j + 4 * lane) = w; }
            }
            float ss = 0.f;
#pragma unroll
            for (int j = 0; j < 8; ++j) ss += (x[j].x * x[j].x + x[j].y * x[j].y) + (x[j].z * x[j].z + x[j].w * x[j].w);
            const float rstd = 1.0f / sqrtf(wave_sum_u(ss) * (1.0f / DM) + EPS);
#pragma unroll
            for (int j = 0; j < 8; ++j) x[j] = x[j] * rstd * A[j] + Sh[j];
            if (MODE == 2) {
#pragma unroll
                for (int j = 0; j < 8; ++j) __builtin_nontemporal_store(x[j], (f32x4*)(out + (size_t)row * DM + 256 * j + 4 * lane));
                continue;
            }
#pragma unroll
            for (int j = 0; j < 8; ++j) {
                constexpr bool W8 = (MODE == 1 && MOE_FP8) || (MODE == 0 && G1_FP8 >= 1), W16 = (MODE == 1 && !MOE_FP8) || (MODE == 0 && G1_FP8 != 2);
                if (W8) *(unsigned*)(F.ws + WS_H8 + (size_t)row * DM + 256 * j + 4 * lane) = pk4_fp8(x[j].x, x[j].y, x[j].z, x[j].w);
                if (W16) { u32x2 w; w.x = cvt_pk_bf16(x[j].x, x[j].y); w.y = cvt_pk_bf16(x[j].z, x[j].w); *(u32x2*)(H + (size_t)row * DM + 256 * j + 4 * lane) = w; } }
            if (MODE == 0) {
                const LAS float* wf = (const LAS float*)F.lds;
                float fl[8];
#pragma unroll
                for (int q = 0; q < 8; ++q) fl[q] = 0.f;
#pragma unroll
                for (int j = 0; j < 8; ++j)
#pragma unroll
                    for (int i = 0; i < 4; ++i) { const f32x4 w0 = *((const LAS f32x4*)wf + ((0 * 4 + i) * 8 + j) * 64 + lane), w1 = *((const LAS f32x4*)wf + ((1 * 4 + i) * 8 + j) * 64 + lane); const float xv = x[j][i];
#pragma unroll
                        for (int q = 0; q < 4; ++q) { fl[q] += xv * w0[q]; fl[4 + q] += xv * w1[q]; }
                        if (i == 3) asm volatile("" ::: "memory"); }
#pragma unroll
                for (int q = 0; q < 8; ++q) fl[q] = wave_sum_u(fl[q]);
                if (lane < 8) { float z = 0.f;
#pragma unroll
                    for (int q = 0; q < 8; ++q) z = (lane == q) ? fl[q] : z;
                    z += ARG_IN(I_BF)[l * 8 + lane];
                    const float ls = fminf(z, 0.f) - log1pf(expf(-fabsf(z)));
                    ((float*)(F.ws + WS_LS))[(size_t)row * 8 + lane] = ls; }
            }
            if (MODE == 1) {
                const LAS float* wr = (const LAS float*)F.lds;
                float lg[16];
#pragma unroll
                for (int q = 0; q < 16; ++q) lg[q] = 0.f;
#pragma unroll
                for (int j = 0; j < 8; ++j)
#pragma unroll
                    for (int i = 0; i < 4; ++i) { const float xv = x[j][i];
#pragma unroll
                        for (int q4 = 0; q4 < 4; ++q4) { const f32x4 w = *((const LAS f32x4*)wr + ((q4 * 4 + i) * 8 + j) * 64 + lane);
#pragma unroll
                            for (int q = 0; q < 4; ++q) lg[4 * q4 + q] += xv * w[q]; }
                        if (i == 3) asm volatile("" ::: "memory"); }
#pragma unroll
                for (int q = 0; q < 16; ++q) lg[q] = wave_sum_u(lg[q]);
                float mx = lg[0];
#pragma unroll
                for (int q = 1; q < 16; ++q) mx = fmaxf(mx, lg[q]);
                float pr[16], se = 0.f;
#pragma unroll
                for (int q = 0; q < 16; ++q) { pr[q] = expf(lg[q] - mx); se += pr[q]; }
                const float inv = 1.0f / se;
                float sel[16];
#pragma unroll
                for (int q = 0; q < 16; ++q) { pr[q] *= inv; sel[q] = pr[q] + ARG_IN(I_BROUTER)[q]; }
                float bestS = -3.0e38f; int be0 = 0, be1 = 1;
#pragma unroll
                for (int g = 0; g < 4; ++g) {
                    float v1 = sel[4 * g]; int i1 = 0;
#pragma unroll
                    for (int i = 1; i < 4; ++i) if (sel[4 * g + i] > v1) { v1 = sel[4 * g + i]; i1 = i; }
                    float v2 = -3.0e38f; int i2 = 0;
#pragma unroll
                    for (int i = 0; i < 4; ++i) if (i != i1 && sel[4 * g + i] > v2) { v2 = sel[4 * g + i]; i2 = i; }
                    const float sc = v1 + v2;
                    if (sc > bestS) { bestS = sc; be0 = 4 * g + i1; be1 = 4 * g + i2; }
                }
                float p0 = 0.f, p1 = 0.f;
#pragma unroll
                for (int q = 0; q < 16; ++q) { p0 = (q == be0) ? pr[q] : p0; p1 = (q == be1) ? pr[q] : p1; }
                const float gs = 1.0f / (p0 + p1);
                if (lane == 0) {
                    int* te = (int*)(F.ws + WS_TOKE) + row * 2; float* tw = (float*)(F.ws + WS_TOKW) + row * 2;
                    te[0] = be0; te[1] = be1; tw[0] = p0 * gs; tw[1] = p1 * gs;
                    volatile LAS int* asg = (volatile LAS int*)(F.lds + X_ASG);
                    asg[(F.wave * 8 + r) * 2] = be0; asg[(F.wave * 8 + r) * 2 + 1] = be1;
                }
            }
        }
        if (MODE == 1) {
            __syncthreads();
            if (!DRY) {
                volatile LAS int* asg = (volatile LAS int*)(F.lds + X_ASG);
                const int a0 = asg[lane], a1 = asg[64 + lane];
                const int eA = F.wave * 2, eB = eA + 1;
                const unsigned long long mA0 = __ballot(a0 == eA), mA1 = __ballot(a1 == eA), mB0 = __ballot(a0 == eB), mB1 = __ballot(a1 == eB);
                const int nA0 = __popcll(mA0), nA = nA0 + __popcll(mA1), nB0 = __popcll(mB0), nB = nB0 + __popcll(mB1);
                unsigned base_l = 0u;
                if (lane < 2) { const int nn = lane ? nB : nA; if (nn) base_l = __hip_atomic_fetch_add((unsigned*)(F.ws + WS_CTL) + CW_CNT + (l * 16 + eA + lane) * 64, (unsigned)nn, RLX_AGENT); }
                const unsigned baseA = (unsigned)__builtin_amdgcn_readlane((int)base_l, 0), baseB = (unsigned)__builtin_amdgcn_readlane((int)base_l, 1);
                const unsigned long long lt = (1ull << lane) - 1ull;
                const int blk_row0 = (wt - F.wave) * 8;
                int* list = (int*)(F.ws + WS_LIST); int* tp = (int*)(F.ws + WS_TOKP);
                if (a0 == eA || a0 == eB) { const bool isA = a0 == eA; const unsigned slot = isA ? baseA + (unsigned)__popcll(mA0 & lt) : baseB + (unsigned)__popcll(mB0 & lt);
                    const int row = blk_row0 + (lane >> 1); list[(isA ? eA : eB) * LIST_CAP + slot] = row; tp[row * 2 + (lane & 1)] = (int)slot; }
                if (a1 == eA || a1 == eB) { const bool isA = a1 == eA; const unsigned slot = isA ? baseA + (unsigned)nA0 + (unsigned)__popcll(mA1 & lt) : baseB + (unsigned)nB0 + (unsigned)__popcll(mB1 & lt);
                    const int row = blk_row0 + 32 + (lane >> 1); list[(isA ? eA : eB) * LIST_CAP + slot] = row; tp[row * 2 + (lane & 1)] = (int)slot; }
            }
            __syncthreads();
        }
    }
}

template <int W>
__device__ __forceinline__ void pool_tile_w(Frame& F, int pm, int g, int half) {
    const bf16* U = (const bf16*)(F.ws + WS_U); bf16* PL = (bf16*)(F.ws + WS_PL);
    const int cc = F.tid & 31, rg = F.tid >> 5;
    const int col = g * 256 + cc * 8 + half * 4;
    const int r0 = pm * 256 + rg * 16, t0 = r0 % SEQ;
    u32x2 cur[16], prv[W - 1];
#pragma unroll
    for (int r = 0; r < 16; ++r) cur[r] = *(const u32x2*)(U + (size_t)(r0 + r) * 1024 + col);
#pragma unroll
    for (int j = 1; j < W; ++j) { const bool ok = t0 - j >= 0; const u32x2 v = *(const u32x2*)(U + (size_t)(ok ? r0 - j : r0) * 1024 + col); prv[j - 1] = ok ? v : (u32x2){0u, 0u}; }
    __builtin_amdgcn_sched_barrier(0);
    f32x4 s = {0.f, 0.f, 0.f, 0.f};
#pragma unroll
    for (int j = 1; j < W; ++j) s += (f32x4){bf_lo(prv[j - 1].x), bf_hi(prv[j - 1].x), bf_lo(prv[j - 1].y), bf_hi(prv[j - 1].y)};
#pragma unroll
    for (int r = 0; r < 16; ++r) {
        const int t = t0 + r; const f32x4 a = {bf_lo(cur[r].x), bf_hi(cur[r].x), bf_lo(cur[r].y), bf_hi(cur[r].y)};
        s += a;
        const float inv = 1.0f / (float)(t + 1 < W ? t + 1 : W);
        const f32x4 o = s * inv - a;
        u32x2 w; w.x = cvt_pk_bf16(o[0], o[1]); w.y = cvt_pk_bf16(o[2], o[3]);
        *(u32x2*)(PL + (size_t)(r0 + r) * 1024 + col) = w;
        {
            const u32x2 q = r - W + 1 >= 0 ? cur[r - W + 1 >= 0 ? r - W + 1 : 0] : prv[r - W + 1 >= 0 ? 0 : W - 2 - r];
            s -= (f32x4){bf_lo(q.x), bf_hi(q.x), bf_lo(q.y), bf_hi(q.y)}; }
    }
}
__device__ __forceinline__ void pool_tile(Frame& F, int pm, int g) {
    if (g == 0) { pool_tile_w<2>(F, pm, g, 0); pool_tile_w<2>(F, pm, g, 1); }
    else if (g == 1) { pool_tile_w<4>(F, pm, g, 0); pool_tile_w<4>(F, pm, g, 1); }
    else if (g == 2) { pool_tile_w<8>(F, pm, g, 0); pool_tile_w<8>(F, pm, g, 1); }
    else { pool_tile_w<16>(F, pm, g, 0); pool_tile_w<16>(F, pm, g, 1); }
}

__device__ __forceinline__ void forget_cumsum(Frame& F, int b, int h, LAS float* Fl, LAS float* tmp, const float L2E) {
    const float* LS = (const float*)(F.ws + WS_LS) + (size_t)b * SEQ * 8 + h;
    const int t4 = F.tid * 4;
    float v0 = LS[(size_t)(t4 + 0) * 8], v1 = LS[(size_t)(t4 + 1) * 8], v2 = LS[(size_t)(t4 + 2) * 8], v3 = LS[(size_t)(t4 + 3) * 8];
    v1 += v0; v2 += v1; v3 += v2;
    float tot = v3;
#pragma unroll
    for (int o = 1; o < 64; o <<= 1) { const float n = __shfl_up(tot, o); if (F.lane >= o) tot += n; }
    if (F.lane == 63) tmp[F.wave] = tot;
    __syncthreads();
    float off = 0.f;
    for (int w = 0; w < F.wave; ++w) off += tmp[w];
    const float base = off + tot - v3;
    *(LAS f32x4*)(Fl + t4) = (f32x4){(base + v0) * L2E, (base + v1) * L2E, (base + v2) * L2E, (base + v3) * L2E};
    __syncthreads();
}

#if ATTN_FAST
namespace att {
constexpr int D = 128, LD = 1024, NW = 8, QBLK = 32, KVBLK = 64, QB = NW * QBLK;
constexpr int SHM_V = KVBLK * D * 2, SHM_K = KVBLK * D * 2;
constexpr int OFF_WS = 2 * SHM_V + 2 * SHM_K;
constexpr int OFF_FN = OFF_WS + NW * 64 * 4;
constexpr int OFF_TMP = OFF_FN + 2048 * 4;
constexpr float SCALE = 0.08838834764831845f, C2 = 1.4426950408889634f * SCALE, THR = 8.f;
typedef short s16x4 __attribute__((ext_vector_type(4)));
typedef float f32x16 __attribute__((ext_vector_type(16)));
#define KSWZ(row, colB) ((row) * 256 + ((colB) ^ (((row) & 7) << 4)))
#define SBAR() __builtin_amdgcn_sched_barrier(0)
__device__ __forceinline__ int v_st(int k, int c) { const int kk = (k & ~0xC) | ((k & 4) << 1) | ((k & 8) >> 1); return ((kk >> 3) * 4 + (c >> 5)) * 512 + ((kk & 7) * 32 + (c & 31)) * 2; }
__device__ __forceinline__ int v_rd_base(int lane) { return ((lane & 3) << 3) | (((lane >> 2) & 3) << 6) | (((lane >> 4) & 1) << 5) | (((lane >> 5) & 1) << 8); }
constexpr int v_rd_off(int d0, int ks, int half) { return d0 * 512 + ks * 4096 + half * 2048; }
__device__ __forceinline__ int crow(int r, int hi) { return (r & 3) + 8 * (r >> 2) + 4 * hi; }
__device__ __forceinline__ unsigned cvtpk(float lo, float hi) { return cvt_pk_bf16(lo, hi); }
__device__ __forceinline__ bf16x8 load8(const bf16* p) { return *reinterpret_cast<const bf16x8*>(p); }
__device__ __forceinline__ void mask_tile(f32x16& p0, f32x16& p1, int dq) {
    const float NEG = -__builtin_inff();
#pragma unroll
    for (int r = 0; r < 16; ++r) { const int c = (r & 3) + 8 * (r >> 2); if (dq - c < 0) p0[r] = NEG; if (dq - c - 32 < 0) p1[r] = NEG; }
}
__device__ __forceinline__ void partialSM(f32x16& p0, f32x16& p1, float& m_reg, float& mn, float& alpha) {
    float pmax = p0[0]; for (int r = 1; r < 16; ++r) pmax = fmaxf(pmax, p0[r]); for (int r = 0; r < 16; ++r) pmax = fmaxf(pmax, p1[r]);
    { auto rr = __builtin_amdgcn_permlane32_swap(__float_as_uint(pmax), __float_as_uint(pmax), false, false);
      pmax = fmaxf(__uint_as_float(rr[0]), __uint_as_float(rr[1])); }
    if (__builtin_expect(__all((pmax - m_reg) * SCALE <= THR), 1)) { mn = m_reg; alpha = 1.f; }
    else { mn = fmaxf(m_reg, pmax); alpha = __builtin_amdgcn_exp2f((m_reg - mn) * C2); m_reg = mn; }
    const float mnL = -mn * C2;
    for (int r = 0; r < 16; ++r) p0[r] = fmaf(p0[r], C2, mnL); for (int r = 0; r < 16; ++r) p1[r] = fmaf(p1[r], C2, mnL);
    for (int r = 0; r < 16; ++r) p0[r] = __builtin_amdgcn_exp2f(p0[r]);
}
__device__ __forceinline__ void finishSM(f32x16& p0, f32x16& p1, float alpha, float& l_reg, bf16x8& pa0, bf16x8& pa1, bf16x8& pa2, bf16x8& pa3) {
    for (int r = 0; r < 16; ++r) p1[r] = __builtin_amdgcn_exp2f(p1[r]);
    float ps = 0; for (int r = 0; r < 16; ++r) ps += p0[r]; for (int r = 0; r < 16; ++r) ps += p1[r];
    { auto rr = __builtin_amdgcn_permlane32_swap(__float_as_uint(ps), __float_as_uint(ps), false, false);
      ps = __uint_as_float(rr[0]) + __uint_as_float(rr[1]); }
    l_reg = l_reg * alpha + ps;
#define PK4(P, B_, OUT) do { unsigned a0 = cvtpk(P[B_+0], P[B_+1]), a1 = cvtpk(P[B_+2], P[B_+3]);                          \
        unsigned b0 = cvtpk(P[B_+4], P[B_+5]), b1 = cvtpk(P[B_+6], P[B_+7]);                                             \
        auto r0 = __builtin_amdgcn_permlane32_swap(a0, b0, false, false); auto r1 = __builtin_amdgcn_permlane32_swap(a1, b1, false, false); \
        u32x4 w = {r0[0], r1[0], r0[1], r1[1]}; OUT = *reinterpret_cast<bf16x8*>(&w); } while (0)
    PK4(p0, 0, pa0); PK4(p0, 8, pa1); PK4(p1, 0, pa2); PK4(p1, 8, pa3);
#undef PK4
}
template <int KB>
__device__ __forceinline__ void qkt(f32x16& p0, f32x16& p1, const char* K_lds, int r32, int hi, const bf16x8* qr, const LAS float* nbt) {
#pragma unroll
    for (int g = 0; g < 4; ++g) { const f32x4 b0 = *(const LAS f32x4*)(nbt + 8 * g), b1 = *(const LAS f32x4*)(nbt + 32 + 8 * g);
#pragma unroll
        for (int i = 0; i < 4; ++i) { p0[4 * g + i] = b0[i]; p1[4 * g + i] = b1[i]; } }
    const char* kb[4];
#pragma unroll
    for (int dd = 0; dd < 4; ++dd) kb[dd] = K_lds + KB * SHM_K + KSWZ(r32, (dd * 16 + hi * 8) * 2);
#pragma unroll
    for (int d0 = 0; d0 < 8; ++d0) { const char* a = kb[d0 & 3] + (d0 >> 2) * 128;
        bf16x8 b0 = *reinterpret_cast<const bf16x8*>(a);
        bf16x8 b1 = *reinterpret_cast<const bf16x8*>(a + 32 * 256);
        p0 = __builtin_amdgcn_mfma_f32_32x32x16_bf16(b0, qr[d0], p0, 0, 0, 0);
        p1 = __builtin_amdgcn_mfma_f32_32x32x16_bf16(b1, qr[d0], p1, 0, 0, 0); }
}
template <int VB>
__device__ __forceinline__ void pv_tile(f32x16* o, int vb0, bf16x8 pa0, bf16x8 pa1, bf16x8 pa2, bf16x8 pa3) {
#define TRRD(dst, off) asm volatile("ds_read_b64_tr_b16 %0, %1 offset:%2" : "=&v"(dst) : "v"(vb0), "i"(off) : "memory")
#define PV_D0(d0) do { s16x4 l0, l1, l2, l3, h0, h1, h2, h3; constexpr int b_ = VB * SHM_V + v_rd_off(d0, 0, 0); \
        TRRD(l0, b_); TRRD(h0, b_ + 2048); TRRD(l1, b_ + 4096); TRRD(h1, b_ + 6144); TRRD(l2, b_ + 8192); TRRD(h2, b_ + 10240); TRRD(l3, b_ + 12288); TRRD(h3, b_ + 14336); \
        asm volatile("s_waitcnt lgkmcnt(0)" ::: "memory"); SBAR();   \
        o[d0] = __builtin_amdgcn_mfma_f32_32x32x16_bf16(pa0, (bf16x8){l0[0], l0[1], l0[2], l0[3], h0[0], h0[1], h0[2], h0[3]}, o[d0], 0, 0, 0);   \
        o[d0] = __builtin_amdgcn_mfma_f32_32x32x16_bf16(pa1, (bf16x8){l1[0], l1[1], l1[2], l1[3], h1[0], h1[1], h1[2], h1[3]}, o[d0], 0, 0, 0);   \
        o[d0] = __builtin_amdgcn_mfma_f32_32x32x16_bf16(pa2, (bf16x8){l2[0], l2[1], l2[2], l2[3], h2[0], h2[1], h2[2], h2[3]}, o[d0], 0, 0, 0);   \
        o[d0] = __builtin_amdgcn_mfma_f32_32x32x16_bf16(pa3, (bf16x8){l3[0], l3[1], l3[2], l3[3], h3[0], h3[1], h3[2], h3[3]}, o[d0], 0, 0, 0); } while (0)
    PV_D0(0); PV_D0(1); PV_D0(2); PV_D0(3);
#undef PV_D0
#undef TRRD
}
struct BlockRef { const bf16* Q; const bf16* K; const bf16* V; bf16* O; int P0; unsigned char* O8; };
struct Seam { bf16x8 qr[8]; bf16x8 st_v0, st_v1, st_k0, st_k1; };
#define ROW(p, k0, rr) ((p) + (size_t)((k0) + (rr)) * LD + sc)
#define VMW() asm volatile("s_waitcnt vmcnt(0)" ::: "memory")
#define VMWN(n) asm volatile("s_waitcnt vmcnt(%0)" :: "i"(n) : "memory")
#define SLOAD_H(Kp, Vp, k0) do { S.st_v0 = load8(ROW(Vp, k0, sr)); S.st_v1 = load8(ROW(Vp, k0, 32 + sr)); S.st_k0 = load8(ROW(Kp, k0, sr)); S.st_k1 = load8(ROW(Kp, k0, 32 + sr)); } while (0)
#define SWRITE_HK(bf) do { *(bf16x8*)(K_lds + (bf) * SHM_K + kws) = S.st_k0; *(bf16x8*)(K_lds + (bf) * SHM_K + kws + 32 * 256) = S.st_k1; } while (0)
#define SWRITE_HV(bf) do { *(bf16x8*)(V_lds + (bf) * SHM_V + vst0) = S.st_v0; *(bf16x8*)(V_lds + (bf) * SHM_V + vst1) = S.st_v1; } while (0)
#define SWRITE_H(bf) do { SWRITE_HV(bf); SWRITE_HK(bf); } while (0)
__device__ __forceinline__ void prime(const BlockRef& cur, char* lds, Seam& S, int tid) {
    const int wid = __builtin_amdgcn_readfirstlane(tid >> 6), lane = tid & 63, r32 = lane & 31, hi = lane >> 5;
    const int sr = tid >> 4, sc = (tid & 15) * 8, kws = KSWZ(sr, sc * 2); char* K_lds = lds + 2 * SHM_V;
    for (int d0 = 0; d0 < 8; ++d0) S.qr[d0] = load8(cur.Q + (size_t)(wid * QBLK + r32) * LD + d0 * 16 + hi * 8);
    SLOAD_H(cur.K, cur.V, 0); VMW(); SWRITE_HK(0);
    __syncthreads();
}
__device__ __forceinline__ void block(const BlockRef& cur, const BlockRef& nxt, char* lds, Seam& S, int tid) {
    const int wid = __builtin_amdgcn_readfirstlane(tid >> 6), lane = tid & 63, r32 = lane & 31, hi = lane >> 5;
    const int NT = (cur.P0 + QB - 1) / KVBLK + 1;
    const int qlo = cur.P0 + wid * QBLK, qm = qlo + r32 - 4 * hi;
    char* V_lds = lds; char* K_lds = lds + 2 * SHM_V;
    float* ws = (float*)(lds + OFF_WS) + wid * 64; float* li_l = ws, * al_l = ws + 32;
    const LAS float* nbl = (const LAS float*)((LAS unsigned char*)lds_raw + OFF_FN) + 4 * hi;
    float m_reg = -1e30f, l_reg = 0; f32x16 o[4] = {};
    const int sr = tid >> 4, sc = (tid & 15) * 8, vst0 = v_st(sr, sc), vst1 = v_st(32 + sr, sc), kws = KSWZ(sr, sc * 2);
    const int vb0 = (int)(uintptr_t)V_lds + v_rd_base(lane);
    const bf16* Kh = cur.K; const bf16* Vh = cur.V;
#define RESC(a) do { if (__any((a) < 1.f)) { if (hi == 0) al_l[r32] = (a); asm volatile("s_waitcnt lgkmcnt(0)" ::: "memory");              \
                     for (int d_ = 0; d_ < 4; ++d_) for (int r = 0; r < 16; ++r) o[d_][r] *= al_l[crow(r, hi)]; } } while (0)
#define KBASE(t) ((t) * KVBLK)
#define MASKT(P0_, P1_, t) do { const int kb_ = KBASE(t); if (kb_ + KVBLK - 1 > qlo) mask_tile(P0_, P1_, qm - kb_); } while (0)
    constexpr int NQL = 8;
#define SEAM_K0() do { VMWN(NQL); SWRITE_HK(0); SBAR(); } while (0)
    f32x16 pA0, pA1, pB0, pB1; float mnA, mnB, alA, alB; bf16x8 pa0, pa1, pa2, pa3;
    SWRITE_HV(0); SBAR();
    if (NT > 1) { SLOAD_H(Kh, Vh, KBASE(1)); }
    SBAR(); qkt<0>(pA0, pA1, K_lds, r32, hi, S.qr, nbl);
    MASKT(pA0, pA1, 0); partialSM(pA0, pA1, m_reg, mnA, alA);
    if (NT > 1) { VMW(); SWRITE_H(1); }
    __syncthreads();
#define HALF_STEP(PX0, PX1, mnX, alX, PY0, PY1, alY, t, KB, VB, SB) do {                                                      \
        SBAR(); qkt<KB>(PX0, PX1, K_lds, r32, hi, S.qr, nbl + KBASE(t));                                             \
        finishSM(PY0, PY1, alY, l_reg, pa0, pa1, pa2, pa3); SBAR();                                                           \
        if ((t) + 1 < NT) { SLOAD_H(Kh, Vh, KBASE((t) + 1)); SBAR(); }                                               \
        pv_tile<VB>(o, vb0, pa0, pa1, pa2, pa3); MASKT(PX0, PX1, (t)); partialSM(PX0, PX1, m_reg, mnX, alX);                                        \
        __syncthreads();                                                                                                      \
        if ((t) + 1 < NT) { VMW(); SWRITE_H(SB); }                                                                          \
        RESC(alX); __syncthreads(); } while (0)
    for (int t = 1; t + 1 < NT; t += 2) {
        HALF_STEP(pB0, pB1, mnB, alB, pA0, pA1, alA, t, 1, 0, 0);
        HALF_STEP(pA0, pA1, mnA, alA, pB0, pB1, alB, t + 1, 0, 1, 1);
    }
    const bool even = (NT & 1) == 0;
    if (even) { SBAR(); qkt<1>(pB0, pB1, K_lds, r32, hi, S.qr, nbl + KBASE(NT - 1)); SBAR(); }
    SLOAD_H(nxt.K, nxt.V, 0); SBAR();
#pragma unroll
    for (int d0 = 0; d0 < 8; ++d0) S.qr[d0] = load8(nxt.Q + (size_t)(wid * QBLK + r32) * LD + d0 * 16 + hi * 8);
    SBAR();
    finishSM(pA0, pA1, alA, l_reg, pa0, pa1, pa2, pa3); SBAR();
    pv_tile<0>(o, vb0, pa0, pa1, pa2, pa3);
    if (even) { MASKT(pB0, pB1, NT - 1); partialSM(pB0, pB1, m_reg, mnB, alB); __syncthreads(); RESC(alB);
        finishSM(pB0, pB1, alB, l_reg, pa0, pa1, pa2, pa3); SBAR(); pv_tile<1>(o, vb0, pa0, pa1, pa2, pa3); }
    SBAR(); SEAM_K0();
    if (hi == 0) li_l[r32] = l_reg; asm volatile("s_waitcnt lgkmcnt(0)" ::: "memory");
    float rli[16];
#pragma unroll
    for (int r = 0; r < 16; ++r) rli[r] = __builtin_amdgcn_rcpf(li_l[crow(r, hi)]);
    bf16* Ow = cur.O + (size_t)(wid * QBLK) * LD;
#pragma unroll
    for (int r = 0; r < 16; ++r) { const int orow = crow(r, hi);
#pragma unroll
        for (int d0 = 0; d0 < 4; ++d0) { const float v = o[d0][r] * rli[r]; const float vn = __shfl_xor(v, 1);
            if ((r32 & 1) == 0) *(unsigned*)(Ow + (size_t)orow * LD + d0 * 32 + r32) = cvtpk(v, vn); } }
    __syncthreads();
#undef RESC
#undef KBASE
#undef MASKT
#undef SEAM_K0
#undef HALF_STEP
}
__device__ __forceinline__ void block_lean(const BlockRef& cur, char* lds, int tid) {
    const int wid = __builtin_amdgcn_readfirstlane(tid >> 6), lane = tid & 63, r32 = lane & 31, hi = lane >> 5;
    const int NT = (cur.P0 + QB - 1) / KVBLK + 1;
    const int qlo = cur.P0 + wid * QBLK, qm = qlo + r32 - 4 * hi;
    char* V_lds = lds; char* K_lds = lds + 2 * SHM_V;
    float* ws = (float*)(lds + OFF_WS) + wid * 64; float* li_l = ws, * al_l = ws + 32;
    const LAS float* nbl = (const LAS float*)((LAS unsigned char*)lds_raw + OFF_FN) + 4 * hi;
    const int sr = tid >> 4, sc = (tid & 15) * 8, vst0 = v_st(sr, sc), vst1 = v_st(32 + sr, sc), kws = KSWZ(sr, sc * 2);
    const int vb0 = (int)(uintptr_t)V_lds + v_rd_base(lane);
    const bf16* Kh = cur.K; const bf16* Vh = cur.V;
    Seam S;
#pragma unroll
    for (int d0 = 0; d0 < 8; ++d0) S.qr[d0] = load8(cur.Q + (size_t)(wid * QBLK + r32) * LD + d0 * 16 + hi * 8);
    SLOAD_H(Kh, Vh, 0); VMW(); SWRITE_H(0);
    if (NT > 1) { SLOAD_H(Kh, Vh, KVBLK); VMW(); SWRITE_H(1); }
    if (NT > 2) SLOAD_H(Kh, Vh, 2 * KVBLK);
    __syncthreads();
    float m_reg = -1e30f, l_reg = 0; f32x16 o[4] = {};
    f32x16 p0, p1; float mn, al; bf16x8 pa0, pa1, pa2, pa3;
#define RESC(a) do { if (__any((a) < 1.f)) { if (hi == 0) al_l[r32] = (a); asm volatile("s_waitcnt lgkmcnt(0)" ::: "memory");              \
                     for (int d_ = 0; d_ < 4; ++d_) for (int r = 0; r < 16; ++r) o[d_][r] *= al_l[crow(r, hi)]; } } while (0)
#define LSTEP(t, B) do { const int kb_ = (t) * KVBLK;                                                                      \
        SBAR(); qkt<B>(p0, p1, K_lds, r32, hi, S.qr, nbl + kb_);                                                            \
        if (kb_ + KVBLK - 1 > qlo) mask_tile(p0, p1, qm - kb_);                                                             \
        partialSM(p0, p1, m_reg, mn, al); RESC(al);                                                                         \
        finishSM(p0, p1, al, l_reg, pa0, pa1, pa2, pa3); SBAR();                                                            \
        pv_tile<B>(o, vb0, pa0, pa1, pa2, pa3);                                                                             \
        __syncthreads();                                                                                                    \
        if ((t) + 2 < NT) { VMW(); SWRITE_H(B); if ((t) + 3 < NT) SLOAD_H(Kh, Vh, ((t) + 3) * KVBLK); } } while (0)
    for (int t = 0; t < NT; t += 2) { LSTEP(t, 0); if (t + 1 < NT) LSTEP(t + 1, 1); }
    if (hi == 0) li_l[r32] = l_reg; asm volatile("s_waitcnt lgkmcnt(0)" ::: "memory");
    float rli[16];
#pragma unroll
    for (int r = 0; r < 16; ++r) rli[r] = __builtin_amdgcn_rcpf(li_l[crow(r, hi)]);
    bf16* Ow = cur.O + (size_t)(wid * QBLK) * LD;
#pragma unroll
    for (int r = 0; r < 16; ++r) { const int orow = crow(r, hi);
#pragma unroll
        for (int d0 = 0; d0 < 4; ++d0) { const float v = o[d0][r] * rli[r]; const float vn = __shfl_xor(v, 1);
            if (cur.O8) { const float v2 = __shfl_xor(v, 2), v3 = __shfl_xor(vn, 2);
                if ((r32 & 3) == 0) *(unsigned*)(cur.O8 + (size_t)(wid * QBLK + orow) * LD + d0 * 32 + r32) = pk4_fp8(v, vn, v2, v3); }
            else if ((r32 & 1) == 0) *(unsigned*)(Ow + (size_t)orow * LD + d0 * 32 + r32) = cvtpk(v, vn); } }
    __syncthreads();
#undef RESC
#undef LSTEP
}
#undef ROW
#undef VMW
#undef VMWN
#undef SLOAD_H
#undef SWRITE_HK
#undef SWRITE_HV
#undef SWRITE_H
#undef KSWZ
#undef SBAR
}

__device__ __forceinline__ void attn_fast(Frame& F) {
    const bf16* Q = (const bf16*)(F.ws + WS_Q); const bf16* Kp = (const bf16*)(F.ws + WS_K); const bf16* V = (const bf16*)(F.ws + WS_V); bf16* AO = (bf16*)(F.ws + WS_AO);
    char* lds = (char*)lds_raw;
    {   const int item = F.vcu;
        const int bh = item >> 2, b = bh >> 3, h = bh & 7, x = item & 3;
        __syncthreads();
        {
            LAS float* Fl = (LAS float*)(F.lds + att::OFF_FN); LAS float* tmp = (LAS float*)(F.lds + att::OFF_TMP);
            forget_cumsum(F, b, h, Fl, tmp, -1.0f / att::SCALE);
        }
        const size_t seq0 = (size_t)b * SEQ * 1024 + h * 128;
        att::BlockRef r0, r1;
        unsigned char* AO8 = G2_FP8 ? (unsigned char*)(F.ws + WS_AO) : (unsigned char*)nullptr;
        r0.Q = Q + seq0 + (size_t)(x * 256) * 1024; r0.O = AO + seq0 + (size_t)(x * 256) * 1024; r0.K = Kp + seq0; r0.V = V + seq0; r0.P0 = x * 256; r0.O8 = AO8 ? AO8 + seq0 + (size_t)(x * 256) * 1024 : AO8;
        r1.Q = Q + seq0 + (size_t)((7 - x) * 256) * 1024; r1.O = AO + seq0 + (size_t)((7 - x) * 256) * 1024; r1.K = Kp + seq0; r1.V = V + seq0; r1.P0 = (7 - x) * 256; r1.O8 = AO8 ? AO8 + seq0 + (size_t)((7 - x) * 256) * 1024 : AO8;
#if ATTN_FAST == 2
        att::Seam S;
        att::prime(r0, lds, S, F.tid);
        att::block(r0, r1, lds, S, F.tid);
        att::block(r1, r1, lds, S, F.tid);
#else
        att::block_lean(r0, lds, F.tid);
        att::block_lean(r1, lds, F.tid);
#endif
    }
    __syncthreads();
}
#endif

#if !ATTN_FAST
__device__ __forceinline__ void attn_simple(Frame& F) {
    const bf16* Q = (const bf16*)(F.ws + WS_Q); const bf16* Kp = (const bf16*)(F.ws + WS_K); const bf16* V = (const bf16*)(F.ws + WS_V); bf16* AO = (bf16*)(F.ws + WS_AO);
    LAS float* Fl = (LAS float*)F.lds;
    LAS float* tmp = (LAS float*)(F.lds + 8192);
    LAS float* sc = (LAS float*)(F.lds + 16384 + F.wave * 8192);
    LAS float* qf = (LAS float*)(F.lds + 16384 + 65536 + F.wave * 512);
    const float L2E = 1.4426950408889634f, scale = 0.08838834764831845f;
    {   const int item = F.vcu;
        const int bh = item >> 2, b = bh >> 3, h = bh & 7, q0 = (item & 3) * 512;
        __syncthreads();
        forget_cumsum(F, b, h, Fl, tmp, 1.4426950408889634f);
        for (int t = q0 + F.wave; t < q0 + 512; t += NWAVES) {
            const size_t row = (size_t)b * SEQ + t;
            { const unsigned qw = *(const unsigned*)(Q + row * 1024 + h * 128 + 2 * F.lane); qf[2 * F.lane] = bf_lo(qw); qf[2 * F.lane + 1] = bf_hi(qw); }
            LDS_WAIT();
            float mx = -3.0e38f;
            for (int j = F.lane; j <= t; j += 64) {
                const bf16* kr = Kp + ((size_t)b * SEQ + j) * 1024 + h * 128; float d = 0.f;
#pragma unroll 2
                for (int c = 0; c < 16; ++c) { const u32x4 kw = *(const u32x4*)(kr + 8 * c); f32x4 k0, k1; pg8::unpack8(kw, k0, k1); const f32x4 q0v = *(const LAS f32x4*)(qf + 8 * c), q1v = *(const LAS f32x4*)(qf + 8 * c + 4);
                    d += (k0[0] * q0v[0] + k0[1] * q0v[1]) + (k0[2] * q0v[2] + k0[3] * q0v[3]) + (k1[0] * q1v[0] + k1[1] * q1v[1]) + (k1[2] * q1v[2] + k1[3] * q1v[3]); }
                const float s = d * scale * L2E + (Fl[t] - Fl[j]);
                sc[j] = s; mx = fmaxf(mx, s);
            }
            mx = wave_max(mx);
            float sum = 0.f;
            for (int j = F.lane; j <= t; j += 64) { const float p = __builtin_amdgcn_exp2f(sc[j] - mx); sc[j] = p; sum += p; }
            sum = wave_sum(sum);
            LDS_WAIT();
            float o0 = 0.f, o1 = 0.f;
            const bf16* vb = V + (size_t)b * SEQ * 1024 + h * 128 + 2 * F.lane;
            for (int j = 0; j <= t; ++j) { const unsigned vw = *(const unsigned*)(vb + (size_t)j * 1024); const float p = sc[j]; o0 += p * bf_lo(vw); o1 += p * bf_hi(vw); }
            const float inv = 1.0f / sum;
            *(unsigned*)(AO + row * 1024 + h * 128 + 2 * F.lane) = cvt_pk_bf16(o0 * inv, o1 * inv);
        }
    }
    __syncthreads();
}
#endif

__device__ __forceinline__ unsigned char* layer_w(const Frame& F, int l) { return F.ws + WS_W + (size_t)l * W_LAYER; }
__device__ __forceinline__ void ph_p0() { Frame F; frame_refresh(F); p0_prologue(F); }
__device__ __forceinline__ void ph_r1(int l, bool pre = false) { Frame F; frame_refresh(F); if (l == 0) rows_phase<0, false>(F, l, pre); else rows_phase<0, true>(F, l, pre); }
__device__ __forceinline__ void ph_r2(int l, bool pre = false) { Frame F; frame_refresh(F); rows_phase<1, false>(F, l, pre); }
__device__ __forceinline__ void ph_r2_dry(int l) { Frame F; frame_refresh(F); rows_phase<1, false, true>(F, l); }
__device__ __forceinline__ void ph_final() { Frame F; frame_refresh(F); rows_phase<2, true>(F, 0);
}
__device__ __forceinline__ void ph_g1(int l) {
    Frame F; frame_refresh(F);
    const LAS int* tt = (const LAS int*)(F.lds + X_TOK);
#if G1_FP8 == 2
    pg8::Gemm g{(const bf16*)(F.ws + WS_H8), (const bf16*)(layer_w(F, l) + WO_PG)};
    typedef pg8::StaticOrder<T, 8192, DM / 2, DM / 2> Order; Order S; S.init(F.G, (int)blockIdx.x);
    pg8::EpiProj E{(bf16*)(F.ws + WS_U), (bf16*)(F.ws + WS_G), ARG_IN(I_BGATE) + (size_t)l * 4096, W8_INV, 0};
    pg8::gemm_phase<pg8::EpiProj, Order, false, DM / 2, DM / 2, DM / 2, true>(F.lds, g, S, E, tt);
#elif G1_FP8 == 1
    {   pg8::Gemm g{(const bf16*)(F.ws + WS_H), (const bf16*)(layer_w(F, l) + WO_PG)};
        typedef pg8::StaticOrder<T, 4096, DM, DM> Order; Order S; S.init(F.G, (int)blockIdx.x);
        pg8::EpiProj E{(bf16*)(F.ws + WS_U), (bf16*)(F.ws + WS_G), ARG_IN(I_BGATE) + (size_t)l * 4096, 1.0f, 0};
        pg8::gemm_phase<pg8::EpiProj, Order, false, DM, DM, DM>(F.lds, g, S, E, tt); }
    {   pg8::Gemm g{(const bf16*)(F.ws + WS_H8), (const bf16*)(layer_w(F, l) + WO_PG + 16 * MiB)};
        typedef pg8::StaticOrder<T, 4096, DM / 2, DM / 2> Order; Order S; S.init(F.G, (int)blockIdx.x);
        pg8::EpiProj E{(bf16*)(F.ws + WS_U), (bf16*)(F.ws + WS_G), ARG_IN(I_BGATE) + (size_t)l * 4096, W8_INV, 16};
        pg8::gemm_phase<pg8::EpiProj, Order, false, DM / 2, DM / 2, DM / 2, true>(F.lds, g, S, E, tt); }
#else
    pg8::Gemm g{(const bf16*)(F.ws + WS_H), (const bf16*)(layer_w(F, l) + WO_PG)};
    typedef pg8::StaticOrder<T, 8192, DM, DM> Order; Order S; S.init(F.G, (int)blockIdx.x);
    pg8::EpiProj E{(bf16*)(F.ws + WS_U), (bf16*)(F.ws + WS_G), ARG_IN(I_BGATE) + (size_t)l * 4096, 1.0f, 0};
    pg8::gemm_phase<pg8::EpiProj, Order, false, DM, DM, DM>(F.lds, g, S, E, tt);
#endif
}
__device__ __forceinline__ void ph_at(int l) {
    Frame F; frame_refresh(F);
#if !ATTN_FAST
    attn_simple(F);
#else
    attn_fast(F);
#endif
    {
        frame_refresh(F);
        const int pu = F.vcu, pm = pu >> 2, g = pu & 3;
        pool_tile(F, pm, g);
        VM_WAIT(); __syncthreads();
    }
    {
        frame_refresh(F);
        const int pu = F.vcu, pm = pu >> 2, g = pu & 3;
        pg8::Gemm gg{(const bf16*)(F.ws + WS_PL), (const bf16*)(layer_w(F, l) + WO_POOL)};
        pg8::OneUnit S; S.u0.pm = pm; S.u0.pn = 0; S.u0.ti = 0; S.u0.aoff = (unsigned)pm * (256u * 1024u * 2u) + (unsigned)g * 512u; S.u0.boff = (unsigned)g * (256u * 256u * 2u); S.u0.aoff2 = 0u; S.u0.boff2 = 0u;
        pg8::EpiPool E{(bf16*)(F.ws + WS_PO), ARG_IN(I_PSCALE) + (size_t)l * 1024, g, G2_FP8 ? (unsigned char*)(F.ws + WS_PO) : (unsigned char*)nullptr};
        pg8::gemm_phase<pg8::EpiPool, pg8::OneUnit, false, 1024, 256, 256>(F.lds, gg, S, E, (const LAS int*)(F.lds + X_TOK));
        __syncthreads();
    }
}
__device__ __forceinline__ void ph_g2(int l) {
    Frame F; frame_refresh(F);
    unsigned char* mg8 = G3_FP8 ? (unsigned char*)(F.ws + WS_MG8) : (unsigned char*)nullptr;
    pg8::Gemm g{(const bf16*)(F.ws + WS_PO), (const bf16*)(layer_w(F, l) + WO_BR)};
#if G2_FP8
    typedef pg8::SplitOrder<pg8::StaticOrder<T, DM, 512, 512>> Order;
    Order S; S.S0.init(F.G, (int)blockIdx.x); S.a2 = (unsigned)(WS_AO - WS_PO); S.b2 = 2048u * 1024u;
    pg8::EpiMerge E{(bf16*)(F.ws + WS_MG), (const unsigned char*)(F.ws + WS_G), mg8, W8_INV};
    pg8::gemm_phase<pg8::EpiMerge, Order, false, 512, 512, 1024, true, 8>(F.lds, g, S, E, (const LAS int*)(F.lds + X_TOK));
#else
    typedef pg8::SplitOrder<pg8::StaticOrder<T, DM, 1024, 1024>> Order;
    Order S; S.S0.init(F.G, (int)blockIdx.x); S.a2 = (unsigned)(WS_AO - WS_PO); S.b2 = 2048u * 1024u * 2u;
    pg8::EpiMerge E{(bf16*)(F.ws + WS_MG), (const unsigned char*)(F.ws + WS_G), mg8, 1.0f};
    pg8::gemm_phase<pg8::EpiMerge, Order, false, 1024, 1024, 2048, false, 16>(F.lds, g, S, E, (const LAS int*)(F.lds + X_TOK));
#endif
}
__device__ __forceinline__ void ph_g3(int l) {
    Frame F; frame_refresh(F);
    const float* gate = (const float*)(F.ws + WS_MOD) + (size_t)l * 8 * MODW + 2 * DM;
#if G3_FP8
    pg8::Gemm g{(const bf16*)(F.ws + WS_MG8), (const bf16*)(layer_w(F, l) + WO_OUT)};
    typedef pg8::StaticOrder<T, DM, DM / 2, DM / 2> Order; Order S; S.init(F.G, (int)blockIdx.x);
    pg8::EpiOut E{(bf16*)(F.ws + WS_DL), gate, W8_INV};
    pg8::gemm_phase<pg8::EpiOut, Order, false, DM / 2, DM / 2, DM / 2, true>(F.lds, g, S, E, (const LAS int*)(F.lds + X_TOK));
#else
    pg8::Gemm g{(const bf16*)(F.ws + WS_MG), (const bf16*)(layer_w(F, l) + WO_OUT)};
    typedef pg8::StaticOrder<T, DM, DM, DM> Order; Order S; S.init(F.G, (int)blockIdx.x);
    pg8::EpiOut E{(bf16*)(F.ws + WS_DL), gate, 1.0f};
    pg8::gemm_phase<pg8::EpiOut, Order, false, DM, DM, DM>(F.lds, g, S, E, (const LAS int*)(F.lds + X_TOK));
#endif
}
__device__ __forceinline__ void ph_m1(int l) {
    Frame F; frame_refresh(F);
    load_expert_tables(F, l);
    const LAS int* misc = (const LAS int*)(F.lds + X_MISC);
    pg8::MoeOrder S; S.G = F.G; S.c = (int)blockIdx.x; S.NT = misc[24]; S.tpre = misc + 8; S.a_tile_bytes = 0u; S.b_exp_bytes = 2048u * 2048u * (MOE_FP8 ? 1u : 2u); S.b_tile_bytes = 256u * 2048u * (MOE_FP8 ? 1u : 2u);
    {
        LAS int* tt = (LAS int*)(F.lds + X_TOK); const int* list = (const int*)(F.ws + WS_LIST);
        pg8::Unit u;
        int tv[8];
#pragma unroll
        for (int i = 0; i < 8; ++i) { tv[i] = -1;
            if (S.next(i, u)) {
                int e = 0;
                for (int j = 1; j < 16; ++j) e += (u.pm >= misc[8 + j]) ? 1 : 0;
                const int mt = u.pm - misc[8 + e], n = misc[32 + e];
                if (F.tid < 256) { int idx = mt * 256 + F.tid; idx = idx < n ? idx : n - 1; tv[i] = list[e * LIST_CAP + idx]; } } }
        __builtin_amdgcn_sched_barrier(0);
#pragma unroll
        for (int i = 0; i < 8; ++i) if (tv[i] >= 0) tt[i * 256 + F.tid] = tv[i];
        VM_WAIT(); __syncthreads();
    }
    pg8::Gemm g{(const bf16*)(F.ws + (MOE_FP8 ? WS_H8 : WS_H)), (const bf16*)(layer_w(F, l) + WO_GU)};
#if MOE_FP8
    pg8::EpiSwiglu8 E{(unsigned char*)(F.ws + WS_ACT)};
    pg8::gemm_phase<pg8::EpiSwiglu8, pg8::MoeOrder, true, DM / 2, DM / 2, DM / 2, true>(F.lds, g, S, E, (const LAS int*)(F.lds + X_TOK));
    frame_refresh(F);
    if (l == 0) cvt_queue_drain(F, 0, Q_FIRST, Q_1); else cvt_queue_drain(F, 2, Q_FIRST + Q_A, Q_B);
#else
    pg8::EpiSwiglu E{(bf16*)(F.ws + WS_ACT)};
    pg8::gemm_phase<pg8::EpiSwiglu, pg8::MoeOrder, true, DM, DM, DM>(F.lds, g, S, E, (const LAS int*)(F.lds + X_TOK));
#endif
}
__device__ __forceinline__ void ph_m2(int l) {
    Frame F; frame_refresh(F);
    load_expert_tables(F, l);
    const LAS int* misc = (const LAS int*)(F.lds + X_MISC);
    pg8::MoeOrder S; S.G = F.G; S.c = (int)blockIdx.x; S.NT = misc[24]; S.tpre = misc + 8; S.a_tile_bytes = 256u * 1024u * (MOE_FP8 ? 1u : 2u); S.b_exp_bytes = 2048u * 1024u * (MOE_FP8 ? 1u : 2u); S.b_tile_bytes = 256u * 1024u * (MOE_FP8 ? 1u : 2u);
    pg8::Gemm g{(const bf16*)(F.ws + WS_ACT), (const bf16*)(layer_w(F, l) + WO_D)};
    pg8::EpiDown E{(bf16*)(F.ws + WS_YB), MOE_FP8 ? W8_INV : 1.0f};
#if MOE_FP8
    pg8::gemm_phase<pg8::EpiDown, pg8::MoeOrder, false, DE / 2, DE / 2, DE / 2, true>(F.lds, g, S, E, (const LAS int*)(F.lds + X_TOK));
    if (l == 0) { frame_refresh(F); cvt_queue_drain(F, 1, Q_FIRST + Q_1, Q_A - Q_1); }
#else
    pg8::gemm_phase<pg8::EpiDown, pg8::MoeOrder, false, DE, DE, DE>(F.lds, g, S, E, (const LAS int*)(F.lds + X_TOK));
#endif
}
__device__ __forceinline__ void grid_seam() {
    XcdBarrier bar; bar.bar = (unsigned*)((unsigned char*)arg_in(21) + WS_CTL) + CW_BAR; bar.x = xb_xcc_id(); bar.st = (volatile LAS unsigned*)((LAS unsigned char*)lds_raw + X_MISC);
    xcd_barrier(bar);
}

template <int MODE>
__device__ __forceinline__ void grid_seam_fill(int l) {
    XcdBarrier b; b.bar = (unsigned*)((unsigned char*)arg_in(21) + WS_CTL) + CW_BAR; b.x = xb_xcc_id(); b.st = (volatile LAS unsigned*)((LAS unsigned char*)lds_raw + X_MISC);
    asm volatile("s_waitcnt vmcnt(0)" ::: "memory");
    __syncthreads();
    if (threadIdx.x == 0) {
        unsigned* bar = b.bar;
        __builtin_amdgcn_s_waitcnt(0);
        unsigned nloc = b.st[0], nx = b.st[1];
        if (nloc == 0u) { xcd_barrier_complete(bar, b.x, nloc, nx); b.st[0] = nloc; b.st[1] = nx; }
        const unsigned old = xb_add(&bar[XB_XSUB(b.x)], 1u);
        const unsigned gen = old / nloc;
        if (old + 1u == (gen + 1u) * nloc) {
            __builtin_amdgcn_fence(__ATOMIC_RELEASE, "agent");
            asm volatile("s_waitcnt vmcnt(0)" ::: "memory");
            const unsigned og = xb_add(&bar[XB_TOP], 1u);
            const unsigned tg = og / nx;
            if (og + 1u == (tg + 1u) * nx) xb_add(&bar[XB_TOPGEN], 1u);
            else XB_SPIN(xb_ld(&bar[XB_TOPGEN]) == tg, bar);
            __builtin_amdgcn_fence(__ATOMIC_ACQUIRE, "agent");
            xb_add(&bar[XB_XGEN(b.x)], 1u);
            asm volatile("s_waitcnt vmcnt(0)" ::: "memory");
        } else {
            XB_SPIN(xb_ld(&bar[XB_XGEN(b.x)]) == gen, bar);
            __builtin_amdgcn_fence(__ATOMIC_ACQUIRE, "agent");
            asm volatile("s_waitcnt vmcnt(0)" ::: "memory");
        }
    } else if (threadIdx.x >= 64) {
        const int t = opaque_tid() - 64;
        LAS f32x4* tab = (LAS f32x4*)lds_raw;
        if (MODE == 1) {
            const f32x4* src = (const f32x4*)ARG_IN(I_WROUTER);
            f32x4 tv[19];
#pragma unroll
            for (int k = 0; k < 19; ++k) { const int i = t + k * 448; tv[k] = src[i < DM * 4 ? i : 0]; }
            __builtin_amdgcn_sched_barrier(0);
#pragma unroll
            for (int k = 0; k < 19; ++k) { const int i = t + k * 448; if (i < DM * 4) { const int c = i >> 2, g = i & 3; tab[((g * 4 + (c & 3)) * 8 + (c >> 8)) * 64 + ((c >> 2) & 63)] = tv[k]; } }
        } else {
            const float* src = ARG_IN(I_WIN) + (size_t)l * DM * INW + 4096;
            f32x4 tv[10];
#pragma unroll
            for (int k = 0; k < 10; ++k) { const int i = t + k * 448, ii = i < DM * 2 ? i : 0, c = ii >> 1, g = ii & 1; tv[k] = *(const f32x4*)(src + (size_t)c * INW + g * 4); }
            __builtin_amdgcn_sched_barrier(0);
#pragma unroll
            for (int k = 0; k < 10; ++k) { const int i = t + k * 448; if (i < DM * 2) { const int c = i >> 1, g = i & 1; tab[((g * 4 + (c & 3)) * 8 + (c >> 8)) * 64 + ((c >> 2) & 63)] = tv[k]; } }
        }
    }
    __syncthreads();
}

constexpr int N_PHASES = 18;
#ifndef PHMASK
#define PHMASK 0xFFFF
#endif
#define EN(j) ((PHMASK >> (j)) & 1)
#ifndef DUPMASK
#define DUPMASK 0
#endif
#define DUP(j) ((DUPMASK >> (j)) & 1)
__global__ void __launch_bounds__(NTHREADS, 2) mk_fwd(Args args) {
    {
        LAS unsigned char* lds = (LAS unsigned char*)lds_raw;
        for (int u = threadIdx.x; u < (LDS_BYTES - EXTRA_OFF) / 4; u += NTHREADS) ((LAS unsigned*)(lds + EXTRA_OFF))[u] = 0u;
        __syncthreads();
        if (args.ph_hi - args.ph_lo > 1) (void)xcd_barrier_post((unsigned*)(args.ws + WS_CTL) + CW_BAR, (volatile LAS unsigned*)(lds + X_MISC));
    }
#define IN(k) (arg_i32(176) <= (k) && (k) < arg_i32(180))
#define SEAM(k) do { if (IN(k) && IN((k) + 1)) grid_seam(); } while (0)
    if (EN(0) && IN(0)) ph_p0();
    if (DUP(0) && IN(0)) ph_p0();
    constexpr bool PRE = MK_ONE_LAUNCH != 0;
#define SEAM_FILL(k, MODE, ll) do { if (IN(k) && IN((k) + 1)) { if (PRE) grid_seam_fill<MODE>(ll); else grid_seam(); } } while (0)
    SEAM_FILL(0, 0, 0);
    for (int l = 0; l < DEPTH; ++l) {
        const int pb = 1 + 8 * l;
        if (EN(1) && IN(pb + 0)) ph_r1(l, PRE);
        if (DUP(1) && l == 0 && IN(pb + 0)) { ph_r1(l); ph_r1(l); }
        SEAM(pb + 0);
        if (EN(2) && IN(pb + 1)) ph_g1(l);
        if (DUP(2) && IN(pb + 1)) ph_g1(l);
        SEAM(pb + 1);
        if (EN(3) && IN(pb + 2)) ph_at(l);
        if (DUP(3) && IN(pb + 2)) ph_at(l);
        SEAM(pb + 2);
        if (EN(4) && IN(pb + 3)) ph_g2(l);
        if (DUP(4) && IN(pb + 3)) ph_g2(l);
        SEAM(pb + 3);
        if (EN(5) && IN(pb + 4)) ph_g3(l);
        if (DUP(5) && l == 0 && IN(pb + 4)) { ph_g3(l); ph_g3(l); }
        SEAM_FILL(pb + 4, 1, l);
        if (EN(6) && IN(pb + 5)) ph_r2(l, PRE);
        if (DUP(6) && l == 0 && IN(pb + 5)) { ph_r2_dry(l); ph_r2_dry(l); }
        SEAM(pb + 5);
        if (EN(7) && IN(pb + 6)) ph_m1(l);
        if (DUP(7) && IN(pb + 6)) ph_m1(l);
        SEAM(pb + 6);
        if (EN(8) && IN(pb + 7)) ph_m2(l);
        if (DUP(8) && IN(pb + 7)) ph_m2(l);
        if (l + 1 < DEPTH) SEAM_FILL(pb + 7, 0, l + 1); else SEAM(pb + 7);
    }
    if (EN(9) && IN(17)) ph_final();
#undef IN
#undef SEAM
#undef SEAM_FILL
}

extern "C" void kernel_launch(void* const* d_in, const int* in_sizes, int n_in, void* d_out, int out_size, void* d_ws, size_t ws_size, hipStream_t stream) {
    static int grid = 0;
    if (grid == 0) {
        if (n_in != 20 || out_size != T * DM || ws_size < WS_END) { fprintf(stderr, "kernel_launch: unexpected shapes (n_in %d out %d ws %zu)\n", n_in, out_size, ws_size); grid = -1; return; }
        int dev = 0, cus = 0, per_cu = 0;
        if (hipGetDevice(&dev) != hipSuccess || hipDeviceGetAttribute(&cus, hipDeviceAttributeMultiprocessorCount, dev) != hipSuccess) { grid = -1; return; }
        if (hipFuncSetAttribute((const void*)mk_fwd, hipFuncAttributeMaxDynamicSharedMemorySize, LDS_BYTES) != hipSuccess) { fprintf(stderr, "kernel_launch: hipFuncSetAttribute failed\n"); grid = -1; return; }
        if (hipOccupancyMaxActiveBlocksPerMultiprocessor(&per_cu, (const void*)mk_fwd, NTHREADS, LDS_BYTES) != hipSuccess || per_cu < 1) { fprintf(stderr, "kernel_launch: occupancy query says %d\n", per_cu); }
        (void)hipGetLastError();
        grid = cus;
    }
    if (grid < 0) return;
    (void)hipMemsetAsync((char*)d_ws + WS_CTL, 0, CTL_ZERO_BYTES, stream);
    Args a{};
    for (int i = 0; i < 20; ++i) a.in[i] = (const float*)d_in[i];
    a.out = (float*)d_out; a.ws = (unsigned char*)d_ws;
#if MK_ONE_LAUNCH
    a.ph_lo = 0; a.ph_hi = N_PHASES;
    hipLaunchKernelGGL(mk_fwd, dim3(grid), dim3(NTHREADS), LDS_BYTES, stream, a);
#else
    for (int p = 0; p < N_PHASES; ++p) { a.ph_lo = p; a.ph_hi = p + 1; hipLaunchKernelGGL(mk_fwd, dim3(grid), dim3(NTHREADS), LDS_BYTES, stream, a); }
#endif
}
```

```cpp
#include <hip/hip_runtime.h>
#include <stdio.h>
#include <stdint.h>

#ifndef MK_ONE_LAUNCH
#define MK_ONE_LAUNCH 1
#endif
#ifndef MOE_FP8
#define MOE_FP8 1
#endif
#ifndef G1_FP8
#define G1_FP8 2
#endif
#ifndef G3_FP8
#define G3_FP8 1
#endif
#ifndef G2_FP8
#define G2_FP8 1
#endif
#ifndef YB_FP8
#define YB_FP8 1
#endif
#ifndef GEMM_FAST
#define GEMM_FAST 1
#endif
#ifndef ATTN_FAST
#define ATTN_FAST 1
#endif

#define GAS __attribute__((address_space(1)))
#define LAS __attribute__((address_space(3)))
typedef unsigned short bf16;
typedef short bf16x8 __attribute__((ext_vector_type(8)));
typedef float f32x4 __attribute__((ext_vector_type(4)));
typedef float f32x2 __attribute__((ext_vector_type(2)));
typedef unsigned u32x4 __attribute__((ext_vector_type(4)));
typedef unsigned u32x2 __attribute__((ext_vector_type(2)));
typedef GAS unsigned gu32;
#define RLX_AGENT __ATOMIC_RELAXED, __HIP_MEMORY_SCOPE_AGENT
#define LDS_WAIT() asm volatile("s_waitcnt lgkmcnt(0)" ::: "memory")
#define VM_WAIT() asm volatile("s_waitcnt vmcnt(0)" ::: "memory")

constexpr int DM = 2048, BATCH = 8, SEQ = 2048, T = BATCH * SEQ, DEPTH = 2;
constexpr int PW = 1024, AW = 1024, NH = 8, HD = 128, INW = 4104, NE = 16, DE = 1024, NMOD = 6;
constexpr int MODW = NMOD * DM;
constexpr float EPS = 1e-6f;
constexpr int NWAVES = 8, NTHREADS = 512;
constexpr int LIST_CAP = 16384;
constexpr int MAX_RT = 144;

constexpr size_t MiB = 1u << 20;
constexpr size_t WS_CTL = 0, CTL_ZERO_BYTES = 1 * MiB;
constexpr size_t WS_MOD = 1 * MiB;
constexpr size_t WS_W = 2 * MiB, W_LAYER = 241 * MiB;
constexpr size_t WO_PG = 0, WO_POOL = 32 * MiB, WO_BR = 33 * MiB, WO_OUT = 41 * MiB, WO_GU = 49 * MiB, WO_D = 177 * MiB;
constexpr size_t WS_H = 484 * MiB;
constexpr size_t WS_U = 548 * MiB, WS_Q = 580 * MiB, WS_K = 612 * MiB, WS_V = 644 * MiB;
constexpr size_t WS_G = 676 * MiB;
constexpr size_t WS_PL = 804 * MiB, WS_PO = 836 * MiB, WS_AO = 868 * MiB;
constexpr size_t WS_MG = 900 * MiB;
constexpr size_t WS_DL = 804 * MiB;
constexpr size_t WS_ACT = 804 * MiB;
constexpr size_t WS_YB = 548 * MiB;
constexpr size_t WS_LS = 964 * MiB;
constexpr size_t WS_TOKE = 965 * MiB;
constexpr size_t WS_TOKW = WS_TOKE + 128 * 1024;
constexpr size_t WS_TOKP = WS_TOKW + 128 * 1024;
constexpr size_t WS_LIST = 966 * MiB;
constexpr size_t WS_MODP = 968 * MiB;
constexpr size_t WS_H8 = 972 * MiB;
constexpr size_t WS_XB = 1004 * MiB;
constexpr size_t WS_MG8 = 1068 * MiB;
constexpr size_t WS_END = 1100 * MiB;
constexpr int CW_BAR = 4096;
constexpr int CW_CNT = 16384;

constexpr int RING_BYTES = 131072;
constexpr int EXTRA_OFF = 135168;
constexpr int LDS_BYTES = 147456;
constexpr int X_MISC = EXTRA_OFF;
constexpr int X_TOK = EXTRA_OFF + 1024;
constexpr int X_ASG = EXTRA_OFF + 9216;

typedef __bf16 bf16x2_t __attribute__((ext_vector_type(2)));
__device__ __forceinline__ unsigned cvt_pk_bf16(float lo, float hi) { f32x2 v = {lo, hi}; bf16x2_t b = __builtin_convertvector(v, bf16x2_t); return __builtin_bit_cast(unsigned, b); }
typedef int i32x8 __attribute__((ext_vector_type(8)));
typedef int i32x4 __attribute__((ext_vector_type(4)));
__device__ __forceinline__ unsigned pk4_fp8(float a, float b, float c, float d) { int w = __builtin_amdgcn_cvt_pk_fp8_f32(a, b, 0, false); w = __builtin_amdgcn_cvt_pk_fp8_f32(c, d, w, true); return (unsigned)w; }
__device__ __forceinline__ unsigned pk4_unorm8(const f32x4 v) { unsigned w = 0;
    w = __builtin_amdgcn_cvt_pk_u8_f32(__builtin_floorf(v[0] * 255.0f + 0.5f), 0, w); w = __builtin_amdgcn_cvt_pk_u8_f32(__builtin_floorf(v[1] * 255.0f + 0.5f), 1, w);
    w = __builtin_amdgcn_cvt_pk_u8_f32(__builtin_floorf(v[2] * 255.0f + 0.5f), 2, w); w = __builtin_amdgcn_cvt_pk_u8_f32(__builtin_floorf(v[3] * 255.0f + 0.5f), 3, w); return w; }
__device__ __forceinline__ f32x4 unpk4_u8(unsigned w) { return (f32x4){(float)(w & 0xffu), (float)((w >> 8) & 0xffu), (float)((w >> 16) & 0xffu), (float)(w >> 24)}; }
__device__ __forceinline__ f32x4 unpk4_unorm8(unsigned w) { return (f32x4){(float)(w & 0xffu), (float)((w >> 8) & 0xffu), (float)((w >> 16) & 0xffu), (float)(w >> 24)} * (1.0f / 255.0f); }
__device__ __forceinline__ f32x4 unpk4_fp8(unsigned w) { const f32x2 lo = __builtin_amdgcn_cvt_pk_f32_fp8((int)w, false), hi = __builtin_amdgcn_cvt_pk_f32_fp8((int)w, true); return (f32x4){lo.x, lo.y, hi.x, hi.y}; }
constexpr float W8_SCALE = 32.0f, W8_INV = 1.0f / 32.0f;
__device__ __forceinline__ float bf_lo(unsigned w) { return __uint_as_float(w << 16); }
__device__ __forceinline__ float bf_hi(unsigned w) { return __uint_as_float(w & 0xffff0000u); }
__device__ __forceinline__ float wave_sum(float v) {
#pragma unroll
    for (int o = 1; o < 64; o <<= 1) v += __shfl_xor(v, o);
    return v;
}
template <int CTRL, int ROW_MASK> __device__ __forceinline__ float dpp_get(float v) { return __int_as_float(__builtin_amdgcn_update_dpp(0, __float_as_int(v), CTRL, ROW_MASK, 0xf, false)); }
__device__ __forceinline__ float wave_sum_u(float v) {
    v += dpp_get<0xB1, 0xf>(v);
    v += dpp_get<0x4E, 0xf>(v);
    v += dpp_get<0x141, 0xf>(v);
    v += dpp_get<0x140, 0xf>(v);
    v += dpp_get<0x142, 0xa>(v);
    v += dpp_get<0x143, 0xc>(v);
    return __int_as_float(__builtin_amdgcn_readlane(__float_as_int(v), 63));
}
__device__ __forceinline__ float wave_max(float v) {
#pragma unroll
    for (int o = 1; o < 64; o <<= 1) v = fmaxf(v, __shfl_xor(v, o));
    return v;
}
__device__ __forceinline__ float sigmoidf_(float x) { return __builtin_amdgcn_rcpf(1.0f + __builtin_amdgcn_exp2f(-1.4426950408889634f * x)); }

__device__ __forceinline__ int opaque_tid() { int t = threadIdx.x; asm volatile("" : "+v"(t)); return t; }

#define XB_TMO      128
#define XB_XCNT(j)  (256  + 64 * (j))
#define XB_XSUB(j)  (1280 + 64 * (j))
#define XB_XGEN(j)  (2304 + 64 * (j))
#define XB_TOP      3328
#define XB_TOPGEN   3392
#define XCD_BAR_WORDS 3456
#define XB_SPIN_CAP (1u << 24)
__device__ __forceinline__ unsigned xb_ld(unsigned* p)              { return __hip_atomic_load(p, __ATOMIC_RELAXED, __HIP_MEMORY_SCOPE_AGENT); }
__device__ __forceinline__ unsigned xb_add(unsigned* p, unsigned v) { return __hip_atomic_fetch_add(p, v, __ATOMIC_RELAXED, __HIP_MEMORY_SCOPE_AGENT); }
__device__ __forceinline__ unsigned xb_xcc_id() { return (unsigned)__builtin_amdgcn_s_getreg((3 << 11) | 20) & 0xFu; }
#define XB_SPIN(cond, bar) do { unsigned _sp = 0; while (cond) { __builtin_amdgcn_s_sleep(1); \
    if ((++_sp & 255u) == 0u) { if (xb_ld(&(bar)[XB_TMO])) break; if (_sp > XB_SPIN_CAP) { atomicAdd(&(bar)[XB_TMO], 1u); break; } } } } while (0)
struct XcdBarrier { unsigned* bar; unsigned x; volatile LAS unsigned* st; };
__device__ __forceinline__ XcdBarrier xcd_barrier_post(unsigned* bar, volatile LAS unsigned* st) {
    XcdBarrier b; b.bar = bar; b.x = xb_xcc_id(); b.st = st;
    if (threadIdx.x == 0) (void)xb_add(&bar[XB_XCNT(b.x)], 1u);
    return b;
}
__device__ __forceinline__ void xcd_barrier_complete(unsigned* bar, unsigned x, unsigned& nloc, unsigned& nx) {
    const unsigned G = gridDim.x * gridDim.y * gridDim.z;
    unsigned sum, cnt, mine, sp = 0u;
    for (;;) {
        sum = 0u; cnt = 0u; mine = 0u;
#pragma unroll
        for (unsigned j = 0; j < 16; ++j) { const unsigned c = xb_ld(&bar[XB_XCNT(j)]); sum += c; cnt += (c > 0u) ? 1u : 0u; mine = (j == x) ? c : mine; }
        if (sum == G) break;
        __builtin_amdgcn_s_sleep(1);
        if ((++sp & 255u) == 0u) { if (xb_ld(&bar[XB_TMO])) break; if (sp > XB_SPIN_CAP) { atomicAdd(&bar[XB_TMO], 1u); break; } }
    }
    nloc = mine > 0u ? mine : 1u; nx = cnt > 0u ? cnt : 1u;
}
__device__ __forceinline__ void xcd_barrier(const XcdBarrier& b) {
    asm volatile("s_waitcnt vmcnt(0)" ::: "memory");
    __syncthreads();
    if (threadIdx.x == 0) {
        unsigned* bar = b.bar;
        __builtin_amdgcn_s_waitcnt(0);
        unsigned nloc = b.st[0], nx = b.st[1];
        if (nloc == 0u) { xcd_barrier_complete(bar, b.x, nloc, nx); b.st[0] = nloc; b.st[1] = nx; }
        const unsigned old = xb_add(&bar[XB_XSUB(b.x)], 1u);
        const unsigned gen = old / nloc;
        if (old + 1u == (gen + 1u) * nloc) {
            __builtin_amdgcn_fence(__ATOMIC_RELEASE, "agent");
            asm volatile("s_waitcnt vmcnt(0)" ::: "memory");
            const unsigned og = xb_add(&bar[XB_TOP], 1u);
            const unsigned tg = og / nx;
            if (og + 1u == (tg + 1u) * nx) xb_add(&bar[XB_TOPGEN], 1u);
            else XB_SPIN(xb_ld(&bar[XB_TOPGEN]) == tg, bar);
            __builtin_amdgcn_fence(__ATOMIC_ACQUIRE, "agent");
            xb_add(&bar[XB_XGEN(b.x)], 1u);
            asm volatile("s_waitcnt vmcnt(0)" ::: "memory");
        } else {
            XB_SPIN(xb_ld(&bar[XB_XGEN(b.x)]) == gen, bar);
            __builtin_amdgcn_fence(__ATOMIC_ACQUIRE, "agent");
            asm volatile("s_waitcnt vmcnt(0)" ::: "memory");
        }
    }
    __syncthreads();
}

namespace pg8 {
constexpr int BM = 256, BK = 64, HALF = 128, HTB = HALF * BK * 2, STAGE_BYTES = 8 * HTB, NXCD = 8, WGM = 8;
__device__ __forceinline__ int lds_byte(int r, int c) { const int st = (r >> 4) * 2 + (c >> 5), rr = r & 15, cc = c & 31, ob = rr * 64 + cc * 2; return st * 1024 + (ob ^ (((ob >> 9) & 1) << 5)); }
__device__ __forceinline__ void stage_rc(int b, int& R, int& C) { const int st = b / 1024, sb = b % 1024, swz = sb ^ (((sb >> 9) & 1) << 5); R = (st >> 1) * 16 + swz / 64; C = (st & 1) * 32 + (swz % 64) / 2; }
__device__ __forceinline__ int perm32(int rho) { const int n = rho >> 4, i = rho & 15; return 8 * (i >> 2) + 4 * n + (i & 3); }

struct Unit { int pm, pn, ti; unsigned aoff, boff, aoff2, boff2; };
struct Gemm { const bf16* A; const bf16* Bt; };

template <int M_, int N_, int LDA, int LDB> struct StaticOrder {
    static constexpr int nM = M_ / BM, nN = N_ / BM, nwg = nM * nN;
    int G, c;
    __device__ void init(int G_, int c_) { G = G_; c = c_; }
    __device__ bool next(int i, Unit& u) const {
        const int L = i * G + c; if (L >= nwg) return false;
        int wgid = L; { constexpr int q = nwg / NXCD, r = nwg % NXCD; const int xcd = wgid % NXCD, off = wgid / NXCD; wgid = (xcd < r ? xcd * (q + 1) : r * (q + 1) + (xcd - r) * q) + off; }
        constexpr int nig = WGM * nN; const int gid = wgid / nig, fm = gid * WGM, gsz = (nM - fm) < WGM ? (nM - fm) : WGM;
        u.pm = fm + ((wgid % nig) % gsz); u.pn = (wgid % nig) / gsz; u.ti = i;
        u.aoff = (unsigned)u.pm * (unsigned)(BM * LDA * 2); u.boff = (unsigned)u.pn * (unsigned)(BM * LDB * 2); u.aoff2 = 0u; u.boff2 = 0u;
        return true;
    }
};
template <class Base> struct BranchOrder {
    Base S0; unsigned a_step, b_step;
    __device__ bool next(int i, Unit& u) const { if (!S0.next(i >> 1, u)) return false; const unsigned p = (unsigned)(i & 1); u.ti = (int)p; u.aoff += p * a_step; u.boff += p * b_step; return true; }
};
template <class Base> struct SplitOrder {
    Base S0; unsigned a2, b2;
    __device__ bool next(int i, Unit& u) const { if (!S0.next(i, u)) return false; u.aoff2 = u.aoff + a2; u.boff2 = u.boff + b2; return true; }
};
struct OneUnit {
    Unit u0;
    __device__ bool next(int i, Unit& u) const { if (i > 0) return false; u = u0; return true; }
};
struct MoeOrder {
    int G, c, NT; const LAS int* tpre; unsigned a_tile_bytes, b_exp_bytes, b_tile_bytes;
    __device__ bool next(int i, Unit& u) const {
        const int L = i * G + c; const int x = L & 7, a = L >> 3, pn = a & 7, q = a >> 3;
        const int rt = (G == 256) ? 32 * i + 4 * x + (c >> 6) : q * 8 + x;
        if (rt >= NT) return false;
        int e = 0;
#pragma unroll
        for (int j = 1; j < 16; ++j) e += (rt >= tpre[j]) ? 1 : 0;
        e = __builtin_amdgcn_readfirstlane(e);
        u.pm = rt; u.pn = pn; u.ti = i; u.aoff = (unsigned)rt * a_tile_bytes; u.boff = (unsigned)e * b_exp_bytes + (unsigned)pn * b_tile_bytes; u.aoff2 = 0u; u.boff2 = 0u;
        return true;
    }
};

#if !GEMM_FAST
template <class Epi, class Sched, bool GATHER, int LDA, int LDB, int KK>
__device__ __forceinline__ void gemm_phase(LAS unsigned char* lds, const Gemm g, const Sched& S, const Epi& E, const LAS int* tokTab) {
    const int tid = opaque_tid(), wid = __builtin_amdgcn_readfirstlane(tid >> 6), lane = tid & 63, wr = wid >> 2, wc = wid & 3, fr = lane & 15, fq = lane >> 4;
    Unit u;
    for (int i = 0; S.next(i, u); ++i) {
        f32x4 acc[2][2][4][2];
#pragma unroll
        for (int a = 0; a < 2; ++a)
#pragma unroll
            for (int b = 0; b < 2; ++b)
#pragma unroll
                for (int m = 0; m < 4; ++m)
#pragma unroll
                    for (int n = 0; n < 2; ++n) acc[a][b][m][n] = (f32x4){0.f, 0.f, 0.f, 0.f};
        const char* Ab = (const char*)g.A + u.aoff; const char* Bb = (const char*)g.Bt + u.boff;
        unsigned arow[2][4], brow[2][2];
#pragma unroll
        for (int ai = 0; ai < 2; ++ai)
#pragma unroll
            for (int m = 0; m < 4; ++m) { const int r = ai * HALF + wr * 64 + m * 16 + fr;
                arow[ai][m] = (GATHER ? (unsigned)tokTab[u.ti * 256 + r] : (unsigned)r) * (unsigned)(LDA * 2); }
#pragma unroll
        for (int bj = 0; bj < 2; ++bj)
#pragma unroll
            for (int n = 0; n < 2; ++n) { const int slot = 16 * n + fr; const int rb = bj * HALF + wc * 32 + (Epi::PERM ? perm32(slot) : slot); brow[bj][n] = (unsigned)rb * (unsigned)(LDB * 2); }
#pragma nounroll
        for (int k0 = 0; k0 < KK; k0 += 32) {
            bf16x8 Bf[2][2];
            const unsigned kb = (unsigned)(k0 + fq * 8) * 2u;
#pragma unroll
            for (int bj = 0; bj < 2; ++bj)
#pragma unroll
                for (int n = 0; n < 2; ++n) Bf[bj][n] = *(const bf16x8*)(Bb + brow[bj][n] + kb);
#pragma unroll
            for (int ai = 0; ai < 2; ++ai) {
                bf16x8 Af[4];
#pragma unroll
                for (int m = 0; m < 4; ++m) Af[m] = *(const bf16x8*)(Ab + arow[ai][m] + kb);
#pragma unroll
                for (int bj = 0; bj < 2; ++bj)
#pragma unroll
                    for (int m = 0; m < 4; ++m)
#pragma unroll
                        for (int n = 0; n < 2; ++n) acc[ai][bj][m][n] = __builtin_amdgcn_mfma_f32_16x16x32_bf16(Bf[bj][n], Af[m], acc[ai][bj][m][n], 0, 0, 0);
                asm volatile("" ::: "memory");
            }
        }
        E(acc, u, wr, wc, fr, fq);
    }
    (void)lds;
}
#else
template <class Epi, class Sched, bool GATHER, int LDA, int LDB, int KK, bool FP8 = false, int KSPLIT = 0>
__device__ __forceinline__ void gemm_phase(LAS unsigned char* lds, const Gemm g, const Sched& S, const Epi& E, const LAS int* tokTab) {
    constexpr bool ALIGN_EPI = true; constexpr int KS = KSPLIT;
    const int tid = opaque_tid(), wid = __builtin_amdgcn_readfirstlane(tid >> 6), lane = tid & 63, wr = wid >> 2, wc = wid & 3, fr = lane & 15, fq = lane >> 4;
    constexpr int nt = KK / BK;
    unsigned voffA[2], voffB[2];
#pragma unroll
    for (int i = 0; i < 2; ++i) { int R, C; stage_rc(tid * 16 + i * 8192, R, C); const int Rb = Epi::PERM ? ((R & ~31) + perm32(R & 31)) : R;
        voffA[i] = (unsigned)(R * LDA + C) * 2u; voffB[i] = (unsigned)(Rb * LDB + C) * 2u; }
    constexpr unsigned rowA = (unsigned)LDA * 2u;
    constexpr unsigned kstep = (unsigned)(BK * 2);
    constexpr unsigned hstepA = (unsigned)HALF * LDA * 2u, hstepB = (unsigned)HALF * LDB * 2u;
    const unsigned ldsw = (unsigned)wid * 1024u;
    const int aoff = lds_byte(wr * 64 + fr, fq * 8), boff = lds_byte(wc * 32 + fr, fq * 8);
#define PG8_SA(b, h) (((b) * 2 + (h)) * HTB)
#define PG8_SB(b, h) ((4 + (b) * 2 + (h)) * HTB)
#define PG8_STAGE(bufoff, gbase, uoff, voff) do { _Pragma("unroll") for (int _i = 0; _i < 2; ++_i) \
        __builtin_amdgcn_global_load_lds((const unsigned*)((const char*)(gbase) + (size_t)(unsigned)((uoff) + (voff)[_i])), (LAS unsigned*)(lds + (bufoff) + ldsw + _i * 8192), 16, 0, 0); } while (0)
#define PG8_STAGE_A(bufoff, p, hh, VA) do { if constexpr (GATHER) { PG8_STAGE(bufoff, g.A, p, VA[hh]); } else { PG8_STAGE(bufoff, g.A, (p) + (hh) * hstepA, voffA); } } while (0)
#define PG8_STAGE_B(bufoff, p) PG8_STAGE(bufoff, g.Bt, p, voffB)
#define PG8_LD32(p) __builtin_shufflevector(*(const LAS i32x4*)(p), *(const LAS i32x4*)((p) + 1024), 0, 1, 2, 3, 4, 5, 6, 7)
#define PG8_LDA(dst, b, h) do { if constexpr (FP8) { _Pragma("unroll") for (int m = 0; m < 4; ++m) dst##8[m] = PG8_LD32(lds + PG8_SA(b, h) + aoff + m * 2048); } \
        else { _Pragma("unroll") for (int m = 0; m < 4; ++m) _Pragma("unroll") for (int k = 0; k < 2; ++k) dst[m][k] = *(const LAS bf16x8*)(lds + PG8_SA(b, h) + aoff + m * 2048 + k * 1024); } } while (0)
#define PG8_LDB(dst, b, h) do { if constexpr (FP8) { _Pragma("unroll") for (int n = 0; n < 2; ++n) dst##8[n] = PG8_LD32(lds + PG8_SB(b, h) + boff + n * 2048); } \
        else { _Pragma("unroll") for (int n = 0; n < 2; ++n) _Pragma("unroll") for (int k = 0; k < 2; ++k) dst[n][k] = *(const LAS bf16x8*)(lds + PG8_SB(b, h) + boff + n * 2048 + k * 1024); } } while (0)
#define PG8_MMA(ai, bj, At, Bt) do { __builtin_amdgcn_s_setprio(1); _Pragma("unroll") for (int m = 0; m < 4; ++m) _Pragma("unroll") for (int n = 0; n < 2; ++n) { \
        if constexpr (FP8) { asm volatile("v_mfma_f32_16x16x128_f8f6f4 %0, %1, %2, %0" : "+v"(acc[ai][bj][m][n]) : "v"(Bt##8[n]), "v"(At##8[m])); }   \
        else { _Pragma("unroll") for (int k = 0; k < 2; ++k) acc[ai][bj][m][n] = __builtin_amdgcn_mfma_f32_16x16x32_bf16(Bt[n][k], At[m][k], acc[ai][bj][m][n], 0, 0, 0); } } \
        __builtin_amdgcn_s_setprio(0); } while (0)
#define PG8_WAIT_V(n) asm volatile("s_waitcnt vmcnt(" #n ")" ::: "memory")
#define PG8_WAIT_L(n) asm volatile("s_waitcnt lgkmcnt(" #n ")" ::: "memory")
#define PG8_BAR __builtin_amdgcn_s_barrier()
#define PG8_SCHED __builtin_amdgcn_sched_barrier(0)
#define PG8_AOFFS(dst, uu) do { _Pragma("unroll") for (int _i = 0; _i < 2; ++_i) { int _R, _C; stage_rc(tid * 16 + _i * 8192, _R, _C); _Pragma("unroll") for (int _h = 0; _h < 2; ++_h) \
        dst[_h][_i] = (unsigned)tokTab[(uu).ti * 256 + _h * HALF + _R] * rowA + (unsigned)_C * 2u; } } while (0)
#define PG8_TRIP(VC, V2) do { \
        PG8_LDB(B0, 0, 0); PG8_LDB(B1, 0, 1); PG8_SCHED; PG8_LDA(At, 0, 0); PG8_STAGE_A(PG8_SA(1, 1), a1, 1, VC); \
        PG8_WAIT_V(8); PG8_WAIT_L(0); PG8_BAR; PG8_MMA(0, 0, At, B0); PG8_MMA(0, 1, At, B1); PG8_BAR; PG8_SCHED; \
        PG8_LDA(At, 0, 1); PG8_STAGE_B(PG8_SB(0, 0), b2); PG8_STAGE_B(PG8_SB(0, 1), b2 + hstepB); PG8_STAGE_A(PG8_SA(0, 0), a2, 0, V2); \
        PG8_WAIT_V(8); PG8_WAIT_L(0); PG8_BAR; PG8_MMA(1, 0, At, B0); PG8_MMA(1, 1, At, B1); PG8_BAR; PG8_SCHED; \
        PG8_LDB(B0, 1, 0); PG8_LDB(B1, 1, 1); PG8_SCHED; PG8_LDA(At, 1, 0); PG8_STAGE_A(PG8_SA(0, 1), a2, 1, V2); \
        PG8_WAIT_V(8); PG8_WAIT_L(0); PG8_BAR; PG8_MMA(0, 0, At, B0); PG8_MMA(0, 1, At, B1); PG8_BAR; PG8_SCHED; \
        PG8_LDA(At, 1, 1); PG8_STAGE_B(PG8_SB(1, 0), b3); PG8_STAGE_B(PG8_SB(1, 1), b3 + hstepB); PG8_STAGE_A(PG8_SA(1, 0), a3, 0, V2); \
        PG8_WAIT_V(8); PG8_WAIT_L(0); PG8_BAR; PG8_MMA(1, 0, At, B0); PG8_MMA(1, 1, At, B1); PG8_BAR; PG8_SCHED; } while (0)
    Unit cur, nxt; int ui = 0;
    if (!S.next(0, cur)) return;
    f32x4 acc[2][2][4][2];
#pragma unroll
    for (int a = 0; a < 2; ++a)
#pragma unroll
        for (int b = 0; b < 2; ++b)
#pragma unroll
            for (int m = 0; m < 4; ++m)
#pragma unroll
                for (int n = 0; n < 2; ++n) acc[a][b][m][n] = (f32x4){0.f, 0.f, 0.f, 0.f};
    bf16x8 At[4][2], B0[2][2], B1[2][2]; i32x8 At8[4], B08[2], B18[2];
    unsigned vAc[2][2] = {{0u, 0u}, {0u, 0u}}, vAn[2][2] = {{0u, 0u}, {0u, 0u}};
    if constexpr (GATHER) { PG8_AOFFS(vAn, cur); vAc[1][0] = vAn[1][0]; vAc[1][1] = vAn[1][1]; }
    unsigned cA = cur.aoff, cB = cur.boff, cA2 = cur.aoff2, cB2 = cur.boff2;
#define PG8_KOFF(b1, b2, kt) ((KS != 0 && (kt) >= KS) ? (b2) + (unsigned)((kt) - KS) * kstep : (b1) + (unsigned)(kt) * kstep)
    PG8_STAGE_B(PG8_SB(0, 0), cB); PG8_STAGE_B(PG8_SB(0, 1), cB + hstepB); PG8_STAGE_A(PG8_SA(0, 0), cA, 0, vAn); PG8_STAGE_A(PG8_SA(0, 1), cA, 1, vAn);
    if (wr == 1) PG8_BAR;
    PG8_WAIT_V(2); PG8_BAR;
    PG8_STAGE_B(PG8_SB(1, 0), cB + kstep); PG8_STAGE_A(PG8_SA(1, 0), cA + kstep, 0, vAn); PG8_STAGE_B(PG8_SB(1, 1), cB + hstepB + kstep);
    PG8_WAIT_V(6); PG8_BAR;
    for (;;) {
        const bool has_next = S.next(ui + 1, nxt);
        const unsigned nA = has_next ? nxt.aoff : cA, nB = has_next ? nxt.boff : cB;
#pragma nounroll
        for (int t = 0; t < nt; t += 2) {
            const bool last = (t == nt - 2);
            const unsigned a1 = PG8_KOFF(cA, cA2, t + 1);
            const unsigned a2 = last ? nA : PG8_KOFF(cA, cA2, t + 2), b2 = last ? nB : PG8_KOFF(cB, cB2, t + 2);
            const unsigned a3 = a2 + kstep, b3 = b2 + kstep;
            if constexpr (GATHER) { if (last && has_next) { PG8_AOFFS(vAn, nxt); } }
            if constexpr (KS != 0) { if (t == KS) {
                if constexpr (FP8) asm volatile("s_nop 15\n\ts_nop 15" ::: "memory");
                E.mid(acc, cur, wr, wc, fr, fq); } }
            PG8_TRIP(vAc, vAn);
        }
        if constexpr (ALIGN_EPI) { if (wr == 0) PG8_BAR; }
        if constexpr (FP8) asm volatile("s_nop 15\n\ts_nop 15" ::: "memory");
        E(acc, cur, wr, wc, fr, fq);
        if (!has_next) break;
#pragma unroll
        for (int a = 0; a < 2; ++a)
#pragma unroll
            for (int b = 0; b < 2; ++b)
#pragma unroll
                for (int m = 0; m < 4; ++m)
#pragma unroll
                    for (int n = 0; n < 2; ++n) acc[a][b][m][n] = (f32x4){0.f, 0.f, 0.f, 0.f};
        cur = nxt; cA = nA; cB = nB; cA2 = cur.aoff2; cB2 = cur.boff2; ++ui;
        if constexpr (GATHER) { vAc[1][0] = vAn[1][0]; vAc[1][1] = vAn[1][1]; }
        if constexpr (ALIGN_EPI) { if (wr == 1) PG8_BAR; }
    }
    PG8_WAIT_V(0);
    if constexpr (!ALIGN_EPI) { if (wr == 0) PG8_BAR; }
    PG8_BAR;
#undef PG8_SA
#undef PG8_SB
#undef PG8_STAGE
#undef PG8_STAGE_A
#undef PG8_STAGE_B
#undef PG8_LDA
#undef PG8_LD32
#undef PG8_LDB
#undef PG8_MMA
#undef PG8_WAIT_V
#undef PG8_WAIT_L
#undef PG8_BAR
#undef PG8_SCHED
#undef PG8_AOFFS
#undef PG8_TRIP
#undef PG8_KOFF
    (void)rowA; (void)vAn;
}
#endif

typedef f32x4 Acc[2][2][4][2];
__device__ __forceinline__ u32x4 pack8(const f32x4 v0, const f32x4 v1) { u32x4 w; w.x = cvt_pk_bf16(v0[0], v0[1]); w.y = cvt_pk_bf16(v0[2], v0[3]); w.z = cvt_pk_bf16(v1[0], v1[1]); w.w = cvt_pk_bf16(v1[2], v1[3]); return w; }
__device__ __forceinline__ void unpack8(const u32x4 w, f32x4& v0, f32x4& v1) { v0 = (f32x4){bf_lo(w.x), bf_hi(w.x), bf_lo(w.y), bf_hi(w.y)}; v1 = (f32x4){bf_lo(w.z), bf_hi(w.z), bf_lo(w.w), bf_hi(w.w)}; }

struct EpiProj {
    static constexpr bool PERM = true;
    bf16* UQKV; bf16* Gt; const float* bgate; float mul; int pn_off;
    __device__ __forceinline__ void operator()(const Acc& acc, const Unit& u, int wr, int wc, int fr, int fq) const {
        const int row0 = u.pm * BM + wr * 64 + fr; const int pn = u.pn + pn_off;
        if (pn < 16) {
            bf16* base = UQKV + (size_t)(pn >> 2) * ((size_t)T * 1024) + (pn & 3) * 256 + wc * 32 + 8 * fq;
#pragma unroll
            for (int ai = 0; ai < 2; ++ai)
#pragma unroll
                for (int m = 0; m < 4; ++m) { bf16* rowp = base + (size_t)(row0 + ai * HALF + m * 16) * 1024;
#pragma unroll
                    for (int bj = 0; bj < 2; ++bj) *(u32x4*)(rowp + bj * HALF) = pack8(acc[ai][bj][m][0] * mul, acc[ai][bj][m][1] * mul); }
        } else {
            const int gc = (pn - 16) * 256 + wc * 32 + 8 * fq;
            f32x4 bv[2][2];
#pragma unroll
            for (int bj = 0; bj < 2; ++bj)
#pragma unroll
                for (int n = 0; n < 2; ++n) bv[bj][n] = *(const f32x4*)(bgate + gc + bj * HALF + 4 * n);
#pragma unroll
            for (int ai = 0; ai < 2; ++ai)
#pragma unroll
                for (int m = 0; m < 4; ++m) { unsigned char* rowp = (unsigned char*)Gt + (size_t)(row0 + ai * HALF + m * 16) * 4096 + gc;
#pragma unroll
                    for (int bj = 0; bj < 2; ++bj) { f32x4 v0 = acc[ai][bj][m][0] * mul + bv[bj][0], v1 = acc[ai][bj][m][1] * mul + bv[bj][1];
#pragma unroll
                        for (int j = 0; j < 4; ++j) { v0[j] = sigmoidf_(v0[j]); v1[j] = sigmoidf_(v1[j]); }
                        u32x2 w; w.x = pk4_unorm8(v0); w.y = pk4_unorm8(v1); *(u32x2*)(rowp + bj * HALF) = w; } }
        }
    }
};
struct EpiPool {
    static constexpr bool PERM = true;
    bf16* PO; const float* pscale; int g; unsigned char* PO8;
    __device__ __forceinline__ void operator()(const Acc& acc, const Unit& u, int wr, int wc, int fr, int fq) const {
        const int row0 = u.pm * BM + wr * 64 + fr; const int c0 = g * 256 + wc * 32 + 8 * fq;
        f32x4 sv[2][2];
#pragma unroll
        for (int bj = 0; bj < 2; ++bj)
#pragma unroll
            for (int n = 0; n < 2; ++n) sv[bj][n] = *(const f32x4*)(pscale + c0 + bj * HALF + 4 * n);
#pragma unroll
        for (int ai = 0; ai < 2; ++ai)
#pragma unroll
            for (int m = 0; m < 4; ++m) { const size_t ro = (size_t)(row0 + ai * HALF + m * 16) * 1024 + c0;
#pragma unroll
                for (int bj = 0; bj < 2; ++bj) { const f32x4 v0 = acc[ai][bj][m][0] * sv[bj][0], v1 = acc[ai][bj][m][1] * sv[bj][1];
                    if (PO8) { u32x2 w; w.x = pk4_fp8(v0[0], v0[1], v0[2], v0[3]); w.y = pk4_fp8(v1[0], v1[1], v1[2], v1[3]); *(u32x2*)(PO8 + ro + bj * HALF) = w; }
                    else *(u32x4*)(PO + ro + bj * HALF) = pack8(v0, v1); } }
    }
};
template <bool SECOND> struct EpiBranch {
    static constexpr bool PERM = true;
    bf16* MG; const bf16* Gt;
    __device__ __forceinline__ void operator()(const Acc& acc, const Unit& u, int wr, int wc, int fr, int fq) const {
        const int row0 = u.pm * BM + wr * 64 + fr; const int c0 = u.pn * BM + wc * 32 + 8 * fq;
#pragma unroll
        for (int ai = 0; ai < 2; ++ai)
#pragma unroll
            for (int m = 0; m < 4; ++m) { const size_t row = (size_t)(row0 + ai * HALF + m * 16);
#pragma unroll
                for (int bj = 0; bj < 2; ++bj) {
                    const u32x4 gw = *(const u32x4*)(Gt + row * 4096 + (SECOND ? 2048 : 0) + c0 + bj * HALF);
                    f32x4 g0, g1; unpack8(gw, g0, g1);
                    f32x4 v0 = acc[ai][bj][m][0] * g0, v1 = acc[ai][bj][m][1] * g1;
                    bf16* p = MG + row * 2048 + c0 + bj * HALF;
                    if (SECOND) { const u32x4 ow = *(const u32x4*)p; f32x4 o0, o1; unpack8(ow, o0, o1); v0 += o0; v1 += o1; }
                    *(u32x4*)p = pack8(v0, v1); } }
    }
};
struct EpiBranchRT {
    static constexpr bool PERM = true;
    bf16* MG; const bf16* Gt; unsigned char* MG8; float mul;
    __device__ __forceinline__ void operator()(const Acc& acc, const Unit& u, int wr, int wc, int fr, int fq) const {
        const int row0 = u.pm * BM + wr * 64 + fr; const int c0 = u.pn * BM + wc * 32 + 8 * fq; const bool second = u.ti != 0;
#pragma unroll
        for (int ai = 0; ai < 2; ++ai)
#pragma unroll
            for (int m = 0; m < 4; ++m) { const size_t row = (size_t)(row0 + ai * HALF + m * 16);
#pragma unroll
                for (int bj = 0; bj < 2; ++bj) {
                    const u32x2 gw = *(const u32x2*)((const unsigned char*)Gt + row * 4096 + (second ? 2048 : 0) + c0 + bj * HALF);
                    const f32x4 g0 = unpk4_unorm8(gw.x), g1 = unpk4_unorm8(gw.y);
                    f32x4 v0 = acc[ai][bj][m][0] * mul * g0, v1 = acc[ai][bj][m][1] * mul * g1;
                    bf16* p = MG + row * 2048 + c0 + bj * HALF;
                    if (second) { const u32x4 ow = *(const u32x4*)p; f32x4 o0, o1; unpack8(ow, o0, o1); v0 += o0; v1 += o1; }
                    if (second && MG8) { u32x2 w; w.x = pk4_fp8(v0[0], v0[1], v0[2], v0[3]); w.y = pk4_fp8(v1[0], v1[1], v1[2], v1[3]); *(u32x2*)(MG8 + row * 2048 + c0 + bj * HALF) = w; }
                    else *(u32x4*)p = pack8(v0, v1); } }
    }
};
struct EpiMerge {
    static constexpr bool PERM = true;
    bf16* MG; const unsigned char* G8; unsigned char* MG8; float mul;
    __device__ __forceinline__ void mid(Acc& acc, const Unit& u, int wr, int wc, int fr, int fq) const {
        const unsigned o0 = (unsigned)(u.pm * BM + wr * 64 + fr) * 4096u + (unsigned)(u.pn * BM + wc * 32 + 8 * fq);
#pragma unroll
        for (int am = 0; am < 4; ++am) { const int ai = am >> 1, m0 = (am & 1) * 2;
            u32x2 ga[2][2], gb[2][2];
#pragma unroll
            for (int mm = 0; mm < 2; ++mm) { const unsigned char* gp = G8 + (o0 + (unsigned)((ai * HALF + (m0 + mm) * 16) * 4096));
                ga[mm][0] = *(const u32x2*)(gp); gb[mm][0] = *(const u32x2*)(gp + 2048); ga[mm][1] = *(const u32x2*)(gp + HALF); gb[mm][1] = *(const u32x2*)(gp + 2048 + HALF); }
            __builtin_amdgcn_sched_barrier(0);
#pragma unroll
            for (int mm = 0; mm < 2; ++mm) { const int m = m0 + mm;
#pragma unroll
                for (int bj = 0; bj < 2; ++bj) { const u32x2 a = ga[mm][bj], b = gb[mm][bj];
                    const f32x4 g00 = unpk4_u8(a.x), g01 = unpk4_u8(a.y); f32x4 g10 = unpk4_u8(b.x), g11 = unpk4_u8(b.y);
#pragma unroll
                    for (int j = 0; j < 4; ++j) { acc[ai][bj][m][0][j] *= g00[j] * __builtin_amdgcn_rcpf(fmaxf(g10[j], 1.0f)); acc[ai][bj][m][1][j] *= g01[j] * __builtin_amdgcn_rcpf(fmaxf(g11[j], 1.0f)); } } }
            __builtin_amdgcn_sched_barrier(0);
        }
    }
    __device__ __forceinline__ void operator()(const Acc& acc, const Unit& u, int wr, int wc, int fr, int fq) const {
        const int row0 = u.pm * BM + wr * 64 + fr; const int c0 = u.pn * BM + wc * 32 + 8 * fq;
#pragma unroll
        for (int ai = 0; ai < 2; ++ai)
#pragma unroll
            for (int m = 0; m < 4; ++m) { const size_t row = (size_t)(row0 + ai * HALF + m * 16);
#pragma unroll
                for (int bj = 0; bj < 2; ++bj) { const u32x2 b = *(const u32x2*)(G8 + row * 4096 + 2048 + c0 + bj * HALF);
                    f32x4 g10 = unpk4_unorm8(b.x), g11 = unpk4_unorm8(b.y);
#pragma unroll
                    for (int j = 0; j < 4; ++j) { g10[j] = fmaxf(g10[j], 1.0f / 255.0f) * mul; g11[j] = fmaxf(g11[j], 1.0f / 255.0f) * mul; }
                    const f32x4 v0 = acc[ai][bj][m][0] * g10, v1 = acc[ai][bj][m][1] * g11;
                    if (MG8) { u32x2 w; w.x = pk4_fp8(v0[0], v0[1], v0[2], v0[3]); w.y = pk4_fp8(v1[0], v1[1], v1[2], v1[3]); *(u32x2*)(MG8 + row * 2048 + c0 + bj * HALF) = w; }
                    else *(u32x4*)(MG + row * 2048 + c0 + bj * HALF) = pack8(v0, v1); } }
    }
};
struct EpiOut {
    static constexpr bool PERM = true;
    bf16* DL; const float* gate; float mul;
    __device__ __forceinline__ void operator()(const Acc& acc, const Unit& u, int wr, int wc, int fr, int fq) const {
        const int row0 = u.pm * BM + wr * 64 + fr, c0 = u.pn * BM + wc * 32 + 8 * fq;
        const float* gp = gate + (size_t)(u.pm >> 3) * MODW + c0;
        f32x4 gv[2][2];
#pragma unroll
        for (int bj = 0; bj < 2; ++bj)
#pragma unroll
            for (int n = 0; n < 2; ++n) gv[bj][n] = *(const f32x4*)(gp + bj * HALF + 4 * n) * mul;
#pragma unroll
        for (int ai = 0; ai < 2; ++ai)
#pragma unroll
            for (int m = 0; m < 4; ++m) { bf16* rowp = DL + (size_t)(row0 + ai * HALF + m * 16) * DM + c0;
#pragma unroll
                for (int bj = 0; bj < 2; ++bj) *(u32x4*)(rowp + bj * HALF) = pack8(acc[ai][bj][m][0] * gv[bj][0], acc[ai][bj][m][1] * gv[bj][1]); }
    }
};
struct EpiSwiglu {
    static constexpr bool PERM = true;
    bf16* ACT;
    __device__ __forceinline__ void operator()(const Acc& acc, const Unit& u, int wr, int wc, int fr, int fq) const {
        const int row0 = u.pm * BM + wr * 64 + fr; const int c0 = u.pn * 128 + wc * 32 + 8 * fq;
#pragma unroll
        for (int ai = 0; ai < 2; ++ai)
#pragma unroll
            for (int m = 0; m < 4; ++m) { f32x4 v[2];
#pragma unroll
                for (int n = 0; n < 2; ++n)
#pragma unroll
                    for (int j = 0; j < 4; ++j) { const float a = acc[ai][0][m][n][j]; v[n][j] = a * sigmoidf_(a) * acc[ai][1][m][n][j]; }
                *(u32x4*)(ACT + (size_t)(row0 + ai * HALF + m * 16) * 1024 + c0) = pack8(v[0], v[1]); }
    }
};
struct EpiSwiglu8 {
    static constexpr bool PERM = true;
    unsigned char* ACT8;
    __device__ __forceinline__ void operator()(const Acc& acc, const Unit& u, int wr, int wc, int fr, int fq) const {
        const int row0 = u.pm * BM + wr * 64 + fr; const int c0 = u.pn * 128 + wc * 32 + 8 * fq;
#pragma unroll
        for (int ai = 0; ai < 2; ++ai)
#pragma unroll
            for (int m = 0; m < 4; ++m) { f32x4 v[2];
#pragma unroll
                for (int n = 0; n < 2; ++n)
#pragma unroll
                    for (int j = 0; j < 4; ++j) { const float a = acc[ai][0][m][n][j] * W8_INV; v[n][j] = a * sigmoidf_(a) * (acc[ai][1][m][n][j] * W8_INV); }
                u32x2 w; w.x = pk4_fp8(v[0][0], v[0][1], v[0][2], v[0][3]); w.y = pk4_fp8(v[1][0], v[1][1], v[1][2], v[1][3]);
                *(u32x2*)(ACT8 + (size_t)(row0 + ai * HALF + m * 16) * 1024 + c0) = w; }
    }
};
struct EpiDown {
    static constexpr bool PERM = true;
    bf16* YB; float mul;
    __device__ __forceinline__ void operator()(const Acc& acc, const Unit& u, int wr, int wc, int fr, int fq) const {
        const int row0 = u.pm * BM + wr * 64 + fr; const int c0 = u.pn * BM + wc * 32 + 8 * fq;
#pragma unroll
        for (int ai = 0; ai < 2; ++ai)
#pragma unroll
            for (int m = 0; m < 4; ++m) { bf16* rowp = YB + (size_t)(row0 + ai * HALF + m * 16) * 2048 + c0;
#pragma unroll
                for (int bj = 0; bj < 2; ++bj) { const f32x4 v0 = acc[ai][bj][m][0] * mul, v1 = acc[ai][bj][m][1] * mul;
                    if (YB_FP8) { u32x2 w; w.x = pk4_fp8(v0[0], v0[1], v0[2], v0[3]); w.y = pk4_fp8(v1[0], v1[1], v1[2], v1[3]); *(u32x2*)((unsigned char*)YB + (size_t)(row0 + ai * HALF + m * 16) * 2048 + c0 + bj * HALF) = w; }
                    else *(u32x4*)(rowp + bj * HALF) = pack8(v0, v1); } }
    }
};
}

struct Args { const float* in[20]; float* out; unsigned char* ws; int ph_lo, ph_hi; };
enum { I_X = 0, I_C, I_WADA, I_BADA, I_NMIX, I_NMOE, I_WIN, I_BF, I_WPOOL, I_PSCALE, I_WBR, I_WGATE, I_BGATE, I_WOUT, I_WROUTER, I_BROUTER, I_WEG, I_WEU, I_WED, I_NFINAL };

__device__ __forceinline__ const __attribute__((address_space(4))) char* kernarg_opaque() {
    const __attribute__((address_space(4))) char* kp = (const __attribute__((address_space(4))) char*)__builtin_amdgcn_kernarg_segment_ptr();
    asm volatile("" : "+s"(kp));
    return kp;
}
__device__ __forceinline__ const float* arg_in(int k) { return *(const float* const __attribute__((address_space(4)))*)(kernarg_opaque() + 8 * k); }
__device__ __forceinline__ int arg_i32(int byte_off) { return *(const int __attribute__((address_space(4)))*)(kernarg_opaque() + byte_off); }
#define ARG_IN(k) arg_in(k)
extern __shared__ __attribute__((aligned(16))) unsigned char lds_raw[];
struct Frame {
    LAS unsigned char* lds;
    int tid, lane, wave, vcu, G;
    float* out;
    unsigned char* ws;
};
__device__ __forceinline__ void frame_refresh(Frame& F) {
    F.lds = (LAS unsigned char*)lds_raw;
    F.tid = opaque_tid(); F.lane = F.tid & 63; F.wave = __builtin_amdgcn_readfirstlane(F.tid >> 6);
    F.G = gridDim.x; { const int bx = blockIdx.x; F.vcu = (F.G % 8 == 0) ? (bx % 8) * (F.G / 8) + bx / 8 : bx; }
    F.out = (float*)arg_in(20); F.ws = (unsigned char*)arg_in(21);
}

struct CvtItem { const float* src; bf16* dst; int srcStride, dstK, k0, n0, rowBase, mode, fp8; };
constexpr int CVT_PER_LAYER = 256 + 256 + 8 + 128 + 128 + 1024 + 1024 + 1024;
__device__ __forceinline__ CvtItem cvt_item(const Frame& F, int it) {
    const int l = it / CVT_PER_LAYER; int r = it % CVT_PER_LAYER;
    unsigned char* wl = F.ws + WS_W + (size_t)l * W_LAYER;
    CvtItem c; c.mode = 0; c.rowBase = 0; c.fp8 = 0;
    if (r < 256) { c.src = ARG_IN(I_WIN) + (size_t)l * DM * INW; c.srcStride = INW; c.dst = (bf16*)(wl + WO_PG); c.dstK = DM; c.k0 = 128 * (r >> 4); c.n0 = 256 * (r & 15); c.fp8 = (G1_FP8 == 2); return c; } r -= 256;
    if (r < 256) { c.src = ARG_IN(I_WGATE) + (size_t)l * DM * 4096; c.srcStride = 4096; c.dst = (bf16*)(wl + WO_PG + (G1_FP8 == 1 ? 16 * MiB : 0)); c.dstK = DM; c.k0 = 128 * (r >> 4); c.n0 = 256 * (r & 15); c.rowBase = (G1_FP8 == 1 ? 0 : 4096); c.fp8 = (G1_FP8 >= 1); return c; } r -= 256;
    if (r < 8) { const int g = r >> 1; c.src = ARG_IN(I_WPOOL) + ((size_t)l * 4 + g) * 65536; c.srcStride = 256; c.dst = (bf16*)(wl + WO_POOL) + (size_t)g * 65536; c.dstK = 256; c.k0 = 128 * (r & 1); c.n0 = 0; return c; } r -= 8;
    if (r < 128) { const int n = r >> 6, q = r & 63; c.src = ARG_IN(I_WBR) + ((size_t)l * 2 + n) * 1024 * 2048; c.srcStride = 2048; c.dst = G2_FP8 ? (bf16*)(wl + WO_BR + (size_t)n * 2048 * 1024) : (bf16*)(wl + WO_BR) + (size_t)n * 2048 * 1024; c.dstK = 1024; c.fp8 = G2_FP8; c.k0 = 128 * (q >> 3); c.n0 = 256 * (q & 7); return c; } r -= 128;
    if (r < 128) { c.src = ARG_IN(I_WOUT) + (size_t)l * DM * DM; c.srcStride = DM; c.dst = (bf16*)(wl + WO_OUT); c.dstK = DM; c.k0 = 128 * (r >> 3); c.n0 = 256 * (r & 7); c.fp8 = G3_FP8; return c; } r -= 128;
    if (r < 2048) { const int up = r >= 1024; if (up) r -= 1024; const int e = r >> 6, q = r & 63;
        c.src = (up ? ARG_IN(I_WEU) : ARG_IN(I_WEG)) + ((size_t)l * NE + e) * DM * DE; c.srcStride = DE; c.dst = MOE_FP8 ? (bf16*)(wl + WO_GU + (size_t)e * 2048 * 2048) : (bf16*)(wl + WO_GU) + (size_t)e * 2048 * 2048; c.dstK = DM; c.fp8 = MOE_FP8; c.k0 = 128 * (q >> 2); c.n0 = 256 * (q & 3); c.mode = up ? 2 : 1; return c; } r -= 2048;
    { const int e = r >> 6, q = r & 63; c.src = ARG_IN(I_WED) + ((size_t)l * NE + e) * DE * DM; c.srcStride = DM; c.dst = MOE_FP8 ? (bf16*)(wl + WO_D + (size_t)e * 2048 * 1024) : (bf16*)(wl + WO_D) + (size_t)e * 2048 * 1024; c.dstK = DE; c.fp8 = MOE_FP8; c.k0 = 128 * (q >> 3); c.n0 = 256 * (q & 7); return c; }
}
__device__ __forceinline__ void cvt_load(const CvtItem& c, int wave, int lane, f32x4 (&v)[16]) {
    const float* p = c.src + (size_t)(c.k0 + wave * 16) * c.srcStride + c.n0 + 4 * lane;
#pragma unroll
    for (int j = 0; j < 16; ++j) v[j] = __builtin_nontemporal_load((const f32x4*)(p + (size_t)j * c.srcStride));
}
__device__ __forceinline__ void p0_mod_task(Frame& F, int q, const LAS float* cact) {
    const int ks = q & 3, cgq = q >> 2, l = cgq / 192, col0 = (cgq % 192) * 64, kq = F.lane >> 4, cl = (F.lane & 15) * 4;
    const int kbase = ks * 512;
    const float* wp = ARG_IN(I_WADA) + ((size_t)l * DM + kbase + kq) * MODW + col0 + cl;
    f32x4 acc[8];
#pragma unroll
    for (int b = 0; b < 8; ++b) acc[b] = (f32x4){0.f, 0.f, 0.f, 0.f};
    for (int i0 = 0; i0 < 128; i0 += 8) {
        f32x4 w[8];
#pragma unroll
        for (int j = 0; j < 8; ++j) w[j] = __builtin_nontemporal_load((const f32x4*)(wp + (size_t)(4 * (i0 + j)) * MODW));
#pragma unroll
        for (int j = 0; j < 8; ++j) { const int k = kbase + 4 * (i0 + j) + kq; const f32x4 c0 = *(const LAS f32x4*)(cact + k * 8), c1 = *(const LAS f32x4*)(cact + k * 8 + 4);
#pragma unroll
            for (int b = 0; b < 4; ++b) { acc[b] += c0[b] * w[j]; acc[4 + b] += c1[b] * w[j]; } }
    }
#pragma unroll
    for (int b = 0; b < 8; ++b)
#pragma unroll
        for (int j = 0; j < 4; ++j) { float v = acc[b][j]; v += __shfl_xor(v, 16); v += __shfl_xor(v, 32); acc[b][j] = v; }
    if (kq == 0) {
        f32x4 bv = (f32x4){0.f, 0.f, 0.f, 0.f};
        if (ks == 0) bv = *(const f32x4*)(ARG_IN(I_BADA) + (size_t)l * MODW + col0 + cl);
        float* mp = (float*)(F.ws + WS_MODP) + ((size_t)ks * 2 + l) * 8 * MODW + col0 + cl;
#pragma unroll
        for (int b = 0; b < 8; ++b) *(f32x4*)(mp + (size_t)b * MODW) = acc[b] + bv;
    }
}
__device__ __forceinline__ f32x4 modp_sum(const float* modp, size_t idx) {
    constexpr size_t Q = (size_t)2 * 8 * MODW;
    const f32x4 a = *(const f32x4*)(modp + idx), b = *(const f32x4*)(modp + Q + idx), c = *(const f32x4*)(modp + 2 * Q + idx), d = *(const f32x4*)(modp + 3 * Q + idx);
    return ((a + b) + c) + d;
}
__device__ __forceinline__ void cvt_to_lds(const CvtItem& c, const f32x4 (&v)[16], LAS unsigned char* tile, int wave, int lane) {
    if (c.fp8) {
#pragma unroll
        for (int i = 0; i < 4; ++i) { u32x4 w;
            w.x = pk4_fp8(v[0][i] * W8_SCALE, v[1][i] * W8_SCALE, v[2][i] * W8_SCALE, v[3][i] * W8_SCALE); w.y = pk4_fp8(v[4][i] * W8_SCALE, v[5][i] * W8_SCALE, v[6][i] * W8_SCALE, v[7][i] * W8_SCALE);
            w.z = pk4_fp8(v[8][i] * W8_SCALE, v[9][i] * W8_SCALE, v[10][i] * W8_SCALE, v[11][i] * W8_SCALE); w.w = pk4_fp8(v[12][i] * W8_SCALE, v[13][i] * W8_SCALE, v[14][i] * W8_SCALE, v[15][i] * W8_SCALE);
            *(LAS u32x4*)(tile + (4 * lane + i) * 144 + wave * 16) = w; }
    } else {
#pragma unroll
        for (int i = 0; i < 4; ++i)
#pragma unroll
            for (int o = 0; o < 2; ++o) { u32x4 w; w.x = cvt_pk_bf16(v[8 * o + 0][i], v[8 * o + 1][i]); w.y = cvt_pk_bf16(v[8 * o + 2][i], v[8 * o + 3][i]); w.z = cvt_pk_bf16(v[8 * o + 4][i], v[8 * o + 5][i]); w.w = cvt_pk_bf16(v[8 * o + 6][i], v[8 * o + 7][i]);
                *(LAS u32x4*)(tile + (4 * lane + i) * 272 + (wave * 16 + 8 * o) * 2) = w; }
    }
}
__device__ __forceinline__ void cvt_store(const CvtItem& cc, const LAS unsigned char* tile, int tid) {
    if (cc.fp8) {
#pragma unroll
        for (int qq = 0; qq < 4; ++qq) { const int ch = tid + 512 * qq, nn = ch >> 3, c16 = ch & 7; const int n = cc.n0 + nn;
            const int drow = cc.mode == 0 ? cc.rowBase + n : 256 * (n >> 7) + (n & 127) + (cc.mode == 2 ? 128 : 0);
            const u32x4 w = *(const LAS u32x4*)(tile + nn * 144 + c16 * 16);
            *(u32x4*)((unsigned char*)cc.dst + (size_t)drow * cc.dstK + cc.k0 + c16 * 16) = w; }
    } else {
#pragma unroll
        for (int qq = 0; qq < 8; ++qq) { const int ch = tid + 512 * qq, nn = ch >> 4, c16 = ch & 15; const int n = cc.n0 + nn;
            const int drow = cc.mode == 0 ? cc.rowBase + n : 256 * (n >> 7) + (n & 127) + (cc.mode == 2 ? 128 : 0);
            const u32x4 w = *(const LAS u32x4*)(tile + nn * 272 + c16 * 16);
            *(u32x4*)(cc.dst + (size_t)drow * cc.dstK + cc.k0 + c16 * 8) = w; }
    }
}
#ifndef Q_A
#define Q_A 1152
#endif
#ifndef Q_1
#define Q_1 768
#endif
constexpr int Q_B = 1024, Q_COUNT = Q_A + Q_B, Q_FIRST = 2 * CVT_PER_LAYER - Q_COUNT, CW_QUEUE = 12800;
__device__ __forceinline__ void cvt_queue_drain(Frame& F, int which, int first, int count) {
    LAS unsigned char* tile = F.lds;
    volatile LAS int* slot = (volatile LAS int*)(F.lds + X_MISC) + 60;
    unsigned* q = (unsigned*)(F.ws + WS_CTL) + CW_QUEUE + 64 * which;
    __syncthreads();
    int t_next = 0;
    if (F.tid == 0) { const int ta = (int)__hip_atomic_fetch_add(q, 1u, __ATOMIC_RELAXED, __HIP_MEMORY_SCOPE_AGENT); t_next = (int)__hip_atomic_fetch_add(q, 1u, __ATOMIC_RELAXED, __HIP_MEMORY_SCOPE_AGENT); slot[0] = ta < count ? ta : -1; }
    __syncthreads();
    int qi = __builtin_amdgcn_readfirstlane(slot[0]);
    f32x4 v[16];
    CvtItem c = cvt_item(F, first + (qi >= 0 ? qi : 0));
    if (qi >= 0) cvt_load(c, F.wave, F.lane, v);
    while (qi >= 0) {
        if (F.tid == 0) { slot[0] = t_next < count ? t_next : -1; t_next = (int)__hip_atomic_fetch_add(q, 1u, __ATOMIC_RELAXED, __HIP_MEMORY_SCOPE_AGENT); }
        cvt_to_lds(c, v, tile, F.wave, F.lane);
        __syncthreads();
        const CvtItem cc = c;
        const int nq = __builtin_amdgcn_readfirstlane(slot[0]);
        if (nq >= 0) { c = cvt_item(F, first + nq); cvt_load(c, F.wave, F.lane, v); }
        cvt_store(cc, tile, F.tid);
        __syncthreads();
        qi = nq;
    }
}
__device__ __forceinline__ void p0_prologue(Frame& F) {
    LAS float* cact = (LAS float*)(F.lds);
    LAS unsigned char* tile = F.lds + 65536;
    {   const float* cin = ARG_IN(I_C);
#pragma unroll
        for (int h = 0; h < 2; ++h) { float cv[16];
#pragma unroll
            for (int k = 0; k < 16; ++k) cv[k] = cin[F.tid + (h * 16 + k) * NTHREADS];
            __builtin_amdgcn_sched_barrier(0);
#pragma unroll
            for (int k = 0; k < 16; ++k) { const int i = F.tid + (h * 16 + k) * NTHREADS, b = i / DM, kk = i % DM; cact[kk * 8 + b] = cv[k] * sigmoidf_(cv[k]); }
            __builtin_amdgcn_sched_barrier(0); } }
    __syncthreads();
    { const int q = F.wave * F.G + F.vcu; if (q < 1536) p0_mod_task(F, q, cact); }
    constexpr int NITEMS = Q_FIRST;
    int it = F.vcu;
    f32x4 v[16];
    CvtItem c = cvt_item(F, it < NITEMS ? it : 0);
    if (it < NITEMS) cvt_load(c, F.wave, F.lane, v);
    while (it < NITEMS) {
        cvt_to_lds(c, v, tile, F.wave, F.lane);
        __syncthreads();
        const CvtItem cc = c;
        const int nit = it + F.G;
        if (nit < NITEMS) { c = cvt_item(F, nit); cvt_load(c, F.wave, F.lane, v); }
        cvt_store(cc, tile, F.tid);
        __syncthreads();
        it = nit;
    }
}

__device__ __forceinline__ void load_expert_tables(Frame& F, int lc) {
    volatile LAS int* misc = (volatile LAS int*)(F.lds + X_MISC);
    if (F.tid < 16) {
        const int c = (int)__hip_atomic_load((unsigned*)(F.ws + WS_CTL) + CW_CNT + (lc * 16 + F.tid) * 64, RLX_AGENT);
        misc[32 + F.tid] = c;
        const int v = (c + 255) >> 8; int incl = v;
#pragma unroll
        for (int o = 1; o < 16; o <<= 1) { const int nb = __shfl_up(incl, o); if (F.tid >= o) incl += nb; }
        misc[8 + F.tid] = incl - v;
        if (F.tid == 15) misc[24] = incl;
    }
    __syncthreads();
}
template <int MODE, bool COMBINE, bool DRY = false>
__device__ __forceinline__ void rows_phase(Frame& F, int l, bool prefilled = false) {
    const int lane = F.lane;
    float* out = F.out;
    const bool xf32 = (MODE == 0 && !COMBINE) || (MODE == 1 && l == 0);
    const float* xin = ARG_IN(I_X); bf16* XB = (bf16*)(F.ws + WS_XB);
    const float* mod = (const float*)(F.ws + WS_MOD);
    bf16* H = (bf16*)(F.ws + WS_H);
    const int lprev = (MODE == 2) ? DEPTH - 1 : l - 1;
    if (COMBINE && !MK_ONE_LAUNCH) load_expert_tables(F, lprev);
    volatile LAS int* misc = (volatile LAS int*)(F.lds + X_MISC);
    if (MODE == 0 && !prefilled) {
        LAS f32x4* wf = (LAS f32x4*)F.lds; const float* src = ARG_IN(I_WIN) + (size_t)l * DM * INW + 4096;
#pragma unroll 8
        for (int i = F.tid; i < DM * 2; i += NTHREADS) { const int c = i >> 1, g = i & 1; wf[((g * 4 + (c & 3)) * 8 + (c >> 8)) * 64 + ((c >> 2) & 63)] = *(const f32x4*)(src + (size_t)c * INW + g * 4); }
    }
    if (MODE == 1 && !prefilled) {
        LAS f32x4* wr = (LAS f32x4*)F.lds; const f32x4* src = (const f32x4*)ARG_IN(I_WROUTER);
        f32x4 tv[16];
#pragma unroll
        for (int k = 0; k < 16; ++k) tv[k] = src[F.tid + k * NTHREADS];
        __builtin_amdgcn_sched_barrier(0);
#pragma unroll
        for (int k = 0; k < 16; ++k) { const int i = F.tid + k * NTHREADS, c = i >> 2, g = i & 3; wr[((g * 4 + (c & 3)) * 8 + (c >> 8)) * 64 + ((c >> 2) & 63)] = tv[k]; }
    }
    __syncthreads();
    const int ntask = T / 8;
    constexpr bool FIRST = (MODE == 0 && !COMBINE);
    const float* modp = (const float*)(F.ws + WS_MODP);
    if (FIRST) {
        for (int wt = F.vcu * NWAVES + F.wave; wt < 2048; wt += F.G * NWAVES)
            if (lane < 24) { const size_t idx = (size_t)wt * 96 + 4 * lane; *(f32x4*)((float*)(F.ws + WS_MOD) + idx) = modp_sum(modp, idx); }
    }
    for (int wt = F.vcu * NWAVES + F.wave; wt < ntask; wt += F.G * NWAVES) {
        const int row0 = wt * 8, b = row0 / SEQ;
        f32x4 A[8], Sh[8], Gm[8];
        {
            const float* nrm = (MODE == 0) ? ARG_IN(I_NMIX) + (size_t)l * DM : (MODE == 1) ? ARG_IN(I_NMOE) + (size_t)l * DM : ARG_IN(I_NFINAL);
            const float* mb = mod + ((size_t)(MODE == 2 ? 0 : l) * 8 + b) * MODW;
#pragma unroll
            for (int j = 0; j < 8; ++j) { const int c = 256 * j + 4 * lane; const f32x4 g = *(const f32x4*)(nrm + c);
                if (MODE == 2) { A[j] = g; Sh[j] = (f32x4){0.f, 0.f, 0.f, 0.f}; }
                else if (FIRST) { const size_t mi = (size_t)b * MODW + c; const f32x4 sc = modp_sum(modp, mi + DM); Sh[j] = modp_sum(modp, mi); A[j] = g * (1.0f + sc); }
                else { const f32x4 sc = *(const f32x4*)(mb + (MODE == 0 ? 1 : 4) * DM + c); Sh[j] = *(const f32x4*)(mb + (MODE == 0 ? 0 : 3) * DM + c); A[j] = g * (1.0f + sc); }
                if (COMBINE) Gm[j] = *(const f32x4*)(mod + ((size_t)lprev * 8 + b) * MODW + 5 * DM + c); }
        }
        int te_l = 0, tp_l = 0; float tw_l = 0.f;
        if (COMBINE) { if (lane < 16) { te_l = ((const int*)(F.ws + WS_TOKE))[row0 * 2 + lane]; tw_l = ((const float*)(F.ws + WS_TOKW))[row0 * 2 + lane]; tp_l = ((const int*)(F.ws + WS_TOKP))[row0 * 2 + lane]; } }
        for (int r = 0; r < 8; ++r) {
            const int row = row0 + r;
            f32x4 x[8];
#pragma unroll
            for (int j = 0; j < 8; ++j) {
                if (xf32) x[j] = __builtin_nontemporal_load((const f32x4*)(xin + (size_t)row * DM + 256 * j + 4 * lane));
                else { const u32x2 p = __builtin_nontemporal_load((const u32x2*)(XB + (size_t)row * DM + 256 * j + 4 * lane)); x[j] = (f32x4){bf_lo(p.x), bf_hi(p.x), bf_lo(p.y), bf_hi(p.y)}; } }
            if (COMBINE) {
                const int e0 = __builtin_amdgcn_readlane(te_l, 2 * r), e1 = __builtin_amdgcn_readlane(te_l, 2 * r + 1);
                const float w0 = __int_as_float(__builtin_amdgcn_readlane(__float_as_int(tw_l), 2 * r)), w1 = __int_as_float(__builtin_amdgcn_readlane(__float_as_int(tw_l), 2 * r + 1));
                const size_t s0 = (size_t)misc[8 + e0] * 256 + __builtin_amdgcn_readlane(tp_l, 2 * r), s1 = (size_t)misc[8 + e1] * 256 + __builtin_amdgcn_readlane(tp_l, 2 * r + 1);
                const bf16* y0p = (const bf16*)(F.ws + WS_YB) + s0 * 2048; const bf16* y1p = (const bf16*)(F.ws + WS_YB) + s1 * 2048;
                unsigned yq0[8], yq1[8];
                if (YB_FP8) {
#pragma unroll
                    for (int j = 0; j < 8; ++j) { yq0[j] = __builtin_nontemporal_load((const unsigned*)((const unsigned char*)(F.ws + WS_YB) + s0 * 2048 + 256 * j + 4 * lane)); yq1[j] = __builtin_nontemporal_load((const unsigned*)((const unsigned char*)(F.ws + WS_YB) + s1 * 2048 + 256 * j + 4 * lane)); }
                    __builtin_amdgcn_sched_barrier(0);
                }
#pragma unroll
                for (int j = 0; j < 8; ++j) { f32x4 y0, y1;
                    if (YB_FP8) { y0 = unpk4_fp8(yq0[j]); y1 = unpk4_fp8(yq1[j]); }
                    else { const u32x2 p0 = *(const u32x2*)(y0p + 256 * j + 4 * lane), p1 = *(const u32x2*)(y1p + 256 * j + 4 * lane);
                        y0 = (f32x4){bf_lo(p0.x), bf_hi(p0.x), bf_lo(p0.y), bf_hi(p0.y)}; y1 = (f32x4){bf_lo(p1.x), bf_hi(p1.x), bf_lo(p1.y), bf_hi(p1.y)}; }
                    x[j] += Gm[j] * (w0 * y0 + w1 * y1); }
                if (MODE != 2) {
#pragma unroll
                    for (int j = 0; j < 8; ++j) { u32x2 w; w.x = cvt_pk_bf16(x[j].x, x[j].y); w.y = cvt_pk_bf16(x[j].z, x[j].w); *(u32x2*)(XB + (size_t)row * DM + 256 * j + 4 * lane) = w; }
                }
            }
            if (MODE == 1) {
                const bf16* dl = (const bf16*)(F.ws + WS_DL) + (size_t)row * DM;
#pragma unroll
                for (int j = 0; j < 8; ++j) { const u32x2 p = __builtin_nontemporal_load((const u32x2*)(dl + 256 * j + 4 * lane)); x[j] += (f32x4){bf_lo(p.x), bf_hi(p.x), bf_lo(p.y), bf_hi(p.y)}; }
#pragma unroll
                for (int j = 0; j < 8; ++j) { u32x2 w; w.x = cvt_pk_bf16(x[j].x, x[j].y); w.y = cvt_pk_bf16(x[j].z, x[j].w); *(u32x2*)(XB + (size_t)row * DM + 256 * j + 4 * lane) = w; }
            }
            float ss = 0.f;
#pragma unroll
            for (int j = 0; j < 8; ++j) ss += (x[j].x * x[j].x + x[j].y * x[j].y) + (x[j].z * x[j].z + x[j].w * x[j].w);
            const float rstd = 1.0f / sqrtf(wave_sum_u(ss) * (1.0f / DM) + EPS);
#pragma unroll
            for (int j = 0; j < 8; ++j) x[j] = x[j] * rstd * A[j] + Sh[j];
            if (MODE == 2) {
#pragma unroll
                for (int j = 0; j < 8; ++j) __builtin_nontemporal_store(x[j], (f32x4*)(out + (size_t)row * DM + 256 * j + 4 * lane));
                continue;
            }
#pragma unroll
            for (int j = 0; j < 8; ++j) {
                constexpr bool W8 = (MODE == 1 && MOE_FP8) || (MODE == 0 && G1_FP8 >= 1), W16 = (MODE == 1 && !MOE_FP8) || (MODE == 0 && G1_FP8 != 2);
                if (W8) *(unsigned*)(F.ws + WS_H8 + (size_t)row * DM + 256 * j + 4 * lane) = pk4_fp8(x[j].x, x[j].y, x[j].z, x[j].w);
                if (W16) { u32x2 w; w.x = cvt_pk_bf16(x[j].x, x[j].y); w.y = cvt_pk_bf16(x[j].z, x[j].w); *(u32x2*)(H + (size_t)row * DM + 256 * j + 4 * lane) = w; } }
            if (MODE == 0) {
                const LAS float* wf = (const LAS float*)F.lds;
                float fl[8];
#pragma unroll
                for (int q = 0; q < 8; ++q) fl[q] = 0.f;
#pragma unroll
                for (int j = 0; j < 8; ++j)
#pragma unroll
                    for (int i = 0; i < 4; ++i) { const f32x4 w0 = *((const LAS f32x4*)wf + ((0 * 4 + i) * 8 + j) * 64 + lane), w1 = *((const LAS f32x4*)wf + ((1 * 4 + i) * 8 + j) * 64 + lane); const float xv = x[j][i];
#pragma unroll
                        for (int q = 0; q < 4; ++q) { fl[q] += xv * w0[q]; fl[4 + q] += xv * w1[q]; }
                        if (i == 3) asm volatile("" ::: "memory"); }
#pragma unroll
                for (int q = 0; q < 8; ++q) fl[q] = wave_sum_u(fl[q]);
                if (lane < 8) { float z = 0.f;
#pragma unroll
                    for (int q = 0; q < 8; ++q) z = (lane == q) ? fl[q] : z;
                    z += ARG_IN(I_BF)[l * 8 + lane];
                    const float ls = fminf(z, 0.f) - log1pf(expf(-fabsf(z)));
                    ((float*)(F.ws + WS_LS))[(size_t)row * 8 + lane] = ls; }
            }
            if (MODE == 1) {
                const LAS float* wr = (const LAS float*)F.lds;
                float lg[16];
#pragma unroll
                for (int q = 0; q < 16; ++q) lg[q] = 0.f;
#pragma unroll
                for (int j = 0; j < 8; ++j)
#pragma unroll
                    for (int i = 0; i < 4; ++i) { const float xv = x[j][i];
#pragma unroll
                        for (int q4 = 0; q4 < 4; ++q4) { const f32x4 w = *((const LAS f32x4*)wr + ((q4 * 4 + i) * 8 + j) * 64 + lane);
#pragma unroll
                            for (int q = 0; q < 4; ++q) lg[4 * q4 + q] += xv * w[q]; }
                        if (i == 3) asm volatile("" ::: "memory"); }
#pragma unroll
                for (int q = 0; q < 16; ++q) lg[q] = wave_sum_u(lg[q]);
                float mx = lg[0];
#pragma unroll
                for (int q = 1; q < 16; ++q) mx = fmaxf(mx, lg[q]);
                float pr[16], se = 0.f;
#pragma unroll
                for (int q = 0; q < 16; ++q) { pr[q] = expf(lg[q] - mx); se += pr[q]; }
                const float inv = 1.0f / se;
                float sel[16];
#pragma unroll
                for (int q = 0; q < 16; ++q) { pr[q] *= inv; sel[q] = pr[q] + ARG_IN(I_BROUTER)[q]; }
                float bestS = -3.0e38f; int be0 = 0, be1 = 1;
#pragma unroll
                for (int g = 0; g < 4; ++g) {
                    float v1 = sel[4 * g]; int i1 = 0;
#pragma unroll
                    for (int i = 1; i < 4; ++i) if (sel[4 * g + i] > v1) { v1 = sel[4 * g + i]; i1 = i; }
                    float v2 = -3.0e38f; int i2 = 0;
#pragma unroll
                    for (int i = 0; i < 4; ++i) if (i != i1 && sel[4 * g + i] > v2) { v2 = sel[4 * g + i]; i2 = i; }
                    const float sc = v1 + v2;
                    if (sc > bestS) { bestS = sc; be0 = 4 * g + i1; be1 = 4 * g + i2; }
                }
                float p0 = 0.f, p1 = 0.f;
#pragma unroll
                for (int q = 0; q < 16; ++q) { p0 = (q == be0) ? pr[q] : p0; p1 = (q == be1) ? pr[q] : p1; }
                const float gs = 1.0f / (p0 + p1);
                if (lane == 0) {
                    int* te = (int*)(F.ws + WS_TOKE) + row * 2; float* tw = (float*)(F.ws + WS_TOKW) + row * 2;
                    te[0] = be0; te[1] = be1; tw[0] = p0 * gs; tw[1] = p1 * gs;
                    volatile LAS int* asg = (volatile LAS int*)(F.lds + X_ASG);
                    asg[(F.wave * 8 + r) * 2] = be0; asg[(F.wave * 8 + r) * 2 + 1] = be1;
                }
            }
        }
        if (MODE == 1) {
            __syncthreads();
            if (!DRY) {
                volatile LAS int* asg = (volatile LAS int*)(F.lds + X_ASG);
                const int a0 = asg[lane], a1 = asg[64 + lane];
                const int eA = F.wave * 2, eB = eA + 1;
                const unsigned long long mA0 = __ballot(a0 == eA), mA1 = __ballot(a1 == eA), mB0 = __ballot(a0 == eB), mB1 = __ballot(a1 == eB);
                const int nA0 = __popcll(mA0), nA = nA0 + __popcll(mA1), nB0 = __popcll(mB0), nB = nB0 + __popcll(mB1);
                unsigned base_l = 0u;
                if (lane < 2) { const int nn = lane ? nB : nA; if (nn) base_l = __hip_atomic_fetch_add((unsigned*)(F.ws + WS_CTL) + CW_CNT + (l * 16 + eA + lane) * 64, (unsigned)nn, RLX_AGENT); }
                const unsigned baseA = (unsigned)__builtin_amdgcn_readlane((int)base_l, 0), baseB = (unsigned)__builtin_amdgcn_readlane((int)base_l, 1);
                const unsigned long long lt = (1ull << lane) - 1ull;
                const int blk_row0 = (wt - F.wave) * 8;
                int* list = (int*)(F.ws + WS_LIST); int* tp = (int*)(F.ws + WS_TOKP);
                if (a0 == eA || a0 == eB) { const bool isA = a0 == eA; const unsigned slot = isA ? baseA + (unsigned)__popcll(mA0 & lt) : baseB + (unsigned)__popcll(mB0 & lt);
                    const int row = blk_row0 + (lane >> 1); list[(isA ? eA : eB) * LIST_CAP + slot] = row; tp[row * 2 + (lane & 1)] = (int)slot; }
                if (a1 == eA || a1 == eB) { const bool isA = a1 == eA; const unsigned slot = isA ? baseA + (unsigned)nA0 + (unsigned)__popcll(mA1 & lt) : baseB + (unsigned)nB0 + (unsigned)__popcll(mB1 & lt);
                    const int row = blk_row0 + 32 + (lane >> 1); list[(isA ? eA : eB) * LIST_CAP + slot] = row; tp[row * 2 + (lane & 1)] = (int)slot; }
            }
            __syncthreads();
        }
    }
}

template <int W>
__device__ __forceinline__ void pool_tile_w(Frame& F, int pm, int g, int half) {
    const bf16* U = (const bf16*)(F.ws + WS_U); bf16* PL = (bf16*)(F.ws + WS_PL);
    const int cc = F.tid & 31, rg = F.tid >> 5;
    const int col = g * 256 + cc * 8 + half * 4;
    const int r0 = pm * 256 + rg * 16, t0 = r0 % SEQ;
    u32x2 cur[16], prv[W - 1];
#pragma unroll
    for (int r = 0; r < 16; ++r) cur[r] = *(const u32x2*)(U + (size_t)(r0 + r) * 1024 + col);
#pragma unroll
    for (int j = 1; j < W; ++j) { const bool ok = t0 - j >= 0; const u32x2 v = *(const u32x2*)(U + (size_t)(ok ? r0 - j : r0) * 1024 + col); prv[j - 1] = ok ? v : (u32x2){0u, 0u}; }
    __builtin_amdgcn_sched_barrier(0);
    f32x4 s = {0.f, 0.f, 0.f, 0.f};
#pragma unroll
    for (int j = 1; j < W; ++j) s += (f32x4){bf_lo(prv[j - 1].x), bf_hi(prv[j - 1].x), bf_lo(prv[j - 1].y), bf_hi(prv[j - 1].y)};
#pragma unroll
    for (int r = 0; r < 16; ++r) {
        const int t = t0 + r; const f32x4 a = {bf_lo(cur[r].x), bf_hi(cur[r].x), bf_lo(cur[r].y), bf_hi(cur[r].y)};
        s += a;
        const float inv = 1.0f / (float)(t + 1 < W ? t + 1 : W);
        const f32x4 o = s * inv - a;
        u32x2 w; w.x = cvt_pk_bf16(o[0], o[1]); w.y = cvt_pk_bf16(o[2], o[3]);
        *(u32x2*)(PL + (size_t)(r0 + r) * 1024 + col) = w;
        {
            const u32x2 q = r - W + 1 >= 0 ? cur[r - W + 1 >= 0 ? r - W + 1 : 0] : prv[r - W + 1 >= 0 ? 0 : W - 2 - r];
            s -= (f32x4){bf_lo(q.x), bf_hi(q.x), bf_lo(q.y), bf_hi(q.y)}; }
    }
}
__device__ __forceinline__ void pool_tile(Frame& F, int pm, int g) {
    if (g == 0) { pool_tile_w<2>(F, pm, g, 0); pool_tile_w<2>(F, pm, g, 1); }
    else if (g == 1) { pool_tile_w<4>(F, pm, g, 0); pool_tile_w<4>(F, pm, g, 1); }
    else if (g == 2) { pool_tile_w<8>(F, pm, g, 0); pool_tile_w<8>(F, pm, g, 1); }
    else { pool_tile_w<16>(F, pm, g, 0); pool_tile_w<16>(F, pm, g, 1); }
}

__device__ __forceinline__ void forget_cumsum(Frame& F, int b, int h, LAS float* Fl, LAS float* tmp, const float L2E) {
    const float* LS = (const float*)(F.ws + WS_LS) + (size_t)b * SEQ * 8 + h;
    const int t4 = F.tid * 4;
    float v0 = LS[(size_t)(t4 + 0) * 8], v1 = LS[(size_t)(t4 + 1) * 8], v2 = LS[(size_t)(t4 + 2) * 8], v3 = LS[(size_t)(t4 + 3) * 8];
    v1 += v0; v2 += v1; v3 += v2;
    float tot = v3;
#pragma unroll
    for (int o = 1; o < 64; o <<= 1) { const float n = __shfl_up(tot, o); if (F.lane >= o) tot += n; }
    if (F.lane == 63) tmp[F.wave] = tot;
    __syncthreads();
    float off = 0.f;
    for (int w = 0; w < F.wave; ++w) off += tmp[w];
    const float base = off + tot - v3;
    *(LAS f32x4*)(Fl + t4) = (f32x4){(base + v0) * L2E, (base + v1) * L2E, (base + v2) * L2E, (base + v3) * L2E};
    __syncthreads();
}

#if ATTN_FAST
namespace att {
constexpr int D = 128, LD = 1024, NW = 8, QBLK = 32, KVBLK = 64, QB = NW * QBLK;
constexpr int SHM_V = KVBLK * D * 2, SHM_K = KVBLK * D * 2;
constexpr int OFF_WS = 2 * SHM_V + 2 * SHM_K;
constexpr int OFF_FN = OFF_WS + NW * 64 * 4;
constexpr int OFF_TMP = OFF_FN + 2048 * 4;
constexpr float SCALE = 0.08838834764831845f, C2 = 1.4426950408889634f * SCALE, THR = 8.f;
typedef short s16x4 __attribute__((ext_vector_type(4)));
typedef float f32x16 __attribute__((ext_vector_type(16)));
#define KSWZ(row, colB) ((row) * 256 + ((colB) ^ (((row) & 7) << 4)))
#define SBAR() __builtin_amdgcn_sched_barrier(0)
__device__ __forceinline__ int v_st(int k, int c) { const int kk = (k & ~0xC) | ((k & 4) << 1) | ((k & 8) >> 1); return ((kk >> 3) * 4 + (c >> 5)) * 512 + ((kk & 7) * 32 + (c & 31)) * 2; }
__device__ __forceinline__ int v_rd_base(int lane) { return ((lane & 3) << 3) | (((lane >> 2) & 3) << 6) | (((lane >> 4) & 1) << 5) | (((lane >> 5) & 1) << 8); }
constexpr int v_rd_off(int d0, int ks, int half) { return d0 * 512 + ks * 4096 + half * 2048; }
__device__ __forceinline__ int crow(int r, int hi) { return (r & 3) + 8 * (r >> 2) + 4 * hi; }
__device__ __forceinline__ unsigned cvtpk(float lo, float hi) { return cvt_pk_bf16(lo, hi); }
__device__ __forceinline__ bf16x8 load8(const bf16* p) { return *reinterpret_cast<const bf16x8*>(p); }
__device__ __forceinline__ void mask_tile(f32x16& p0, f32x16& p1, int dq) {
    const float NEG = -__builtin_inff();
#pragma unroll
    for (int r = 0; r < 16; ++r) { const int c = (r & 3) + 8 * (r >> 2); if (dq - c < 0) p0[r] = NEG; if (dq - c - 32 < 0) p1[r] = NEG; }
}
__device__ __forceinline__ void partialSM(f32x16& p0, f32x16& p1, float& m_reg, float& mn, float& alpha) {
    float pmax = p0[0]; for (int r = 1; r < 16; ++r) pmax = fmaxf(pmax, p0[r]); for (int r = 0; r < 16; ++r) pmax = fmaxf(pmax, p1[r]);
    { auto rr = __builtin_amdgcn_permlane32_swap(__float_as_uint(pmax), __float_as_uint(pmax), false, false);
      pmax = fmaxf(__uint_as_float(rr[0]), __uint_as_float(rr[1])); }
    if (__builtin_expect(__all((pmax - m_reg) * SCALE <= THR), 1)) { mn = m_reg; alpha = 1.f; }
    else { mn = fmaxf(m_reg, pmax); alpha = __builtin_amdgcn_exp2f((m_reg - mn) * C2); m_reg = mn; }
    const float mnL = -mn * C2;
    for (int r = 0; r < 16; ++r) p0[r] = fmaf(p0[r], C2, mnL); for (int r = 0; r < 16; ++r) p1[r] = fmaf(p1[r], C2, mnL);
    for (int r = 0; r < 16; ++r) p0[r] = __builtin_amdgcn_exp2f(p0[r]);
}
__device__ __forceinline__ void finishSM(f32x16& p0, f32x16& p1, float alpha, float& l_reg, bf16x8& pa0, bf16x8& pa1, bf16x8& pa2, bf16x8& pa3) {
    for (int r = 0; r < 16; ++r) p1[r] = __builtin_amdgcn_exp2f(p1[r]);
    float ps = 0; for (int r = 0; r < 16; ++r) ps += p0[r]; for (int r = 0; r < 16; ++r) ps += p1[r];
    { auto rr = __builtin_amdgcn_permlane32_swap(__float_as_uint(ps), __float_as_uint(ps), false, false);
      ps = __uint_as_float(rr[0]) + __uint_as_float(rr[1]); }
    l_reg = l_reg * alpha + ps;
#define PK4(P, B_, OUT) do { unsigned a0 = cvtpk(P[B_+0], P[B_+1]), a1 = cvtpk(P[B_+2], P[B_+3]);                          \
        unsigned b0 = cvtpk(P[B_+4], P[B_+5]), b1 = cvtpk(P[B_+6], P[B_+7]);                                             \
        auto r0 = __builtin_amdgcn_permlane32_swap(a0, b0, false, false); auto r1 = __builtin_amdgcn_permlane32_swap(a1, b1, false, false); \
        u32x4 w = {r0[0], r1[0], r0[1], r1[1]}; OUT = *reinterpret_cast<bf16x8*>(&w); } while (0)
    PK4(p0, 0, pa0); PK4(p0, 8, pa1); PK4(p1, 0, pa2); PK4(p1, 8, pa3);
#undef PK4
}
template <int KB>
__device__ __forceinline__ void qkt(f32x16& p0, f32x16& p1, const char* K_lds, int r32, int hi, const bf16x8* qr, const LAS float* nbt) {
#pragma unroll
    for (int g = 0; g < 4; ++g) { const f32x4 b0 = *(const LAS f32x4*)(nbt + 8 * g), b1 = *(const LAS f32x4*)(nbt + 32 + 8 * g);
#pragma unroll
        for (int i = 0; i < 4; ++i) { p0[4 * g + i] = b0[i]; p1[4 * g + i] = b1[i]; } }
    const char* kb[4];
#pragma unroll
    for (int dd = 0; dd < 4; ++dd) kb[dd] = K_lds + KB * SHM_K + KSWZ(r32, (dd * 16 + hi * 8) * 2);
#pragma unroll
    for (int d0 = 0; d0 < 8; ++d0) { const char* a = kb[d0 & 3] + (d0 >> 2) * 128;
        bf16x8 b0 = *reinterpret_cast<const bf16x8*>(a);
        bf16x8 b1 = *reinterpret_cast<const bf16x8*>(a + 32 * 256);
        p0 = __builtin_amdgcn_mfma_f32_32x32x16_bf16(b0, qr[d0], p0, 0, 0, 0);
        p1 = __builtin_amdgcn_mfma_f32_32x32x16_bf16(b1, qr[d0], p1, 0, 0, 0); }
}
template <int VB>
__device__ __forceinline__ void pv_tile(f32x16* o, int vb0, bf16x8 pa0, bf16x8 pa1, bf16x8 pa2, bf16x8 pa3) {
#define TRRD(dst, off) asm volatile("ds_read_b64_tr_b16 %0, %1 offset:%2" : "=&v"(dst) : "v"(vb0), "i"(off) : "memory")
#define PV_D0(d0) do { s16x4 l0, l1, l2, l3, h0, h1, h2, h3; constexpr int b_ = VB * SHM_V + v_rd_off(d0, 0, 0); \
        TRRD(l0, b_); TRRD(h0, b_ + 2048); TRRD(l1, b_ + 4096); TRRD(h1, b_ + 6144); TRRD(l2, b_ + 8192); TRRD(h2, b_ + 10240); TRRD(l3, b_ + 12288); TRRD(h3, b_ + 14336); \
        asm volatile("s_waitcnt lgkmcnt(0)" ::: "memory"); SBAR();   \
        o[d0] = __builtin_amdgcn_mfma_f32_32x32x16_bf16(pa0, (bf16x8){l0[0], l0[1], l0[2], l0[3], h0[0], h0[1], h0[2], h0[3]}, o[d0], 0, 0, 0);   \
        o[d0] = __builtin_amdgcn_mfma_f32_32x32x16_bf16(pa1, (bf16x8){l1[0], l1[1], l1[2], l1[3], h1[0], h1[1], h1[2], h1[3]}, o[d0], 0, 0, 0);   \
        o[d0] = __builtin_amdgcn_mfma_f32_32x32x16_bf16(pa2, (bf16x8){l2[0], l2[1], l2[2], l2[3], h2[0], h2[1], h2[2], h2[3]}, o[d0], 0, 0, 0);   \
        o[d0] = __builtin_amdgcn_mfma_f32_32x32x16_bf16(pa3, (bf16x8){l3[0], l3[1], l3[2], l3[3], h3[0], h3[1], h3[2], h3[3]}, o[d0], 0, 0, 0); } while (0)
    PV_D0(0); PV_D0(1); PV_D0(2); PV_D0(3);
#undef PV_D0
#undef TRRD
}
struct BlockRef { const bf16* Q; const bf16* K; const bf16* V; bf16* O; int P0; unsigned char* O8; };
struct Seam { bf16x8 qr[8]; bf16x8 st_v0, st_v1, st_k0, st_k1; };
#define ROW(p, k0, rr) ((p) + (size_t)((k0) + (rr)) * LD + sc)
#define VMW() asm volatile("s_waitcnt vmcnt(0)" ::: "memory")
#define VMWN(n) asm volatile("s_waitcnt vmcnt(%0)" :: "i"(n) : "memory")
#define SLOAD_H(Kp, Vp, k0) do { S.st_v0 = load8(ROW(Vp, k0, sr)); S.st_v1 = load8(ROW(Vp, k0, 32 + sr)); S.st_k0 = load8(ROW(Kp, k0, sr)); S.st_k1 = load8(ROW(Kp, k0, 32 + sr)); } while (0)
#define SWRITE_HK(bf) do { *(bf16x8*)(K_lds + (bf) * SHM_K + kws) = S.st_k0; *(bf16x8*)(K_lds + (bf) * SHM_K + kws + 32 * 256) = S.st_k1; } while (0)
#define SWRITE_HV(bf) do { *(bf16x8*)(V_lds + (bf) * SHM_V + vst0) = S.st_v0; *(bf16x8*)(V_lds + (bf) * SHM_V + vst1) = S.st_v1; } while (0)
#define SWRITE_H(bf) do { SWRITE_HV(bf); SWRITE_HK(bf); } while (0)
__device__ __forceinline__ void prime(const BlockRef& cur, char* lds, Seam& S, int tid) {
    const int wid = __builtin_amdgcn_readfirstlane(tid >> 6), lane = tid & 63, r32 = lane & 31, hi = lane >> 5;
    const int sr = tid >> 4, sc = (tid & 15) * 8, kws = KSWZ(sr, sc * 2); char* K_lds = lds + 2 * SHM_V;
    for (int d0 = 0; d0 < 8; ++d0) S.qr[d0] = load8(cur.Q + (size_t)(wid * QBLK + r32) * LD + d0 * 16 + hi * 8);
    SLOAD_H(cur.K, cur.V, 0); VMW(); SWRITE_HK(0);
    __syncthreads();
}
__device__ __forceinline__ void block(const BlockRef& cur, const BlockRef& nxt, char* lds, Seam& S, int tid) {
    const int wid = __builtin_amdgcn_readfirstlane(tid >> 6), lane = tid & 63, r32 = lane & 31, hi = lane >> 5;
    const int NT = (cur.P0 + QB - 1) / KVBLK + 1;
    const int qlo = cur.P0 + wid * QBLK, qm = qlo + r32 - 4 * hi;
    char* V_lds = lds; char* K_lds = lds + 2 * SHM_V;
    float* ws = (float*)(lds + OFF_WS) + wid * 64; float* li_l = ws, * al_l = ws + 32;
    const LAS float* nbl = (const LAS float*)((LAS unsigned char*)lds_raw + OFF_FN) + 4 * hi;
    float m_reg = -1e30f, l_reg = 0; f32x16 o[4] = {};
    const int sr = tid >> 4, sc = (tid & 15) * 8, vst0 = v_st(sr, sc), vst1 = v_st(32 + sr, sc), kws = KSWZ(sr, sc * 2);
    const int vb0 = (int)(uintptr_t)V_lds + v_rd_base(lane);
    const bf16* Kh = cur.K; const bf16* Vh = cur.V;
#define RESC(a) do { if (__any((a) < 1.f)) { if (hi == 0) al_l[r32] = (a); asm volatile("s_waitcnt lgkmcnt(0)" ::: "memory");              \
                     for (int d_ = 0; d_ < 4; ++d_) for (int r = 0; r < 16; ++r) o[d_][r] *= al_l[crow(r, hi)]; } } while (0)
#define KBASE(t) ((t) * KVBLK)
#define MASKT(P0_, P1_, t) do { const int kb_ = KBASE(t); if (kb_ + KVBLK - 1 > qlo) mask_tile(P0_, P1_, qm - kb_); } while (0)
    constexpr int NQL = 8;
#define SEAM_K0() do { VMWN(NQL); SWRITE_HK(0); SBAR(); } while (0)
    f32x16 pA0, pA1, pB0, pB1; float mnA, mnB, alA, alB; bf16x8 pa0, pa1, pa2, pa3;
    SWRITE_HV(0); SBAR();
    if (NT > 1) { SLOAD_H(Kh, Vh, KBASE(1)); }
    SBAR(); qkt<0>(pA0, pA1, K_lds, r32, hi, S.qr, nbl);
    MASKT(pA0, pA1, 0); partialSM(pA0, pA1, m_reg, mnA, alA);
    if (NT > 1) { VMW(); SWRITE_H(1); }
    __syncthreads();
#define HALF_STEP(PX0, PX1, mnX, alX, PY0, PY1, alY, t, KB, VB, SB) do {                                                      \
        SBAR(); qkt<KB>(PX0, PX1, K_lds, r32, hi, S.qr, nbl + KBASE(t));                                             \
        finishSM(PY0, PY1, alY, l_reg, pa0, pa1, pa2, pa3); SBAR();                                                           \
        if ((t) + 1 < NT) { SLOAD_H(Kh, Vh, KBASE((t) + 1)); SBAR(); }                                               \
        pv_tile<VB>(o, vb0, pa0, pa1, pa2, pa3); MASKT(PX0, PX1, (t)); partialSM(PX0, PX1, m_reg, mnX, alX);                                        \
        __syncthreads();                                                                                                      \
        if ((t) + 1 < NT) { VMW(); SWRITE_H(SB); }                                                                          \
        RESC(alX); __syncthreads(); } while (0)
    for (int t = 1; t + 1 < NT; t += 2) {
        HALF_STEP(pB0, pB1, mnB, alB, pA0, pA1, alA, t, 1, 0, 0);
        HALF_STEP(pA0, pA1, mnA, alA, pB0, pB1, alB, t + 1, 0, 1, 1);
    }
    const bool even = (NT & 1) == 0;
    if (even) { SBAR(); qkt<1>(pB0, pB1, K_lds, r32, hi, S.qr, nbl + KBASE(NT - 1)); SBAR(); }
    SLOAD_H(nxt.K, nxt.V, 0); SBAR();
#pragma unroll
    for (int d0 = 0; d0 < 8; ++d0) S.qr[d0] = load8(nxt.Q + (size_t)(wid * QBLK + r32) * LD + d0 * 16 + hi * 8);
    SBAR();
    finishSM(pA0, pA1, alA, l_reg, pa0, pa1, pa2, pa3); SBAR();
    pv_tile<0>(o, vb0, pa0, pa1, pa2, pa3);
    if (even) { MASKT(pB0, pB1, NT - 1); partialSM(pB0, pB1, m_reg, mnB, alB); __syncthreads(); RESC(alB);
        finishSM(pB0, pB1, alB, l_reg, pa0, pa1, pa2, pa3); SBAR(); pv_tile<1>(o, vb0, pa0, pa1, pa2, pa3); }
    SBAR(); SEAM_K0();
    if (hi == 0) li_l[r32] = l_reg; asm volatile("s_waitcnt lgkmcnt(0)" ::: "memory");
    float rli[16];
#pragma unroll
    for (int r = 0; r < 16; ++r) rli[r] = __builtin_amdgcn_rcpf(li_l[crow(r, hi)]);
    bf16* Ow = cur.O + (size_t)(wid * QBLK) * LD;
#pragma unroll
    for (int r = 0; r < 16; ++r) { const int orow = crow(r, hi);
#pragma unroll
        for (int d0 = 0; d0 < 4; ++d0) { const float v = o[d0][r] * rli[r]; const float vn = __shfl_xor(v, 1);
            if ((r32 & 1) == 0) *(unsigned*)(Ow + (size_t)orow * LD + d0 * 32 + r32) = cvtpk(v, vn); } }
    __syncthreads();
#undef RESC
#undef KBASE
#undef MASKT
#undef SEAM_K0
#undef HALF_STEP
}
__device__ __forceinline__ void block_lean(const BlockRef& cur, char* lds, int tid) {
    const int wid = __builtin_amdgcn_readfirstlane(tid >> 6), lane = tid & 63, r32 = lane & 31, hi = lane >> 5;
    const int NT = (cur.P0 + QB - 1) / KVBLK + 1;
    const int qlo = cur.P0 + wid * QBLK, qm = qlo + r32 - 4 * hi;
    char* V_lds = lds; char* K_lds = lds + 2 * SHM_V;
    float* ws = (float*)(lds + OFF_WS) + wid * 64; float* li_l = ws, * al_l = ws + 32;
    const LAS float* nbl = (const LAS float*)((LAS unsigned char*)lds_raw + OFF_FN) + 4 * hi;
    const int sr = tid >> 4, sc = (tid & 15) * 8, vst0 = v_st(sr, sc), vst1 = v_st(32 + sr, sc), kws = KSWZ(sr, sc * 2);
    const int vb0 = (int)(uintptr_t)V_lds + v_rd_base(lane);
    const bf16* Kh = cur.K; const bf16* Vh = cur.V;
    Seam S;
#pragma unroll
    for (int d0 = 0; d0 < 8; ++d0) S.qr[d0] = load8(cur.Q + (size_t)(wid * QBLK + r32) * LD + d0 * 16 + hi * 8);
    SLOAD_H(Kh, Vh, 0); VMW(); SWRITE_H(0);
    if (NT > 1) { SLOAD_H(Kh, Vh, KVBLK); VMW(); SWRITE_H(1); }
    if (NT > 2) SLOAD_H(Kh, Vh, 2 * KVBLK);
    __syncthreads();
    float m_reg = -1e30f, l_reg = 0; f32x16 o[4] = {};
    f32x16 p0, p1; float mn, al; bf16x8 pa0, pa1, pa2, pa3;
#define RESC(a) do { if (__any((a) < 1.f)) { if (hi == 0) al_l[r32] = (a); asm volatile("s_waitcnt lgkmcnt(0)" ::: "memory");              \
                     for (int d_ = 0; d_ < 4; ++d_) for (int r = 0; r < 16; ++r) o[d_][r] *= al_l[crow(r, hi)]; } } while (0)
#define LSTEP(t, B) do { const int kb_ = (t) * KVBLK;                                                                      \
        SBAR(); qkt<B>(p0, p1, K_lds, r32, hi, S.qr, nbl + kb_);                                                            \
        if (kb_ + KVBLK - 1 > qlo) mask_tile(p0, p1, qm - kb_);                                                             \
        partialSM(p0, p1, m_reg, mn, al); RESC(al);                                                                         \
        finishSM(p0, p1, al, l_reg, pa0, pa1, pa2, pa3); SBAR();                                                            \
        pv_tile<B>(o, vb0, pa0, pa1, pa2, pa3);                                                                             \
        __syncthreads();                                                                                                    \
        if ((t) + 2 < NT) { VMW(); SWRITE_H(B); if ((t) + 3 < NT) SLOAD_H(Kh, Vh, ((t) + 3) * KVBLK); } } while (0)
    for (int t = 0; t < NT; t += 2) { LSTEP(t, 0); if (t + 1 < NT) LSTEP(t + 1, 1); }
    if (hi == 0) li_l[r32] = l_reg; asm volatile("s_waitcnt lgkmcnt(0)" ::: "memory");
    float rli[16];
#pragma unroll
    for (int r = 0; r < 16; ++r) rli[r] = __builtin_amdgcn_rcpf(li_l[crow(r, hi)]);
    bf16* Ow = cur.O + (size_t)(wid * QBLK) * LD;
#pragma unroll
    for (int r = 0; r < 16; ++r) { const int orow = crow(r, hi);
#pragma unroll
        for (int d0 = 0; d0 < 4; ++d0) { const float v = o[d0][r] * rli[r]; const float vn = __shfl_xor(v, 1);
            if (cur.O8) { const float v2 = __shfl_xor(v, 2), v3 = __shfl_xor(vn, 2);
                if ((r32 & 3) == 0) *(unsigned*)(cur.O8 + (size_t)(wid * QBLK + orow) * LD + d0 * 32 + r32) = pk4_fp8(v, vn, v2, v3); }
            else if ((r32 & 1) == 0) *(unsigned*)(Ow + (size_t)orow * LD + d0 * 32 + r32) = cvtpk(v, vn); } }
    __syncthreads();
#undef RESC
#undef LSTEP
}
#undef ROW
#undef VMW
#undef VMWN
#undef SLOAD_H
#undef SWRITE_HK
#undef SWRITE_HV
#undef SWRITE_H
#undef KSWZ
#undef SBAR
}

__device__ __forceinline__ void attn_fast(Frame& F) {
    const bf16* Q = (const bf16*)(F.ws + WS_Q); const bf16* Kp = (const bf16*)(F.ws + WS_K); const bf16* V = (const bf16*)(F.ws + WS_V); bf16* AO = (bf16*)(F.ws + WS_AO);
    char* lds = (char*)lds_raw;
    {   const int item = F.vcu;
        const int bh = item >> 2, b = bh >> 3, h = bh & 7, x = item & 3;
        __syncthreads();
        {
            LAS float* Fl = (LAS float*)(F.lds + att::OFF_FN); LAS float* tmp = (LAS float*)(F.lds + att::OFF_TMP);
            forget_cumsum(F, b, h, Fl, tmp, -1.0f / att::SCALE);
        }
        const size_t seq0 = (size_t)b * SEQ * 1024 + h * 128;
        att::BlockRef r0, r1;
        unsigned char* AO8 = G2_FP8 ? (unsigned char*)(F.ws + WS_AO) : (unsigned char*)nullptr;
        r0.Q = Q + seq0 + (size_t)(x * 256) * 1024; r0.O = AO + seq0 + (size_t)(x * 256) * 1024; r0.K = Kp + seq0; r0.V = V + seq0; r0.P0 = x * 256; r0.O8 = AO8 ? AO8 + seq0 + (size_t)(x * 256) * 1024 : AO8;
        r1.Q = Q + seq0 + (size_t)((7 - x) * 256) * 1024; r1.O = AO + seq0 + (size_t)((7 - x) * 256) * 1024; r1.K = Kp + seq0; r1.V = V + seq0; r1.P0 = (7 - x) * 256; r1.O8 = AO8 ? AO8 + seq0 + (size_t)((7 - x) * 256) * 1024 : AO8;
#if ATTN_FAST == 2
        att::Seam S;
        att::prime(r0, lds, S, F.tid);
        att::block(r0, r1, lds, S, F.tid);
        att::block(r1, r1, lds, S, F.tid);
#else
        att::block_lean(r0, lds, F.tid);
        att::block_lean(r1, lds, F.tid);
#endif
    }
    __syncthreads();
}
#endif

#if !ATTN_FAST
__device__ __forceinline__ void attn_simple(Frame& F) {
    const bf16* Q = (const bf16*)(F.ws + WS_Q); const bf16* Kp = (const bf16*)(F.ws + WS_K); const bf16* V = (const bf16*)(F.ws + WS_V); bf16* AO = (bf16*)(F.ws + WS_AO);
    LAS float* Fl = (LAS float*)F.lds;
    LAS float* tmp = (LAS float*)(F.lds + 8192);
    LAS float* sc = (LAS float*)(F.lds + 16384 + F.wave * 8192);
    LAS float* qf = (LAS float*)(F.lds + 16384 + 65536 + F.wave * 512);
    const float L2E = 1.4426950408889634f, scale = 0.08838834764831845f;
    {   const int item = F.vcu;
        const int bh = item >> 2, b = bh >> 3, h = bh & 7, q0 = (item & 3) * 512;
        __syncthreads();
        forget_cumsum(F, b, h, Fl, tmp, 1.4426950408889634f);
        for (int t = q0 + F.wave; t < q0 + 512; t += NWAVES) {
            const size_t row = (size_t)b * SEQ + t;
            { const unsigned qw = *(const unsigned*)(Q + row * 1024 + h * 128 + 2 * F.lane); qf[2 * F.lane] = bf_lo(qw); qf[2 * F.lane + 1] = bf_hi(qw); }
            LDS_WAIT();
            float mx = -3.0e38f;
            for (int j = F.lane; j <= t; j += 64) {
                const bf16* kr = Kp + ((size_t)b * SEQ + j) * 1024 + h * 128; float d = 0.f;
#pragma unroll 2
                for (int c = 0; c < 16; ++c) { const u32x4 kw = *(const u32x4*)(kr + 8 * c); f32x4 k0, k1; pg8::unpack8(kw, k0, k1); const f32x4 q0v = *(const LAS f32x4*)(qf + 8 * c), q1v = *(const LAS f32x4*)(qf + 8 * c + 4);
                    d += (k0[0] * q0v[0] + k0[1] * q0v[1]) + (k0[2] * q0v[2] + k0[3] * q0v[3]) + (k1[0] * q1v[0] + k1[1] * q1v[1]) + (k1[2] * q1v[2] + k1[3] * q1v[3]); }
                const float s = d * scale * L2E + (Fl[t] - Fl[j]);
                sc[j] = s; mx = fmaxf(mx, s);
            }
            mx = wave_max(mx);
            float sum = 0.f;
            for (int j = F.lane; j <= t; j += 64) { const float p = __builtin_amdgcn_exp2f(sc[j] - mx); sc[j] = p; sum += p; }
            sum = wave_sum(sum);
            LDS_WAIT();
            float o0 = 0.f, o1 = 0.f;
            const bf16* vb = V + (size_t)b * SEQ * 1024 + h * 128 + 2 * F.lane;
            for (int j = 0; j <= t; ++j) { const unsigned vw = *(const unsigned*)(vb + (size_t)j * 1024); const float p = sc[j]; o0 += p * bf_lo(vw); o1 += p * bf_hi(vw); }
            const float inv = 1.0f / sum;
            *(unsigned*)(AO + row * 1024 + h * 128 + 2 * F.lane) = cvt_pk_bf16(o0 * inv, o1 * inv);
        }
    }
    __syncthreads();
}
#endif

__device__ __forceinline__ unsigned char* layer_w(const Frame& F, int l) { return F.ws + WS_W + (size_t)l * W_LAYER; }
__device__ __forceinline__ void ph_p0() { Frame F; frame_refresh(F); p0_prologue(F); }
__device__ __forceinline__ void ph_r1(int l, bool pre = false) { Frame F; frame_refresh(F); if (l == 0) rows_phase<0, false>(F, l, pre); else rows_phase<0, true>(F, l, pre); }
__device__ __forceinline__ void ph_r2(int l, bool pre = false) { Frame F; frame_refresh(F); rows_phase<1, false>(F, l, pre); }
__device__ __forceinline__ void ph_r2_dry(int l) { Frame F; frame_refresh(F); rows_phase<1, false, true>(F, l); }
__device__ __forceinline__ void ph_final() { Frame F; frame_refresh(F); rows_phase<2, true>(F, 0);
}
__device__ __forceinline__ void ph_g1(int l) {
    Frame F; frame_refresh(F);
    const LAS int* tt = (const LAS int*)(F.lds + X_TOK);
#if G1_FP8 == 2
    pg8::Gemm g{(const bf16*)(F.ws + WS_H8), (const bf16*)(layer_w(F, l) + WO_PG)};
    typedef pg8::StaticOrder<T, 8192, DM / 2, DM / 2> Order; Order S; S.init(F.G, (int)blockIdx.x);
    pg8::EpiProj E{(bf16*)(F.ws + WS_U), (bf16*)(F.ws + WS_G), ARG_IN(I_BGATE) + (size_t)l * 4096, W8_INV, 0};
    pg8::gemm_phase<pg8::EpiProj, Order, false, DM / 2, DM / 2, DM / 2, true>(F.lds, g, S, E, tt);
#elif G1_FP8 == 1
    {   pg8::Gemm g{(const bf16*)(F.ws + WS_H), (const bf16*)(layer_w(F, l) + WO_PG)};
        typedef pg8::StaticOrder<T, 4096, DM, DM> Order; Order S; S.init(F.G, (int)blockIdx.x);
        pg8::EpiProj E{(bf16*)(F.ws + WS_U), (bf16*)(F.ws + WS_G), ARG_IN(I_BGATE) + (size_t)l * 4096, 1.0f, 0};
        pg8::gemm_phase<pg8::EpiProj, Order, false, DM, DM, DM>(F.lds, g, S, E, tt); }
    {   pg8::Gemm g{(const bf16*)(F.ws + WS_H8), (const bf16*)(layer_w(F, l) + WO_PG + 16 * MiB)};
        typedef pg8::StaticOrder<T, 4096, DM / 2, DM / 2> Order; Order S; S.init(F.G, (int)blockIdx.x);
        pg8::EpiProj E{(bf16*)(F.ws + WS_U), (bf16*)(F.ws + WS_G), ARG_IN(I_BGATE) + (size_t)l * 4096, W8_INV, 16};
        pg8::gemm_phase<pg8::EpiProj, Order, false, DM / 2, DM / 2, DM / 2, true>(F.lds, g, S, E, tt); }
#else
    pg8::Gemm g{(const bf16*)(F.ws + WS_H), (const bf16*)(layer_w(F, l) + WO_PG)};
    typedef pg8::StaticOrder<T, 8192, DM, DM> Order; Order S; S.init(F.G, (int)blockIdx.x);
    pg8::EpiProj E{(bf16*)(F.ws + WS_U), (bf16*)(F.ws + WS_G), ARG_IN(I_BGATE) + (size_t)l * 4096, 1.0f, 0};
    pg8::gemm_phase<pg8::EpiProj, Order, false, DM, DM, DM>(F.lds, g, S, E, tt);
#endif
}
__device__ __forceinline__ void ph_at(int l) {
    Frame F; frame_refresh(F);
#if !ATTN_FAST
    attn_simple(F);
#else
    attn_fast(F);
#endif
    {
        frame_refresh(F);
        const int pu = F.vcu, pm = pu >> 2, g = pu & 3;
        pool_tile(F, pm, g);
        VM_WAIT(); __syncthreads();
    }
    {
        frame_refresh(F);
        const int pu = F.vcu, pm = pu >> 2, g = pu & 3;
        pg8::Gemm gg{(const bf16*)(F.ws + WS_PL), (const bf16*)(layer_w(F, l) + WO_POOL)};
        pg8::OneUnit S; S.u0.pm = pm; S.u0.pn = 0; S.u0.ti = 0; S.u0.aoff = (unsigned)pm * (256u * 1024u * 2u) + (unsigned)g * 512u; S.u0.boff = (unsigned)g * (256u * 256u * 2u); S.u0.aoff2 = 0u; S.u0.boff2 = 0u;
        pg8::EpiPool E{(bf16*)(F.ws + WS_PO), ARG_IN(I_PSCALE) + (size_t)l * 1024, g, G2_FP8 ? (unsigned char*)(F.ws + WS_PO) : (unsigned char*)nullptr};
        pg8::gemm_phase<pg8::EpiPool, pg8::OneUnit, false, 1024, 256, 256>(F.lds, gg, S, E, (const LAS int*)(F.lds + X_TOK));
        __syncthreads();
    }
}
__device__ __forceinline__ void ph_g2(int l) {
    Frame F; frame_refresh(F);
    unsigned char* mg8 = G3_FP8 ? (unsigned char*)(F.ws + WS_MG8) : (unsigned char*)nullptr;
    pg8::Gemm g{(const bf16*)(F.ws + WS_PO), (const bf16*)(layer_w(F, l) + WO_BR)};
#if G2_FP8
    typedef pg8::SplitOrder<pg8::StaticOrder<T, DM, 512, 512>> Order;
    Order S; S.S0.init(F.G, (int)blockIdx.x); S.a2 = (unsigned)(WS_AO - WS_PO); S.b2 = 2048u * 1024u;
    pg8::EpiMerge E{(bf16*)(F.ws + WS_MG), (const unsigned char*)(F.ws + WS_G), mg8, W8_INV};
    pg8::gemm_phase<pg8::EpiMerge, Order, false, 512, 512, 1024, true, 8>(F.lds, g, S, E, (const LAS int*)(F.lds + X_TOK));
#else
    typedef pg8::SplitOrder<pg8::StaticOrder<T, DM, 1024, 1024>> Order;
    Order S; S.S0.init(F.G, (int)blockIdx.x); S.a2 = (unsigned)(WS_AO - WS_PO); S.b2 = 2048u * 1024u * 2u;
    pg8::EpiMerge E{(bf16*)(F.ws + WS_MG), (const unsigned char*)(F.ws + WS_G), mg8, 1.0f};
    pg8::gemm_phase<pg8::EpiMerge, Order, false, 1024, 1024, 2048, false, 16>(F.lds, g, S, E, (const LAS int*)(F.lds + X_TOK));
#endif
}
__device__ __forceinline__ void ph_g3(int l) {
    Frame F; frame_refresh(F);
    const float* gate = (const float*)(F.ws + WS_MOD) + (size_t)l * 8 * MODW + 2 * DM;
#if G3_FP8
    pg8::Gemm g{(const bf16*)(F.ws + WS_MG8), (const bf16*)(layer_w(F, l) + WO_OUT)};
    typedef pg8::StaticOrder<T, DM, DM / 2, DM / 2> Order; Order S; S.init(F.G, (int)blockIdx.x);
    pg8::EpiOut E{(bf16*)(F.ws + WS_DL), gate, W8_INV};
    pg8::gemm_phase<pg8::EpiOut, Order, false, DM / 2, DM / 2, DM / 2, true>(F.lds, g, S, E, (const LAS int*)(F.lds + X_TOK));
#else
    pg8::Gemm g{(const bf16*)(F.ws + WS_MG), (const bf16*)(layer_w(F, l) + WO_OUT)};
    typedef pg8::StaticOrder<T, DM, DM, DM> Order; Order S; S.init(F.G, (int)blockIdx.x);
    pg8::EpiOut E{(bf16*)(F.ws + WS_DL), gate, 1.0f};
    pg8::gemm_phase<pg8::EpiOut, Order, false, DM, DM, DM>(F.lds, g, S, E, (const LAS int*)(F.lds + X_TOK));
#endif
}
__device__ __forceinline__ void ph_m1(int l) {
    Frame F; frame_refresh(F);
    load_expert_tables(F, l);
    const LAS int* misc = (const LAS int*)(F.lds + X_MISC);
    pg8::MoeOrder S; S.G = F.G; S.c = (int)blockIdx.x; S.NT = misc[24]; S.tpre = misc + 8; S.a_tile_bytes = 0u; S.b_exp_bytes = 2048u * 2048u * (MOE_FP8 ? 1u : 2u); S.b_tile_bytes = 256u * 2048u * (MOE_FP8 ? 1u : 2u);
    {
        LAS int* tt = (LAS int*)(F.lds + X_TOK); const int* list = (const int*)(F.ws + WS_LIST);
        pg8::Unit u;
        int tv[8];
#pragma unroll
        for (int i = 0; i < 8; ++i) { tv[i] = -1;
            if (S.next(i, u)) {
                int e = 0;
                for (int j = 1; j < 16; ++j) e += (u.pm >= misc[8 + j]) ? 1 : 0;
                const int mt = u.pm - misc[8 + e], n = misc[32 + e];
                if (F.tid < 256) { int idx = mt * 256 + F.tid; idx = idx < n ? idx : n - 1; tv[i] = list[e * LIST_CAP + idx]; } } }
        __builtin_amdgcn_sched_barrier(0);
#pragma unroll
        for (int i = 0; i < 8; ++i) if (tv[i] >= 0) tt[i * 256 + F.tid] = tv[i];
        VM_WAIT(); __syncthreads();
    }
    pg8::Gemm g{(const bf16*)(F.ws + (MOE_FP8 ? WS_H8 : WS_H)), (const bf16*)(layer_w(F, l) + WO_GU)};
#if MOE_FP8
    pg8::EpiSwiglu8 E{(unsigned char*)(F.ws + WS_ACT)};
    pg8::gemm_phase<pg8::EpiSwiglu8, pg8::MoeOrder, true, DM / 2, DM / 2, DM / 2, true>(F.lds, g, S, E, (const LAS int*)(F.lds + X_TOK));
    frame_refresh(F);
    if (l == 0) cvt_queue_drain(F, 0, Q_FIRST, Q_1); else cvt_queue_drain(F, 2, Q_FIRST + Q_A, Q_B);
#else
    pg8::EpiSwiglu E{(bf16*)(F.ws + WS_ACT)};
    pg8::gemm_phase<pg8::EpiSwiglu, pg8::MoeOrder, true, DM, DM, DM>(F.lds, g, S, E, (const LAS int*)(F.lds + X_TOK));
#endif
}
__device__ __forceinline__ void ph_m2(int l) {
    Frame F; frame_refresh(F);
    if (!MK_ONE_LAUNCH) load_expert_tables(F, l);
    const LAS int* misc = (const LAS int*)(F.lds + X_MISC);
    pg8::MoeOrder S; S.G = F.G; S.c = (int)blockIdx.x; S.NT = misc[24]; S.tpre = misc + 8; S.a_tile_bytes = 256u * 1024u * (MOE_FP8 ? 1u : 2u); S.b_exp_bytes = 2048u * 1024u * (MOE_FP8 ? 1u : 2u); S.b_tile_bytes = 256u * 1024u * (MOE_FP8 ? 1u : 2u);
    pg8::Gemm g{(const bf16*)(F.ws + WS_ACT), (const bf16*)(layer_w(F, l) + WO_D)};
    pg8::EpiDown E{(bf16*)(F.ws + WS_YB), MOE_FP8 ? W8_INV : 1.0f};
#if MOE_FP8
    pg8::gemm_phase<pg8::EpiDown, pg8::MoeOrder, false, DE / 2, DE / 2, DE / 2, true>(F.lds, g, S, E, (const LAS int*)(F.lds + X_TOK));
    if (l == 0) { frame_refresh(F); cvt_queue_drain(F, 1, Q_FIRST + Q_1, Q_A - Q_1); }
#else
    pg8::gemm_phase<pg8::EpiDown, pg8::MoeOrder, false, DE, DE, DE>(F.lds, g, S, E, (const LAS int*)(F.lds + X_TOK));
#endif
}
__device__ __forceinline__ void grid_seam() {
    XcdBarrier bar; bar.bar = (unsigned*)((unsigned char*)arg_in(21) + WS_CTL) + CW_BAR; bar.x = xb_xcc_id(); bar.st = (volatile LAS unsigned*)((LAS unsigned char*)lds_raw + X_MISC);
    xcd_barrier(bar);
}

template <int MODE>
__device__ __forceinline__ void grid_seam_fill(int l) {
    XcdBarrier b; b.bar = (unsigned*)((unsigned char*)arg_in(21) + WS_CTL) + CW_BAR; b.x = xb_xcc_id(); b.st = (volatile LAS unsigned*)((LAS unsigned char*)lds_raw + X_MISC);
    asm volatile("s_waitcnt vmcnt(0)" ::: "memory");
    __syncthreads();
    if (threadIdx.x == 0) {
        unsigned* bar = b.bar;
        __builtin_amdgcn_s_waitcnt(0);
        unsigned nloc = b.st[0], nx = b.st[1];
        if (nloc == 0u) { xcd_barrier_complete(bar, b.x, nloc, nx); b.st[0] = nloc; b.st[1] = nx; }
        const unsigned old = xb_add(&bar[XB_XSUB(b.x)], 1u);
        const unsigned gen = old / nloc;
        if (old + 1u == (gen + 1u) * nloc) {
            __builtin_amdgcn_fence(__ATOMIC_RELEASE, "agent");
            asm volatile("s_waitcnt vmcnt(0)" ::: "memory");
            const unsigned og = xb_add(&bar[XB_TOP], 1u);
            const unsigned tg = og / nx;
            if (og + 1u == (tg + 1u) * nx) xb_add(&bar[XB_TOPGEN], 1u);
            else XB_SPIN(xb_ld(&bar[XB_TOPGEN]) == tg, bar);
            __builtin_amdgcn_fence(__ATOMIC_ACQUIRE, "agent");
            xb_add(&bar[XB_XGEN(b.x)], 1u);
            asm volatile("s_waitcnt vmcnt(0)" ::: "memory");
        } else {
            XB_SPIN(xb_ld(&bar[XB_XGEN(b.x)]) == gen, bar);
            __builtin_amdgcn_fence(__ATOMIC_ACQUIRE, "agent");
            asm volatile("s_waitcnt vmcnt(0)" ::: "memory");
        }
    } else if (threadIdx.x >= 64) {
        const int t = opaque_tid() - 64;
        LAS f32x4* tab = (LAS f32x4*)lds_raw;
        if (MODE == 1) {
            const f32x4* src = (const f32x4*)ARG_IN(I_WROUTER);
            f32x4 tv[19];
#pragma unroll
            for (int k = 0; k < 19; ++k) { const int i = t + k * 448; tv[k] = src[i < DM * 4 ? i : 0]; }
            __builtin_amdgcn_sched_barrier(0);
#pragma unroll
            for (int k = 0; k < 19; ++k) { const int i = t + k * 448; if (i < DM * 4) { const int c = i >> 2, g = i & 3; tab[((g * 4 + (c & 3)) * 8 + (c >> 8)) * 64 + ((c >> 2) & 63)] = tv[k]; } }
        } else {
            const float* src = ARG_IN(I_WIN) + (size_t)l * DM * INW + 4096;
            f32x4 tv[10];
#pragma unroll
            for (int k = 0; k < 10; ++k) { const int i = t + k * 448, ii = i < DM * 2 ? i : 0, c = ii >> 1, g = ii & 1; tv[k] = *(const f32x4*)(src + (size_t)c * INW + g * 4); }
            __builtin_amdgcn_sched_barrier(0);
#pragma unroll
            for (int k = 0; k < 10; ++k) { const int i = t + k * 448; if (i < DM * 2) { const int c = i >> 1, g = i & 1; tab[((g * 4 + (c & 3)) * 8 + (c >> 8)) * 64 + ((c >> 2) & 63)] = tv[k]; } }
        }
    }
    __syncthreads();
}

constexpr int N_PHASES = 18;
#ifndef PHMASK
#define PHMASK 0xFFFF
#endif
#define EN(j) ((PHMASK >> (j)) & 1)
#ifndef DUPMASK
#define DUPMASK 0
#endif
#define DUP(j) ((DUPMASK >> (j)) & 1)
__global__ void __launch_bounds__(NTHREADS, 2) mk_fwd(Args args) {
    {
        LAS unsigned char* lds = (LAS unsigned char*)lds_raw;
        for (int u = threadIdx.x; u < (LDS_BYTES - EXTRA_OFF) / 4; u += NTHREADS) ((LAS unsigned*)(lds + EXTRA_OFF))[u] = 0u;
        __syncthreads();
        if (args.ph_hi - args.ph_lo > 1) (void)xcd_barrier_post((unsigned*)(args.ws + WS_CTL) + CW_BAR, (volatile LAS unsigned*)(lds + X_MISC));
    }
#define IN(k) (arg_i32(176) <= (k) && (k) < arg_i32(180))
#define SEAM(k) do { if (IN(k) && IN((k) + 1)) grid_seam(); } while (0)
    if (EN(0) && IN(0)) ph_p0();
    if (DUP(0) && IN(0)) ph_p0();
    constexpr bool PRE = MK_ONE_LAUNCH != 0;
#define SEAM_FILL(k, MODE, ll) do { if (IN(k) && IN((k) + 1)) { if (PRE) grid_seam_fill<MODE>(ll); else grid_seam(); } } while (0)
    SEAM_FILL(0, 0, 0);
    for (int l = 0; l < DEPTH; ++l) {
        const int pb = 1 + 8 * l;
        if (EN(1) && IN(pb + 0)) ph_r1(l, PRE);
        if (DUP(1) && l == 0 && IN(pb + 0)) { ph_r1(l); ph_r1(l); }
        SEAM(pb + 0);
        if (EN(2) && IN(pb + 1)) ph_g1(l);
        if (DUP(2) && IN(pb + 1)) ph_g1(l);
        SEAM(pb + 1);
        if (EN(3) && IN(pb + 2)) ph_at(l);
        if (DUP(3) && IN(pb + 2)) ph_at(l);
        SEAM(pb + 2);
        if (EN(4) && IN(pb + 3)) ph_g2(l);
        if (DUP(4) && IN(pb + 3)) ph_g2(l);
        SEAM(pb + 3);
        if (EN(5) && IN(pb + 4)) ph_g3(l);
        if (DUP(5) && l == 0 && IN(pb + 4)) { ph_g3(l); ph_g3(l); }
        SEAM_FILL(pb + 4, 1, l);
        if (EN(6) && IN(pb + 5)) ph_r2(l, PRE);
        if (DUP(6) && l == 0 && IN(pb + 5)) { ph_r2_dry(l); ph_r2_dry(l); }
        SEAM(pb + 5);
        if (EN(7) && IN(pb + 6)) ph_m1(l);
        if (DUP(7) && IN(pb + 6)) ph_m1(l);
        SEAM(pb + 6);
        if (EN(8) && IN(pb + 7)) ph_m2(l);
        if (DUP(8) && IN(pb + 7)) ph_m2(l);
        if (l + 1 < DEPTH) SEAM_FILL(pb + 7, 0, l + 1); else SEAM(pb + 7);
    }
    if (EN(9) && IN(17)) ph_final();
#undef IN
#undef SEAM
#undef SEAM_FILL
}

extern "C" void kernel_launch(void* const* d_in, const int* in_sizes, int n_in, void* d_out, int out_size, void* d_ws, size_t ws_size, hipStream_t stream) {
    static int grid = 0;
    if (grid == 0) {
        if (n_in != 20 || out_size != T * DM || ws_size < WS_END) { fprintf(stderr, "kernel_launch: unexpected shapes (n_in %d out %d ws %zu)\n", n_in, out_size, ws_size); grid = -1; return; }
        int dev = 0, cus = 0, per_cu = 0;
        if (hipGetDevice(&dev) != hipSuccess || hipDeviceGetAttribute(&cus, hipDeviceAttributeMultiprocessorCount, dev) != hipSuccess) { grid = -1; return; }
        if (hipFuncSetAttribute((const void*)mk_fwd, hipFuncAttributeMaxDynamicSharedMemorySize, LDS_BYTES) != hipSuccess) { fprintf(stderr, "kernel_launch: hipFuncSetAttribute failed\n"); grid = -1; return; }
        if (hipOccupancyMaxActiveBlocksPerMultiprocessor(&per_cu, (const void*)mk_fwd, NTHREADS, LDS_BYTES) != hipSuccess || per_cu < 1) { fprintf(stderr, "kernel_launch: occupancy query says %d\n", per_cu); }
        (void)hipGetLastError();
        grid = cus;
    }
    if (grid < 0) return;
    (void)hipMemsetAsync((char*)d_ws + WS_CTL, 0, CTL_ZERO_BYTES, stream);
    Args a{};
    for (int i = 0; i < 20; ++i) a.in[i] = (const float*)d_in[i];
    a.out = (float*)d_out; a.ws = (unsigned char*)d_ws;
#if MK_ONE_LAUNCH
    a.ph_lo = 0; a.ph_hi = N_PHASES;
    hipLaunchKernelGGL(mk_fwd, dim3(grid), dim3(NTHREADS), LDS_BYTES, stream, a);
#else
    for (int p = 0; p < N_PHASES; ++p) { a.ph_lo = p; a.ph_hi = p + 1; hipLaunchKernelGGL(mk_fwd, dim3(grid), dim3(NTHREADS), LDS_BYTES, stream, a); }
#endif
}
```

```cpp
#include <hip/hip_runtime.h>
#include <stdio.h>
#include <stdint.h>

#ifndef MK_ONE_LAUNCH
#define MK_ONE_LAUNCH 1
#endif
#ifndef MOE_FP8
#define MOE_FP8 1
#endif
#ifndef G1_FP8
#define G1_FP8 2
#endif
#ifndef G3_FP8
#define G3_FP8 1
#endif
#ifndef G2_FP8
#define G2_FP8 1
#endif
#ifndef YB_FP8
#define YB_FP8 1
#endif
#ifndef GEMM_FAST
#define GEMM_FAST 1
#endif
#ifndef ATTN_FAST
#define ATTN_FAST 1
#endif

#define GAS __attribute__((address_space(1)))
#define LAS __attribute__((address_space(3)))
typedef unsigned short bf16;
typedef short bf16x8 __attribute__((ext_vector_type(8)));
typedef float f32x4 __attribute__((ext_vector_type(4)));
typedef float f32x2 __attribute__((ext_vector_type(2)));
typedef unsigned u32x4 __attribute__((ext_vector_type(4)));
typedef unsigned u32x2 __attribute__((ext_vector_type(2)));
typedef GAS unsigned gu32;
#define RLX_AGENT __ATOMIC_RELAXED, __HIP_MEMORY_SCOPE_AGENT
#define LDS_WAIT() asm volatile("s_waitcnt lgkmcnt(0)" ::: "memory")
#define VM_WAIT() asm volatile("s_waitcnt vmcnt(0)" ::: "memory")

constexpr int DM = 2048, BATCH = 8, SEQ = 2048, T = BATCH * SEQ, DEPTH = 2;
constexpr int PW = 1024, AW = 1024, NH = 8, HD = 128, INW = 4104, NE = 16, DE = 1024, NMOD = 6;
constexpr int MODW = NMOD * DM;
constexpr float EPS = 1e-6f;
constexpr int NWAVES = 8, NTHREADS = 512;
constexpr int LIST_CAP = 16384;
constexpr int MAX_RT = 144;

constexpr size_t MiB = 1u << 20;
constexpr size_t WS_CTL = 0, CTL_ZERO_BYTES = 1 * MiB;
constexpr size_t WS_MOD = 1 * MiB;
constexpr size_t WS_W = 2 * MiB, W_LAYER = 241 * MiB;
constexpr size_t WO_PG = 0, WO_POOL = 32 * MiB, WO_BR = 33 * MiB, WO_OUT = 41 * MiB, WO_GU = 49 * MiB, WO_D = 177 * MiB;
constexpr size_t WS_H = 484 * MiB;
constexpr size_t WS_U = 548 * MiB, WS_Q = 580 * MiB, WS_K = 612 * MiB, WS_V = 644 * MiB;
constexpr size_t WS_G = 676 * MiB;
constexpr size_t WS_PL = 804 * MiB, WS_PO = 836 * MiB, WS_AO = 868 * MiB;
constexpr size_t WS_MG = 900 * MiB;
constexpr size_t WS_DL = 804 * MiB;
constexpr size_t WS_ACT = 804 * MiB;
constexpr size_t WS_YB = 548 * MiB;
constexpr size_t WS_LS = 964 * MiB;
constexpr size_t WS_TOKE = 965 * MiB;
constexpr size_t WS_TOKW = WS_TOKE + 128 * 1024;
constexpr size_t WS_TOKP = WS_TOKW + 128 * 1024;
constexpr size_t WS_LIST = 966 * MiB;
constexpr size_t WS_MODP = 968 * MiB;
constexpr size_t WS_H8 = 972 * MiB;
constexpr size_t WS_XB = 1004 * MiB;
constexpr size_t WS_MG8 = 1068 * MiB;
constexpr size_t WS_END = 1100 * MiB;
constexpr int CW_BAR = 4096;
constexpr int CW_CNT = 16384;

constexpr int RING_BYTES = 131072;
constexpr int EXTRA_OFF = 135168;
constexpr int LDS_BYTES = 147456;
constexpr int X_MISC = EXTRA_OFF;
constexpr int X_TOK = EXTRA_OFF + 1024;
constexpr int X_ASG = EXTRA_OFF + 9216;

typedef __bf16 bf16x2_t __attribute__((ext_vector_type(2)));
__device__ __forceinline__ unsigned cvt_pk_bf16(float lo, float hi) { f32x2 v = {lo, hi}; bf16x2_t b = __builtin_convertvector(v, bf16x2_t); return __builtin_bit_cast(unsigned, b); }
typedef int i32x8 __attribute__((ext_vector_type(8)));
typedef int i32x4 __attribute__((ext_vector_type(4)));
__device__ __forceinline__ unsigned pk4_fp8(float a, float b, float c, float d) { int w = __builtin_amdgcn_cvt_pk_fp8_f32(a, b, 0, false); w = __builtin_amdgcn_cvt_pk_fp8_f32(c, d, w, true); return (unsigned)w; }
__device__ __forceinline__ unsigned pk4_unorm8(const f32x4 v) { unsigned w = 0;
    w = __builtin_amdgcn_cvt_pk_u8_f32(__builtin_floorf(v[0] * 255.0f + 0.5f), 0, w); w = __builtin_amdgcn_cvt_pk_u8_f32(__builtin_floorf(v[1] * 255.0f + 0.5f), 1, w);
    w = __builtin_amdgcn_cvt_pk_u8_f32(__builtin_floorf(v[2] * 255.0f + 0.5f), 2, w); w = __builtin_amdgcn_cvt_pk_u8_f32(__builtin_floorf(v[3] * 255.0f + 0.5f), 3, w); return w; }
__device__ __forceinline__ f32x4 unpk4_u8(unsigned w) { return (f32x4){(float)(w & 0xffu), (float)((w >> 8) & 0xffu), (float)((w >> 16) & 0xffu), (float)(w >> 24)}; }
__device__ __forceinline__ f32x4 unpk4_unorm8(unsigned w) { return (f32x4){(float)(w & 0xffu), (float)((w >> 8) & 0xffu), (float)((w >> 16) & 0xffu), (float)(w >> 24)} * (1.0f / 255.0f); }
__device__ __forceinline__ f32x4 unpk4_fp8(unsigned w) { const f32x2 lo = __builtin_amdgcn_cvt_pk_f32_fp8((int)w, false), hi = __builtin_amdgcn_cvt_pk_f32_fp8((int)w, true); return (f32x4){lo.x, lo.y, hi.x, hi.y}; }
constexpr float W8_SCALE = 32.0f, W8_INV = 1.0f / 32.0f;
__device__ __forceinline__ float bf_lo(unsigned w) { return __uint_as_float(w << 16); }
__device__ __forceinline__ float bf_hi(unsigned w) { return __uint_as_float(w & 0xffff0000u); }
__device__ __forceinline__ float wave_sum(float v) {
#pragma unroll
    for (int o = 1; o < 64; o <<= 1) v += __shfl_xor(v, o);
    return v;
}
template <int CTRL, int ROW_MASK> __device__ __forceinline__ float dpp_get(float v) { return __int_as_float(__builtin_amdgcn_update_dpp(0, __float_as_int(v), CTRL, ROW_MASK, 0xf, false)); }
__device__ __forceinline__ float wave_sum_u(float v) {
    v += dpp_get<0xB1, 0xf>(v);
    v += dpp_get<0x4E, 0xf>(v);
    v += dpp_get<0x141, 0xf>(v);
    v += dpp_get<0x140, 0xf>(v);
    v += dpp_get<0x142, 0xa>(v);
    v += dpp_get<0x143, 0xc>(v);
    return __int_as_float(__builtin_amdgcn_readlane(__float_as_int(v), 63));
}
__device__ __forceinline__ float wave_max(float v) {
#pragma unroll
    for (int o = 1; o < 64; o <<= 1) v = fmaxf(v, __shfl_xor(v, o));
    return v;
}
__device__ __forceinline__ float sigmoidf_(float x) { return __builtin_amdgcn_rcpf(1.0f + __builtin_amdgcn_exp2f(-1.4426950408889634f * x)); }

__device__ __forceinline__ int opaque_tid() { int t = threadIdx.x; asm volatile("" : "+v"(t)); return t; }

#define XB_TMO      128
#define XB_XCNT(j)  (256  + 64 * (j))
#define XB_XSUB(j)  (1280 + 64 * (j))
#define XB_XGEN(j)  (2304 + 64 * (j))
#define XB_TOP      3328
#define XB_TOPGEN   3392
#define XCD_BAR_WORDS 3456
#define XB_SPIN_CAP (1u << 24)
__device__ __forceinline__ unsigned xb_ld(unsigned* p)              { return __hip_atomic_load(p, __ATOMIC_RELAXED, __HIP_MEMORY_SCOPE_AGENT); }
__device__ __forceinline__ unsigned xb_add(unsigned* p, unsigned v) { return __hip_atomic_fetch_add(p, v, __ATOMIC_RELAXED, __HIP_MEMORY_SCOPE_AGENT); }
__device__ __forceinline__ unsigned xb_xcc_id() { return (unsigned)__builtin_amdgcn_s_getreg((3 << 11) | 20) & 0xFu; }
#define XB_SPIN(cond, bar) do { unsigned _sp = 0; while (cond) { __builtin_amdgcn_s_sleep(1); \
    if ((++_sp & 255u) == 0u) { if (xb_ld(&(bar)[XB_TMO])) break; if (_sp > XB_SPIN_CAP) { atomicAdd(&(bar)[XB_TMO], 1u); break; } } } } while (0)
struct XcdBarrier { unsigned* bar; unsigned x; volatile LAS unsigned* st; };
__device__ __forceinline__ XcdBarrier xcd_barrier_post(unsigned* bar, volatile LAS unsigned* st) {
    XcdBarrier b; b.bar = bar; b.x = xb_xcc_id(); b.st = st;
    if (threadIdx.x == 0) (void)xb_add(&bar[XB_XCNT(b.x)], 1u);
    return b;
}
__device__ __forceinline__ void xcd_barrier_complete(unsigned* bar, unsigned x, unsigned& nloc, unsigned& nx) {
    const unsigned G = gridDim.x * gridDim.y * gridDim.z;
    unsigned sum, cnt, mine, sp = 0u;
    for (;;) {
        sum = 0u; cnt = 0u; mine = 0u;
#pragma unroll
        for (unsigned j = 0; j < 16; ++j) { const unsigned c = xb_ld(&bar[XB_XCNT(j)]); sum += c; cnt += (c > 0u) ? 1u : 0u; mine = (j == x) ? c : mine; }
        if (sum == G) break;
        __builtin_amdgcn_s_sleep(1);
        if ((++sp & 255u) == 0u) { if (xb_ld(&bar[XB_TMO])) break; if (sp > XB_SPIN_CAP) { atomicAdd(&bar[XB_TMO], 1u); break; } }
    }
    nloc = mine > 0u ? mine : 1u; nx = cnt > 0u ? cnt : 1u;
}
__device__ __forceinline__ void xcd_barrier(const XcdBarrier& b) {
    asm volatile("s_waitcnt vmcnt(0)" ::: "memory");
    __syncthreads();
    if (threadIdx.x == 0) {
        unsigned* bar = b.bar;
        __builtin_amdgcn_s_waitcnt(0);
        unsigned nloc = b.st[0], nx = b.st[1];
        if (nloc == 0u) { xcd_barrier_complete(bar, b.x, nloc, nx); b.st[0] = nloc; b.st[1] = nx; }
        const unsigned old = xb_add(&bar[XB_XSUB(b.x)], 1u);
        const unsigned gen = old / nloc;
        if (old + 1u == (gen + 1u) * nloc) {
            __builtin_amdgcn_fence(__ATOMIC_RELEASE, "agent");
            asm volatile("s_waitcnt vmcnt(0)" ::: "memory");
            const unsigned og = xb_add(&bar[XB_TOP], 1u);
            const unsigned tg = og / nx;
            if (og + 1u == (tg + 1u) * nx) xb_add(&bar[XB_TOPGEN], 1u);
            else XB_SPIN(xb_ld(&bar[XB_TOPGEN]) == tg, bar);
            __builtin_amdgcn_fence(__ATOMIC_ACQUIRE, "agent");
            xb_add(&bar[XB_XGEN(b.x)], 1u);
            asm volatile("s_waitcnt vmcnt(0)" ::: "memory");
        } else {
            XB_SPIN(xb_ld(&bar[XB_XGEN(b.x)]) == gen, bar);
            __builtin_amdgcn_fence(__ATOMIC_ACQUIRE, "agent");
            asm volatile("s_waitcnt vmcnt(0)" ::: "memory");
        }
    }
    __syncthreads();
}

namespace pg8 {
constexpr int BM = 256, BK = 64, HALF = 128, HTB = HALF * BK * 2, STAGE_BYTES = 8 * HTB, NXCD = 8, WGM = 8;
__device__ __forceinline__ int lds_byte(int r, int c) { const int st = (r >> 4) * 2 + (c >> 5), rr = r & 15, cc = c & 31, ob = rr * 64 + cc * 2; return st * 1024 + (ob ^ (((ob >> 9) & 1) << 5)); }
__device__ __forceinline__ void stage_rc(int b, int& R, int& C) { const int st = b / 1024, sb = b % 1024, swz = sb ^ (((sb >> 9) & 1) << 5); R = (st >> 1) * 16 + swz / 64; C = (st & 1) * 32 + (swz % 64) / 2; }
__device__ __forceinline__ int perm32(int rho) { const int n = rho >> 4, i = rho & 15; return 8 * (i >> 2) + 4 * n + (i & 3); }

struct Unit { int pm, pn, ti; unsigned aoff, boff, aoff2, boff2; };
struct Gemm { const bf16* A; const bf16* Bt; };

template <int M_, int N_, int LDA, int LDB> struct StaticOrder {
    static constexpr int nM = M_ / BM, nN = N_ / BM, nwg = nM * nN;
    int G, c;
    __device__ void init(int G_, int c_) { G = G_; c = c_; }
    __device__ bool next(int i, Unit& u) const {
        const int L = i * G + c; if (L >= nwg) return false;
        int wgid = L; { constexpr int q = nwg / NXCD, r = nwg % NXCD; const int xcd = wgid % NXCD, off = wgid / NXCD; wgid = (xcd < r ? xcd * (q + 1) : r * (q + 1) + (xcd - r) * q) + off; }
        constexpr int nig = WGM * nN; const int gid = wgid / nig, fm = gid * WGM, gsz = (nM - fm) < WGM ? (nM - fm) : WGM;
        u.pm = fm + ((wgid % nig) % gsz); u.pn = (wgid % nig) / gsz; u.ti = i;
        u.aoff = (unsigned)u.pm * (unsigned)(BM * LDA * 2); u.boff = (unsigned)u.pn * (unsigned)(BM * LDB * 2); u.aoff2 = 0u; u.boff2 = 0u;
        return true;
    }
};
template <class Base> struct BranchOrder {
    Base S0; unsigned a_step, b_step;
    __device__ bool next(int i, Unit& u) const { if (!S0.next(i >> 1, u)) return false; const unsigned p = (unsigned)(i & 1); u.ti = (int)p; u.aoff += p * a_step; u.boff += p * b_step; return true; }
};
template <class Base> struct SplitOrder {
    Base S0; unsigned a2, b2;
    __device__ bool next(int i, Unit& u) const { if (!S0.next(i, u)) return false; u.aoff2 = u.aoff + a2; u.boff2 = u.boff + b2; return true; }
};
struct OneUnit {
    Unit u0;
    __device__ bool next(int i, Unit& u) const { if (i > 0) return false; u = u0; return true; }
};
struct MoeOrder {
    int G, c, NT; const LAS int* tpre; unsigned a_tile_bytes, b_exp_bytes, b_tile_bytes;
    __device__ bool next(int i, Unit& u) const {
        const int L = i * G + c; const int x = L & 7, a = L >> 3, pn = a & 7, q = a >> 3;
        const int rt = (G == 256) ? 32 * i + 4 * x + (c >> 6) : q * 8 + x;
        if (rt >= NT) return false;
        int e = 0;
#pragma unroll
        for (int j = 1; j < 16; ++j) e += (rt >= tpre[j]) ? 1 : 0;
        e = __builtin_amdgcn_readfirstlane(e);
        u.pm = rt; u.pn = pn; u.ti = i; u.aoff = (unsigned)rt * a_tile_bytes; u.boff = (unsigned)e * b_exp_bytes + (unsigned)pn * b_tile_bytes; u.aoff2 = 0u; u.boff2 = 0u;
        return true;
    }
};

#if !GEMM_FAST
template <class Epi, class Sched, bool GATHER, int LDA, int LDB, int KK>
__device__ __forceinline__ void gemm_phase(LAS unsigned char* lds, const Gemm g, const Sched& S, const Epi& E, const LAS int* tokTab) {
    const int tid = opaque_tid(), wid = __builtin_amdgcn_readfirstlane(tid >> 6), lane = tid & 63, wr = wid >> 2, wc = wid & 3, fr = lane & 15, fq = lane >> 4;
    Unit u;
    for (int i = 0; S.next(i, u); ++i) {
        f32x4 acc[2][2][4][2];
#pragma unroll
        for (int a = 0; a < 2; ++a)
#pragma unroll
            for (int b = 0; b < 2; ++b)
#pragma unroll
                for (int m = 0; m < 4; ++m)
#pragma unroll
                    for (int n = 0; n < 2; ++n) acc[a][b][m][n] = (f32x4){0.f, 0.f, 0.f, 0.f};
        const char* Ab = (const char*)g.A + u.aoff; const char* Bb = (const char*)g.Bt + u.boff;
        unsigned arow[2][4], brow[2][2];
#pragma unroll
        for (int ai = 0; ai < 2; ++ai)
#pragma unroll
            for (int m = 0; m < 4; ++m) { const int r = ai * HALF + wr * 64 + m * 16 + fr;
                arow[ai][m] = (GATHER ? (unsigned)tokTab[u.ti * 256 + r] : (unsigned)r) * (unsigned)(LDA * 2); }
#pragma unroll
        for (int bj = 0; bj < 2; ++bj)
#pragma unroll
            for (int n = 0; n < 2; ++n) { const int slot = 16 * n + fr; const int rb = bj * HALF + wc * 32 + (Epi::PERM ? perm32(slot) : slot); brow[bj][n] = (unsigned)rb * (unsigned)(LDB * 2); }
#pragma nounroll
        for (int k0 = 0; k0 < KK; k0 += 32) {
            bf16x8 Bf[2][2];
            const unsigned kb = (unsigned)(k0 + fq * 8) * 2u;
#pragma unroll
            for (int bj = 0; bj < 2; ++bj)
#pragma unroll
                for (int n = 0; n < 2; ++n) Bf[bj][n] = *(const bf16x8*)(Bb + brow[bj][n] + kb);
#pragma unroll
            for (int ai = 0; ai < 2; ++ai) {
                bf16x8 Af[4];
#pragma unroll
                for (int m = 0; m < 4; ++m) Af[m] = *(const bf16x8*)(Ab + arow[ai][m] + kb);
#pragma unroll
                for (int bj = 0; bj < 2; ++bj)
#pragma unroll
                    for (int m = 0; m < 4; ++m)
#pragma unroll
                        for (int n = 0; n < 2; ++n) acc[ai][bj][m][n] = __builtin_amdgcn_mfma_f32_16x16x32_bf16(Bf[bj][n], Af[m], acc[ai][bj][m][n], 0, 0, 0);
                asm volatile("" ::: "memory");
            }
        }
        E(acc, u, wr, wc, fr, fq);
    }
    (void)lds;
}
#else
template <class Epi, class Sched, bool GATHER, int LDA, int LDB, int KK, bool FP8 = false, int KSPLIT = 0>
__device__ __forceinline__ void gemm_phase(LAS unsigned char* lds, const Gemm g, const Sched& S, const Epi& E, const LAS int* tokTab) {
    constexpr bool ALIGN_EPI = true; constexpr int KS = KSPLIT;
    const int tid = opaque_tid(), wid = __builtin_amdgcn_readfirstlane(tid >> 6), lane = tid & 63, wr = wid >> 2, wc = wid & 3, fr = lane & 15, fq = lane >> 4;
    constexpr int nt = KK / BK;
    unsigned voffA[2], voffB[2];
#pragma unroll
    for (int i = 0; i < 2; ++i) { int R, C; stage_rc(tid * 16 + i * 8192, R, C); const int Rb = Epi::PERM ? ((R & ~31) + perm32(R & 31)) : R;
        voffA[i] = (unsigned)(R * LDA + C) * 2u; voffB[i] = (unsigned)(Rb * LDB + C) * 2u; }
    constexpr unsigned rowA = (unsigned)LDA * 2u;
    constexpr unsigned kstep = (unsigned)(BK * 2);
    constexpr unsigned hstepA = (unsigned)HALF * LDA * 2u, hstepB = (unsigned)HALF * LDB * 2u;
    const unsigned ldsw = (unsigned)wid * 1024u;
    const int aoff = lds_byte(wr * 64 + fr, fq * 8), boff = lds_byte(wc * 32 + fr, fq * 8);
#define PG8_SA(b, h) (((b) * 2 + (h)) * HTB)
#define PG8_SB(b, h) ((4 + (b) * 2 + (h)) * HTB)
#define PG8_STAGE(bufoff, gbase, uoff, voff) do { _Pragma("unroll") for (int _i = 0; _i < 2; ++_i) \
        __builtin_amdgcn_global_load_lds((const unsigned*)((const char*)(gbase) + (size_t)(unsigned)((uoff) + (voff)[_i])), (LAS unsigned*)(lds + (bufoff) + ldsw + _i * 8192), 16, 0, 0); } while (0)
#define PG8_STAGE_A(bufoff, p, hh, VA) do { if constexpr (GATHER) { PG8_STAGE(bufoff, g.A, p, VA[hh]); } else { PG8_STAGE(bufoff, g.A, (p) + (hh) * hstepA, voffA); } } while (0)
#define PG8_STAGE_B(bufoff, p) PG8_STAGE(bufoff, g.Bt, p, voffB)
#define PG8_LD32(p) __builtin_shufflevector(*(const LAS i32x4*)(p), *(const LAS i32x4*)((p) + 1024), 0, 1, 2, 3, 4, 5, 6, 7)
#define PG8_LDA(dst, b, h) do { if constexpr (FP8) { _Pragma("unroll") for (int m = 0; m < 4; ++m) dst##8[m] = PG8_LD32(lds + PG8_SA(b, h) + aoff + m * 2048); } \
        else { _Pragma("unroll") for (int m = 0; m < 4; ++m) _Pragma("unroll") for (int k = 0; k < 2; ++k) dst[m][k] = *(const LAS bf16x8*)(lds + PG8_SA(b, h) + aoff + m * 2048 + k * 1024); } } while (0)
#define PG8_LDB(dst, b, h) do { if constexpr (FP8) { _Pragma("unroll") for (int n = 0; n < 2; ++n) dst##8[n] = PG8_LD32(lds + PG8_SB(b, h) + boff + n * 2048); } \
        else { _Pragma("unroll") for (int n = 0; n < 2; ++n) _Pragma("unroll") for (int k = 0; k < 2; ++k) dst[n][k] = *(const LAS bf16x8*)(lds + PG8_SB(b, h) + boff + n * 2048 + k * 1024); } } while (0)
#define PG8_MMA(ai, bj, At, Bt) do { __builtin_amdgcn_s_setprio(1); _Pragma("unroll") for (int m = 0; m < 4; ++m) _Pragma("unroll") for (int n = 0; n < 2; ++n) { \
        if constexpr (FP8) { asm volatile("v_mfma_f32_16x16x128_f8f6f4 %0, %1, %2, %0" : "+v"(acc[ai][bj][m][n]) : "v"(Bt##8[n]), "v"(At##8[m])); }   \
        else { _Pragma("unroll") for (int k = 0; k < 2; ++k) acc[ai][bj][m][n] = __builtin_amdgcn_mfma_f32_16x16x32_bf16(Bt[n][k], At[m][k], acc[ai][bj][m][n], 0, 0, 0); } } \
        __builtin_amdgcn_s_setprio(0); } while (0)
#define PG8_WAIT_V(n) asm volatile("s_waitcnt vmcnt(" #n ")" ::: "memory")
#define PG8_WAIT_L(n) asm volatile("s_waitcnt lgkmcnt(" #n ")" ::: "memory")
#define PG8_BAR __builtin_amdgcn_s_barrier()
#define PG8_SCHED __builtin_amdgcn_sched_barrier(0)
#define PG8_AOFFS(dst, uu) do { _Pragma("unroll") for (int _i = 0; _i < 2; ++_i) { int _R, _C; stage_rc(tid * 16 + _i * 8192, _R, _C); _Pragma("unroll") for (int _h = 0; _h < 2; ++_h) \
        dst[_h][_i] = (unsigned)tokTab[(uu).ti * 256 + _h * HALF + _R] * rowA + (unsigned)_C * 2u; } } while (0)
#define PG8_TRIP(VC, V2) do { \
        PG8_LDB(B0, 0, 0); PG8_LDB(B1, 0, 1); PG8_SCHED; PG8_LDA(At, 0, 0); PG8_STAGE_A(PG8_SA(1, 1), a1, 1, VC); \
        PG8_WAIT_V(8); PG8_WAIT_L(0); PG8_BAR; PG8_MMA(0, 0, At, B0); PG8_MMA(0, 1, At, B1); PG8_BAR; PG8_SCHED; \
        PG8_LDA(At, 0, 1); PG8_STAGE_B(PG8_SB(0, 0), b2); PG8_STAGE_B(PG8_SB(0, 1), b2 + hstepB); PG8_STAGE_A(PG8_SA(0, 0), a2, 0, V2); \
        PG8_WAIT_V(8); PG8_WAIT_L(0); PG8_BAR; PG8_MMA(1, 0, At, B0); PG8_MMA(1, 1, At, B1); PG8_BAR; PG8_SCHED; \
        PG8_LDB(B0, 1, 0); PG8_LDB(B1, 1, 1); PG8_SCHED; PG8_LDA(At, 1, 0); PG8_STAGE_A(PG8_SA(0, 1), a2, 1, V2); \
        PG8_WAIT_V(8); PG8_WAIT_L(0); PG8_BAR; PG8_MMA(0, 0, At, B0); PG8_MMA(0, 1, At, B1); PG8_BAR; PG8_SCHED; \
        PG8_LDA(At, 1, 1); PG8_STAGE_B(PG8_SB(1, 0), b3); PG8_STAGE_B(PG8_SB(1, 1), b3 + hstepB); PG8_STAGE_A(PG8_SA(1, 0), a3, 0, V2); \
        PG8_WAIT_V(8); PG8_WAIT_L(0); PG8_BAR; PG8_MMA(1, 0, At, B0); PG8_MMA(1, 1, At, B1); PG8_BAR; PG8_SCHED; } while (0)
    Unit cur, nxt; int ui = 0;
    if (!S.next(0, cur)) return;
    f32x4 acc[2][2][4][2];
#pragma unroll
    for (int a = 0; a < 2; ++a)
#pragma unroll
        for (int b = 0; b < 2; ++b)
#pragma unroll
            for (int m = 0; m < 4; ++m)
#pragma unroll
                for (int n = 0; n < 2; ++n) acc[a][b][m][n] = (f32x4){0.f, 0.f, 0.f, 0.f};
    bf16x8 At[4][2], B0[2][2], B1[2][2]; i32x8 At8[4], B08[2], B18[2];
    unsigned vAc[2][2] = {{0u, 0u}, {0u, 0u}}, vAn[2][2] = {{0u, 0u}, {0u, 0u}};
    if constexpr (GATHER) { PG8_AOFFS(vAn, cur); vAc[1][0] = vAn[1][0]; vAc[1][1] = vAn[1][1]; }
    unsigned cA = cur.aoff, cB = cur.boff, cA2 = cur.aoff2, cB2 = cur.boff2;
#define PG8_KOFF(b1, b2, kt) ((KS != 0 && (kt) >= KS) ? (b2) + (unsigned)((kt) - KS) * kstep : (b1) + (unsigned)(kt) * kstep)
    PG8_STAGE_B(PG8_SB(0, 0), cB); PG8_STAGE_B(PG8_SB(0, 1), cB + hstepB); PG8_STAGE_A(PG8_SA(0, 0), cA, 0, vAn); PG8_STAGE_A(PG8_SA(0, 1), cA, 1, vAn);
    if (wr == 1) PG8_BAR;
    PG8_WAIT_V(2); PG8_BAR;
    PG8_STAGE_B(PG8_SB(1, 0), cB + kstep); PG8_STAGE_A(PG8_SA(1, 0), cA + kstep, 0, vAn); PG8_STAGE_B(PG8_SB(1, 1), cB + hstepB + kstep);
    PG8_WAIT_V(6); PG8_BAR;
    for (;;) {
        const bool has_next = S.next(ui + 1, nxt);
        const unsigned nA = has_next ? nxt.aoff : cA, nB = has_next ? nxt.boff : cB;
#pragma nounroll
        for (int t = 0; t < nt; t += 2) {
            const bool last = (t == nt - 2);
            const unsigned a1 = PG8_KOFF(cA, cA2, t + 1);
            const unsigned a2 = last ? nA : PG8_KOFF(cA, cA2, t + 2), b2 = last ? nB : PG8_KOFF(cB, cB2, t + 2);
            const unsigned a3 = a2 + kstep, b3 = b2 + kstep;
            if constexpr (GATHER) { if (last && has_next) { PG8_AOFFS(vAn, nxt); } }
            if constexpr (KS != 0) { if (t == KS) {
                if constexpr (FP8) asm volatile("s_nop 15\n\ts_nop 15" ::: "memory");
                E.mid(acc, cur, wr, wc, fr, fq); } }
            PG8_TRIP(vAc, vAn);
        }
        if constexpr (ALIGN_EPI) { if (wr == 0) PG8_BAR; }
        if constexpr (FP8) asm volatile("s_nop 15\n\ts_nop 15" ::: "memory");
        E(acc, cur, wr, wc, fr, fq);
        if (!has_next) break;
#pragma unroll
        for (int a = 0; a < 2; ++a)
#pragma unroll
            for (int b = 0; b < 2; ++b)
#pragma unroll
                for (int m = 0; m < 4; ++m)
#pragma unroll
                    for (int n = 0; n < 2; ++n) acc[a][b][m][n] = (f32x4){0.f, 0.f, 0.f, 0.f};
        cur = nxt; cA = nA; cB = nB; cA2 = cur.aoff2; cB2 = cur.boff2; ++ui;
        if constexpr (GATHER) { vAc[1][0] = vAn[1][0]; vAc[1][1] = vAn[1][1]; }
        if constexpr (ALIGN_EPI) { if (wr == 1) PG8_BAR; }
    }
    PG8_WAIT_V(0);
    if constexpr (!ALIGN_EPI) { if (wr == 0) PG8_BAR; }
    PG8_BAR;
#undef PG8_SA
#undef PG8_SB
#undef PG8_STAGE
#undef PG8_STAGE_A
#undef PG8_STAGE_B
#undef PG8_LDA
#undef PG8_LD32
#undef PG8_LDB
#undef PG8_MMA
#undef PG8_WAIT_V
#undef PG8_WAIT_L
#undef PG8_BAR
#undef PG8_SCHED
#undef PG8_AOFFS
#undef PG8_TRIP
#undef PG8_KOFF
    (void)rowA; (void)vAn;
}
#endif

typedef f32x4 Acc[2][2][4][2];
__device__ __forceinline__ u32x4 pack8(const f32x4 v0, const f32x4 v1) { u32x4 w; w.x = cvt_pk_bf16(v0[0], v0[1]); w.y = cvt_pk_bf16(v0[2], v0[3]); w.z = cvt_pk_bf16(v1[0], v1[1]); w.w = cvt_pk_bf16(v1[2], v1[3]); return w; }
__device__ __forceinline__ void unpack8(const u32x4 w, f32x4& v0, f32x4& v1) { v0 = (f32x4){bf_lo(w.x), bf_hi(w.x), bf_lo(w.y), bf_hi(w.y)}; v1 = (f32x4){bf_lo(w.z), bf_hi(w.z), bf_lo(w.w), bf_hi(w.w)}; }

struct EpiProj {
    static constexpr bool PERM = true;
    bf16* UQKV; bf16* Gt; const float* bgate; float mul; int pn_off;
    __device__ __forceinline__ void operator()(const Acc& acc, const Unit& u, int wr, int wc, int fr, int fq) const {
        const int row0 = u.pm * BM + wr * 64 + fr; const int pn = u.pn + pn_off;
        if (pn < 16) {
            bf16* base = UQKV + (size_t)(pn >> 2) * ((size_t)T * 1024) + (pn & 3) * 256 + wc * 32 + 8 * fq;
#pragma unroll
            for (int ai = 0; ai < 2; ++ai)
#pragma unroll
                for (int m = 0; m < 4; ++m) { bf16* rowp = base + (size_t)(row0 + ai * HALF + m * 16) * 1024;
#pragma unroll
                    for (int bj = 0; bj < 2; ++bj) *(u32x4*)(rowp + bj * HALF) = pack8(acc[ai][bj][m][0] * mul, acc[ai][bj][m][1] * mul); }
        } else {
            const int gc = (pn - 16) * 256 + wc * 32 + 8 * fq;
            f32x4 bv[2][2];
#pragma unroll
            for (int bj = 0; bj < 2; ++bj)
#pragma unroll
                for (int n = 0; n < 2; ++n) bv[bj][n] = *(const f32x4*)(bgate + gc + bj * HALF + 4 * n);
#pragma unroll
            for (int ai = 0; ai < 2; ++ai)
#pragma unroll
                for (int m = 0; m < 4; ++m) { unsigned char* rowp = (unsigned char*)Gt + (size_t)(row0 + ai * HALF + m * 16) * 4096 + gc;
#pragma unroll
                    for (int bj = 0; bj < 2; ++bj) { f32x4 v0 = acc[ai][bj][m][0] * mul + bv[bj][0], v1 = acc[ai][bj][m][1] * mul + bv[bj][1];
#pragma unroll
                        for (int j = 0; j < 4; ++j) { v0[j] = sigmoidf_(v0[j]); v1[j] = sigmoidf_(v1[j]); }
                        u32x2 w; w.x = pk4_unorm8(v0); w.y = pk4_unorm8(v1); *(u32x2*)(rowp + bj * HALF) = w; } }
        }
    }
};
struct EpiPool {
    static constexpr bool PERM = true;
    bf16* PO; const float* pscale; int g; unsigned char* PO8;
    __device__ __forceinline__ void operator()(const Acc& acc, const Unit& u, int wr, int wc, int fr, int fq) const {
        const int row0 = u.pm * BM + wr * 64 + fr; const int c0 = g * 256 + wc * 32 + 8 * fq;
        f32x4 sv[2][2];
#pragma unroll
        for (int bj = 0; bj < 2; ++bj)
#pragma unroll
            for (int n = 0; n < 2; ++n) sv[bj][n] = *(const f32x4*)(pscale + c0 + bj * HALF + 4 * n);
#pragma unroll
        for (int ai = 0; ai < 2; ++ai)
#pragma unroll
            for (int m = 0; m < 4; ++m) { const size_t ro = (size_t)(row0 + ai * HALF + m * 16) * 1024 + c0;
#pragma unroll
                for (int bj = 0; bj < 2; ++bj) { const f32x4 v0 = acc[ai][bj][m][0] * sv[bj][0], v1 = acc[ai][bj][m][1] * sv[bj][1];
                    if (PO8) { u32x2 w; w.x = pk4_fp8(v0[0], v0[1], v0[2], v0[3]); w.y = pk4_fp8(v1[0], v1[1], v1[2], v1[3]); *(u32x2*)(PO8 + ro + bj * HALF) = w; }
                    else *(u32x4*)(PO + ro + bj * HALF) = pack8(v0, v1); } }
    }
};
template <bool SECOND> struct EpiBranch {
    static constexpr bool PERM = true;
    bf16* MG; const bf16* Gt;
    __device__ __forceinline__ void operator()(const Acc& acc, const Unit& u, int wr, int wc, int fr, int fq) const {
        const int row0 = u.pm * BM + wr * 64 + fr; const int c0 = u.pn * BM + wc * 32 + 8 * fq;
#pragma unroll
        for (int ai = 0; ai < 2; ++ai)
#pragma unroll
            for (int m = 0; m < 4; ++m) { const size_t row = (size_t)(row0 + ai * HALF + m * 16);
#pragma unroll
                for (int bj = 0; bj < 2; ++bj) {
                    const u32x4 gw = *(const u32x4*)(Gt + row * 4096 + (SECOND ? 2048 : 0) + c0 + bj * HALF);
                    f32x4 g0, g1; unpack8(gw, g0, g1);
                    f32x4 v0 = acc[ai][bj][m][0] * g0, v1 = acc[ai][bj][m][1] * g1;
                    bf16* p = MG + row * 2048 + c0 + bj * HALF;
                    if (SECOND) { const u32x4 ow = *(const u32x4*)p; f32x4 o0, o1; unpack8(ow, o0, o1); v0 += o0; v1 += o1; }
                    *(u32x4*)p = pack8(v0, v1); } }
    }
};
struct EpiBranchRT {
    static constexpr bool PERM = true;
    bf16* MG; const bf16* Gt; unsigned char* MG8; float mul;
    __device__ __forceinline__ void operator()(const Acc& acc, const Unit& u, int wr, int wc, int fr, int fq) const {
        const int row0 = u.pm * BM + wr * 64 + fr; const int c0 = u.pn * BM + wc * 32 + 8 * fq; const bool second = u.ti != 0;
#pragma unroll
        for (int ai = 0; ai < 2; ++ai)
#pragma unroll
            for (int m = 0; m < 4; ++m) { const size_t row = (size_t)(row0 + ai * HALF + m * 16);
#pragma unroll
                for (int bj = 0; bj < 2; ++bj) {
                    const u32x2 gw = *(const u32x2*)((const unsigned char*)Gt + row * 4096 + (second ? 2048 : 0) + c0 + bj * HALF);
                    const f32x4 g0 = unpk4_unorm8(gw.x), g1 = unpk4_unorm8(gw.y);
                    f32x4 v0 = acc[ai][bj][m][0] * mul * g0, v1 = acc[ai][bj][m][1] * mul * g1;
                    bf16* p = MG + row * 2048 + c0 + bj * HALF;
                    if (second) { const u32x4 ow = *(const u32x4*)p; f32x4 o0, o1; unpack8(ow, o0, o1); v0 += o0; v1 += o1; }
                    if (second && MG8) { u32x2 w; w.x = pk4_fp8(v0[0], v0[1], v0[2], v0[3]); w.y = pk4_fp8(v1[0], v1[1], v1[2], v1[3]); *(u32x2*)(MG8 + row * 2048 + c0 + bj * HALF) = w; }
                    else *(u32x4*)p = pack8(v0, v1); } }
    }
};
struct EpiMerge {
    static constexpr bool PERM = true;
    bf16* MG; const unsigned char* G8; unsigned char* MG8; float mul;
    __device__ __forceinline__ void mid(Acc& acc, const Unit& u, int wr, int wc, int fr, int fq) const {
        const unsigned o0 = (unsigned)(u.pm * BM + wr * 64 + fr) * 4096u + (unsigned)(u.pn * BM + wc * 32 + 8 * fq);
#pragma unroll
        for (int am = 0; am < 4; ++am) { const int ai = am >> 1, m0 = (am & 1) * 2;
            u32x2 ga[2][2], gb[2][2];
#pragma unroll
            for (int mm = 0; mm < 2; ++mm) { const unsigned char* gp = G8 + (o0 + (unsigned)((ai * HALF + (m0 + mm) * 16) * 4096));
                ga[mm][0] = *(const u32x2*)(gp); gb[mm][0] = *(const u32x2*)(gp + 2048); ga[mm][1] = *(const u32x2*)(gp + HALF); gb[mm][1] = *(const u32x2*)(gp + 2048 + HALF); }
            __builtin_amdgcn_sched_barrier(0);
#pragma unroll
            for (int mm = 0; mm < 2; ++mm) { const int m = m0 + mm;
#pragma unroll
                for (int bj = 0; bj < 2; ++bj) { const u32x2 a = ga[mm][bj], b = gb[mm][bj];
                    const f32x4 g00 = unpk4_u8(a.x), g01 = unpk4_u8(a.y); f32x4 g10 = unpk4_u8(b.x), g11 = unpk4_u8(b.y);
#pragma unroll
                    for (int j = 0; j < 4; ++j) { acc[ai][bj][m][0][j] *= g00[j] * __builtin_amdgcn_rcpf(fmaxf(g10[j], 1.0f)); acc[ai][bj][m][1][j] *= g01[j] * __builtin_amdgcn_rcpf(fmaxf(g11[j], 1.0f)); } } }
            __builtin_amdgcn_sched_barrier(0);
        }
    }
    __device__ __forceinline__ void operator()(const Acc& acc, const Unit& u, int wr, int wc, int fr, int fq) const {
        const int row0 = u.pm * BM + wr * 64 + fr; const int c0 = u.pn * BM + wc * 32 + 8 * fq;
#pragma unroll
        for (int ai = 0; ai < 2; ++ai)
#pragma unroll
            for (int m = 0; m < 4; ++m) { const size_t row = (size_t)(row0 + ai * HALF + m * 16);
#pragma unroll
                for (int bj = 0; bj < 2; ++bj) { const u32x2 b = *(const u32x2*)(G8 + row * 4096 + 2048 + c0 + bj * HALF);
                    f32x4 g10 = unpk4_unorm8(b.x), g11 = unpk4_unorm8(b.y);
#pragma unroll
                    for (int j = 0; j < 4; ++j) { g10[j] = fmaxf(g10[j], 1.0f / 255.0f) * mul; g11[j] = fmaxf(g11[j], 1.0f / 255.0f) * mul; }
                    const f32x4 v0 = acc[ai][bj][m][0] * g10, v1 = acc[ai][bj][m][1] * g11;
                    if (MG8) { u32x2 w; w.x = pk4_fp8(v0[0], v0[1], v0[2], v0[3]); w.y = pk4_fp8(v1[0], v1[1], v1[2], v1[3]); *(u32x2*)(MG8 + row * 2048 + c0 + bj * HALF) = w; }
                    else *(u32x4*)(MG + row * 2048 + c0 + bj * HALF) = pack8(v0, v1); } }
    }
};
struct EpiOut {
    static constexpr bool PERM = true;
    bf16* DL; const float* gate; float mul;
    __device__ __forceinline__ void operator()(const Acc& acc, const Unit& u, int wr, int wc, int fr, int fq) const {
        const int row0 = u.pm * BM + wr * 64 + fr, c0 = u.pn * BM + wc * 32 + 8 * fq;
        const float* gp = gate + (size_t)(u.pm >> 3) * MODW + c0;
        f32x4 gv[2][2];
#pragma unroll
        for (int bj = 0; bj < 2; ++bj)
#pragma unroll
            for (int n = 0; n < 2; ++n) gv[bj][n] = *(const f32x4*)(gp + bj * HALF + 4 * n) * mul;
#pragma unroll
        for (int ai = 0; ai < 2; ++ai)
#pragma unroll
            for (int m = 0; m < 4; ++m) { bf16* rowp = DL + (size_t)(row0 + ai * HALF + m * 16) * DM + c0;
#pragma unroll
                for (int bj = 0; bj < 2; ++bj) *(u32x4*)(rowp + bj * HALF) = pack8(acc[ai][bj][m][0] * gv[bj][0], acc[ai][bj][m][1] * gv[bj][1]); }
    }
};
struct EpiSwiglu {
    static constexpr bool PERM = true;
    bf16* ACT;
    __device__ __forceinline__ void operator()(const Acc& acc, const Unit& u, int wr, int wc, int fr, int fq) const {
        const int row0 = u.pm * BM + wr * 64 + fr; const int c0 = u.pn * 128 + wc * 32 + 8 * fq;
#pragma unroll
        for (int ai = 0; ai < 2; ++ai)
#pragma unroll
            for (int m = 0; m < 4; ++m) { f32x4 v[2];
#pragma unroll
                for (int n = 0; n < 2; ++n)
#pragma unroll
                    for (int j = 0; j < 4; ++j) { const float a = acc[ai][0][m][n][j]; v[n][j] = a * sigmoidf_(a) * acc[ai][1][m][n][j]; }
                *(u32x4*)(ACT + (size_t)(row0 + ai * HALF + m * 16) * 1024 + c0) = pack8(v[0], v[1]); }
    }
};
struct EpiSwiglu8 {
    static constexpr bool PERM = true;
    unsigned char* ACT8;
    __device__ __forceinline__ void operator()(const Acc& acc, const Unit& u, int wr, int wc, int fr, int fq) const {
        const int row0 = u.pm * BM + wr * 64 + fr; const int c0 = u.pn * 128 + wc * 32 + 8 * fq;
#pragma unroll
        for (int ai = 0; ai < 2; ++ai)
#pragma unroll
            for (int m = 0; m < 4; ++m) { f32x4 v[2];
#pragma unroll
                for (int n = 0; n < 2; ++n)
#pragma unroll
                    for (int j = 0; j < 4; ++j) { const float a = acc[ai][0][m][n][j] * W8_INV; v[n][j] = a * sigmoidf_(a) * (acc[ai][1][m][n][j] * W8_INV); }
                u32x2 w; w.x = pk4_fp8(v[0][0], v[0][1], v[0][2], v[0][3]); w.y = pk4_fp8(v[1][0], v[1][1], v[1][2], v[1][3]);
                *(u32x2*)(ACT8 + (size_t)(row0 + ai * HALF + m * 16) * 1024 + c0) = w; }
    }
};
struct EpiDown {
    static constexpr bool PERM = true;
    bf16* YB; float mul;
    __device__ __forceinline__ void operator()(const Acc& acc, const Unit& u, int wr, int wc, int fr, int fq) const {
        const int row0 = u.pm * BM + wr * 64 + fr; const int c0 = u.pn * BM + wc * 32 + 8 * fq;
#pragma unroll
        for (int ai = 0; ai < 2; ++ai)
#pragma unroll
            for (int m = 0; m < 4; ++m) { bf16* rowp = YB + (size_t)(row0 + ai * HALF + m * 16) * 2048 + c0;
#pragma unroll
                for (int bj = 0; bj < 2; ++bj) { const f32x4 v0 = acc[ai][bj][m][0] * mul, v1 = acc[ai][bj][m][1] * mul;
                    if (YB_FP8) { u32x2 w; w.x = pk4_fp8(v0[0], v0[1], v0[2], v0[3]); w.y = pk4_fp8(v1[0], v1[1], v1[2], v1[3]); *(u32x2*)((unsigned char*)YB + (size_t)(row0 + ai * HALF + m * 16) * 2048 + c0 + bj * HALF) = w; }
                    else *(u32x4*)(rowp + bj * HALF) = pack8(v0, v1); } }
    }
};
}

struct Args { const float* in[20]; float* out; unsigned char* ws; int ph_lo, ph_hi; };
enum { I_X = 0, I_C, I_WADA, I_BADA, I_NMIX, I_NMOE, I_WIN, I_BF, I_WPOOL, I_PSCALE, I_WBR, I_WGATE, I_BGATE, I_WOUT, I_WROUTER, I_BROUTER, I_WEG, I_WEU, I_WED, I_NFINAL };

__device__ __forceinline__ const __attribute__((address_space(4))) char* kernarg_opaque() {
    const __attribute__((address_space(4))) char* kp = (const __attribute__((address_space(4))) char*)__builtin_amdgcn_kernarg_segment_ptr();
    asm volatile("" : "+s"(kp));
    return kp;
}
__device__ __forceinline__ const float* arg_in(int k) { return *(const float* const __attribute__((address_space(4)))*)(kernarg_opaque() + 8 * k); }
__device__ __forceinline__ int arg_i32(int byte_off) { return *(const int __attribute__((address_space(4)))*)(kernarg_opaque() + byte_off); }
#define ARG_IN(k) arg_in(k)
extern __shared__ __attribute__((aligned(16))) unsigned char lds_raw[];
struct Frame {
    LAS unsigned char* lds;
    int tid, lane, wave, vcu, G;
    float* out;
    unsigned char* ws;
};
__device__ __forceinline__ void frame_refresh(Frame& F) {
    F.lds = (LAS unsigned char*)lds_raw;
    F.tid = opaque_tid(); F.lane = F.tid & 63; F.wave = __builtin_amdgcn_readfirstlane(F.tid >> 6);
    F.G = gridDim.x; { const int bx = blockIdx.x; F.vcu = (F.G % 8 == 0) ? (bx % 8) * (F.G / 8) + bx / 8 : bx; }
    F.out = (float*)arg_in(20); F.ws = (unsigned char*)arg_in(21);
}

struct CvtItem { const float* src; bf16* dst; int srcStride, dstK, k0, n0, rowBase, mode, fp8; };
constexpr int CVT_PER_LAYER = 256 + 256 + 8 + 128 + 128 + 1024 + 1024 + 1024;
__device__ __forceinline__ CvtItem cvt_item(const Frame& F, int it) {
    const int l = it / CVT_PER_LAYER; int r = it % CVT_PER_LAYER;
    unsigned char* wl = F.ws + WS_W + (size_t)l * W_LAYER;
    CvtItem c; c.mode = 0; c.rowBase = 0; c.fp8 = 0;
    if (r < 256) { c.src = ARG_IN(I_WIN) + (size_t)l * DM * INW; c.srcStride = INW; c.dst = (bf16*)(wl + WO_PG); c.dstK = DM; c.k0 = 128 * (r >> 4); c.n0 = 256 * (r & 15); c.fp8 = (G1_FP8 == 2); return c; } r -= 256;
    if (r < 256) { c.src = ARG_IN(I_WGATE) + (size_t)l * DM * 4096; c.srcStride = 4096; c.dst = (bf16*)(wl + WO_PG + (G1_FP8 == 1 ? 16 * MiB : 0)); c.dstK = DM; c.k0 = 128 * (r >> 4); c.n0 = 256 * (r & 15); c.rowBase = (G1_FP8 == 1 ? 0 : 4096); c.fp8 = (G1_FP8 >= 1); return c; } r -= 256;
    if (r < 8) { const int g = r >> 1; c.src = ARG_IN(I_WPOOL) + ((size_t)l * 4 + g) * 65536; c.srcStride = 256; c.dst = (bf16*)(wl + WO_POOL) + (size_t)g * 65536; c.dstK = 256; c.k0 = 128 * (r & 1); c.n0 = 0; return c; } r -= 8;
    if (r < 128) { const int n = r >> 6, q = r & 63; c.src = ARG_IN(I_WBR) + ((size_t)l * 2 + n) * 1024 * 2048; c.srcStride = 2048; c.dst = G2_FP8 ? (bf16*)(wl + WO_BR + (size_t)n * 2048 * 1024) : (bf16*)(wl + WO_BR) + (size_t)n * 2048 * 1024; c.dstK = 1024; c.fp8 = G2_FP8; c.k0 = 128 * (q >> 3); c.n0 = 256 * (q & 7); return c; } r -= 128;
    if (r < 128) { c.src = ARG_IN(I_WOUT) + (size_t)l * DM * DM; c.srcStride = DM; c.dst = (bf16*)(wl + WO_OUT); c.dstK = DM; c.k0 = 128 * (r >> 3); c.n0 = 256 * (r & 7); c.fp8 = G3_FP8; return c; } r -= 128;
    if (r < 2048) { const int up = r >= 1024; if (up) r -= 1024; const int e = r >> 6, q = r & 63;
        c.src = (up ? ARG_IN(I_WEU) : ARG_IN(I_WEG)) + ((size_t)l * NE + e) * DM * DE; c.srcStride = DE; c.dst = MOE_FP8 ? (bf16*)(wl + WO_GU + (size_t)e * 2048 * 2048) : (bf16*)(wl + WO_GU) + (size_t)e * 2048 * 2048; c.dstK = DM; c.fp8 = MOE_FP8; c.k0 = 128 * (q >> 2); c.n0 = 256 * (q & 3); c.mode = up ? 2 : 1; return c; } r -= 2048;
    { const int e = r >> 6, q = r & 63; c.src = ARG_IN(I_WED) + ((size_t)l * NE + e) * DE * DM; c.srcStride = DM; c.dst = MOE_FP8 ? (bf16*)(wl + WO_D + (size_t)e * 2048 * 1024) : (bf16*)(wl + WO_D) + (size_t)e * 2048 * 1024; c.dstK = DE; c.fp8 = MOE_FP8; c.k0 = 128 * (q >> 3); c.n0 = 256 * (q & 7); return c; }
}
__device__ __forceinline__ void cvt_load(const CvtItem& c, int wave, int lane, f32x4 (&v)[16]) {
    const float* p = c.src + (size_t)(c.k0 + wave * 16) * c.srcStride + c.n0 + 4 * lane;
#pragma unroll
    for (int j = 0; j < 16; ++j) v[j] = __builtin_nontemporal_load((const f32x4*)(p + (size_t)j * c.srcStride));
}
__device__ __forceinline__ void p0_mod_task(Frame& F, int q, const LAS float* cact) {
    const int ks = q & 3, cgq = q >> 2, l = cgq / 192, col0 = (cgq % 192) * 64, kq = F.lane >> 4, cl = (F.lane & 15) * 4;
    const int kbase = ks * 512;
    const float* wp = ARG_IN(I_WADA) + ((size_t)l * DM + kbase + kq) * MODW + col0 + cl;
    f32x4 acc[8];
#pragma unroll
    for (int b = 0; b < 8; ++b) acc[b] = (f32x4){0.f, 0.f, 0.f, 0.f};
    for (int i0 = 0; i0 < 128; i0 += 8) {
        f32x4 w[8];
#pragma unroll
        for (int j = 0; j < 8; ++j) w[j] = __builtin_nontemporal_load((const f32x4*)(wp + (size_t)(4 * (i0 + j)) * MODW));
#pragma unroll
        for (int j = 0; j < 8; ++j) { const int k = kbase + 4 * (i0 + j) + kq; const f32x4 c0 = *(const LAS f32x4*)(cact + k * 8), c1 = *(const LAS f32x4*)(cact + k * 8 + 4);
#pragma unroll
            for (int b = 0; b < 4; ++b) { acc[b] += c0[b] * w[j]; acc[4 + b] += c1[b] * w[j]; } }
    }
#pragma unroll
    for (int b = 0; b < 8; ++b)
#pragma unroll
        for (int j = 0; j < 4; ++j) { float v = acc[b][j]; v += __shfl_xor(v, 16); v += __shfl_xor(v, 32); acc[b][j] = v; }
    if (kq == 0) {
        f32x4 bv = (f32x4){0.f, 0.f, 0.f, 0.f};
        if (ks == 0) bv = *(const f32x4*)(ARG_IN(I_BADA) + (size_t)l * MODW + col0 + cl);
        float* mp = (float*)(F.ws + WS_MODP) + ((size_t)ks * 2 + l) * 8 * MODW + col0 + cl;
#pragma unroll
        for (int b = 0; b < 8; ++b) *(f32x4*)(mp + (size_t)b * MODW) = acc[b] + bv;
    }
}
__device__ __forceinline__ f32x4 modp_sum(const float* modp, size_t idx) {
    constexpr size_t Q = (size_t)2 * 8 * MODW;
    const f32x4 a = *(const f32x4*)(modp + idx), b = *(const f32x4*)(modp + Q + idx), c = *(const f32x4*)(modp + 2 * Q + idx), d = *(const f32x4*)(modp + 3 * Q + idx);
    return ((a + b) + c) + d;
}
__device__ __forceinline__ void cvt_to_lds(const CvtItem& c, const f32x4 (&v)[16], LAS unsigned char* tile, int wave, int lane) {
    if (c.fp8) {
#pragma unroll
        for (int i = 0; i < 4; ++i) { u32x4 w;
            w.x = pk4_fp8(v[0][i] * W8_SCALE, v[1][i] * W8_SCALE, v[2][i] * W8_SCALE, v[3][i] * W8_SCALE); w.y = pk4_fp8(v[4][i] * W8_SCALE, v[5][i] * W8_SCALE, v[6][i] * W8_SCALE, v[7][i] * W8_SCALE);
            w.z = pk4_fp8(v[8][i] * W8_SCALE, v[9][i] * W8_SCALE, v[10][i] * W8_SCALE, v[11][i] * W8_SCALE); w.w = pk4_fp8(v[12][i] * W8_SCALE, v[13][i] * W8_SCALE, v[14][i] * W8_SCALE, v[15][i] * W8_SCALE);
            *(LAS u32x4*)(tile + (4 * lane + i) * 144 + wave * 16) = w; }
    } else {
#pragma unroll
        for (int i = 0; i < 4; ++i)
#pragma unroll
            for (int o = 0; o < 2; ++o) { u32x4 w; w.x = cvt_pk_bf16(v[8 * o + 0][i], v[8 * o + 1][i]); w.y = cvt_pk_bf16(v[8 * o + 2][i], v[8 * o + 3][i]); w.z = cvt_pk_bf16(v[8 * o + 4][i], v[8 * o + 5][i]); w.w = cvt_pk_bf16(v[8 * o + 6][i], v[8 * o + 7][i]);
                *(LAS u32x4*)(tile + (4 * lane + i) * 272 + (wave * 16 + 8 * o) * 2) = w; }
    }
}
__device__ __forceinline__ void cvt_store(const CvtItem& cc, const LAS unsigned char* tile, int tid) {
    if (cc.fp8) {
#pragma unroll
        for (int qq = 0; qq < 4; ++qq) { const int ch = tid + 512 * qq, nn = ch >> 3, c16 = ch & 7; const int n = cc.n0 + nn;
            const int drow = cc.mode == 0 ? cc.rowBase + n : 256 * (n >> 7) + (n & 127) + (cc.mode == 2 ? 128 : 0);
            const u32x4 w = *(const LAS u32x4*)(tile + nn * 144 + c16 * 16);
            *(u32x4*)((unsigned char*)cc.dst + (size_t)drow * cc.dstK + cc.k0 + c16 * 16) = w; }
    } else {
#pragma unroll
        for (int qq = 0; qq < 8; ++qq) { const int ch = tid + 512 * qq, nn = ch >> 4, c16 = ch & 15; const int n = cc.n0 + nn;
            const int drow = cc.mode == 0 ? cc.rowBase + n : 256 * (n >> 7) + (n & 127) + (cc.mode == 2 ? 128 : 0);
            const u32x4 w = *(const LAS u32x4*)(tile + nn * 272 + c16 * 16);
            *(u32x4*)(cc.dst + (size_t)drow * cc.dstK + cc.k0 + c16 * 8) = w; }
    }
}
#ifndef Q_A
#define Q_A 1152
#endif
#ifndef Q_1
#define Q_1 768
#endif
constexpr int Q_B = 1024, Q_COUNT = Q_A + Q_B, Q_FIRST = 2 * CVT_PER_LAYER - Q_COUNT, CW_QUEUE = 12800;
__device__ __forceinline__ void cvt_queue_drain(Frame& F, int which, int first, int count) {
    LAS unsigned char* tile = F.lds;
    volatile LAS int* slot = (volatile LAS int*)(F.lds + X_MISC) + 60;
    unsigned* q = (unsigned*)(F.ws + WS_CTL) + CW_QUEUE + 64 * which;
    __syncthreads();
    int t_next = 0;
    if (F.tid == 0) { const int ta = (int)__hip_atomic_fetch_add(q, 1u, __ATOMIC_RELAXED, __HIP_MEMORY_SCOPE_AGENT); t_next = (int)__hip_atomic_fetch_add(q, 1u, __ATOMIC_RELAXED, __HIP_MEMORY_SCOPE_AGENT); slot[0] = ta < count ? ta : -1; }
    __syncthreads();
    int qi = __builtin_amdgcn_readfirstlane(slot[0]);
    f32x4 v[16];
    CvtItem c = cvt_item(F, first + (qi >= 0 ? qi : 0));
    if (qi >= 0) cvt_load(c, F.wave, F.lane, v);
    while (qi >= 0) {
        if (F.tid == 0) { slot[0] = t_next < count ? t_next : -1; t_next = (int)__hip_atomic_fetch_add(q, 1u, __ATOMIC_RELAXED, __HIP_MEMORY_SCOPE_AGENT); }
        cvt_to_lds(c, v, tile, F.wave, F.lane);
        __syncthreads();
        const CvtItem cc = c;
        const int nq = __builtin_amdgcn_readfirstlane(slot[0]);
        if (nq >= 0) { c = cvt_item(F, first + nq); cvt_load(c, F.wave, F.lane, v); }
        cvt_store(cc, tile, F.tid);
        __syncthreads();
        qi = nq;
    }
}
__device__ __forceinline__ void p0_prologue(Frame& F) {
    LAS float* cact = (LAS float*)(F.lds);
    LAS unsigned char* tile = F.lds + 65536;
    {   const float* cin = ARG_IN(I_C);
#pragma unroll
        for (int h = 0; h < 2; ++h) { float cv[16];
#pragma unroll
            for (int k = 0; k < 16; ++k) cv[k] = cin[F.tid + (h * 16 + k) * NTHREADS];
            __builtin_amdgcn_sched_barrier(0);
#pragma unroll
            for (int k = 0; k < 16; ++k) { const int i = F.tid + (h * 16 + k) * NTHREADS, b = i / DM, kk = i % DM; cact[kk * 8 + b] = cv[k] * sigmoidf_(cv[k]); }
            __builtin_amdgcn_sched_barrier(0); } }
    __syncthreads();
    { const int q = F.wave * F.G + F.vcu; if (q < 1536) p0_mod_task(F, q, cact); }
    constexpr int NITEMS = Q_FIRST;
    int it = F.vcu;
    f32x4 v[16];
    CvtItem c = cvt_item(F, it < NITEMS ? it : 0);
    if (it < NITEMS) cvt_load(c, F.wave, F.lane, v);
    while (it < NITEMS) {
        cvt_to_lds(c, v, tile, F.wave, F.lane);
        __syncthreads();
        const CvtItem cc = c;
        const int nit = it + F.G;
        if (nit < NITEMS) { c = cvt_item(F, nit); cvt_load(c, F.wave, F.lane, v); }
        cvt_store(cc, tile, F.tid);
        __syncthreads();
        it = nit;
    }
}

__device__ __forceinline__ void load_expert_tables(Frame& F, int lc) {
    volatile LAS int* misc = (volatile LAS int*)(F.lds + X_MISC);
    if (F.tid < 16) {
        const int c = (int)__hip_atomic_load((unsigned*)(F.ws + WS_CTL) + CW_CNT + (lc * 16 + F.tid) * 64, RLX_AGENT);
        misc[32 + F.tid] = c;
        const int v = (c + 255) >> 8; int incl = v;
#pragma unroll
        for (int o = 1; o < 16; o <<= 1) { const int nb = __shfl_up(incl, o); if (F.tid >= o) incl += nb; }
        misc[8 + F.tid] = incl - v;
        if (F.tid == 15) misc[24] = incl;
    }
    __syncthreads();
}
template <int MODE, bool COMBINE, bool DRY = false>
__device__ __forceinline__ void rows_phase(Frame& F, int l, bool prefilled = false) {
    const int lane = F.lane;
    float* out = F.out;
    const bool xf32 = (MODE == 0 && !COMBINE) || (MODE == 1 && l == 0);
    const float* xin = ARG_IN(I_X); bf16* XB = (bf16*)(F.ws + WS_XB);
    const float* mod = (const float*)(F.ws + WS_MOD);
    bf16* H = (bf16*)(F.ws + WS_H);
    const int lprev = (MODE == 2) ? DEPTH - 1 : l - 1;
    if (COMBINE && !MK_ONE_LAUNCH) load_expert_tables(F, lprev);
    volatile LAS int* misc = (volatile LAS int*)(F.lds + X_MISC);
    if (MODE == 0 && !prefilled) {
        LAS f32x4* wf = (LAS f32x4*)F.lds; const float* src = ARG_IN(I_WIN) + (size_t)l * DM * INW + 4096;
#pragma unroll 8
        for (int i = F.tid; i < DM * 2; i += NTHREADS) { const int c = i >> 1, g = i & 1; wf[((g * 4 + (c & 3)) * 8 + (c >> 8)) * 64 + ((c >> 2) & 63)] = *(const f32x4*)(src + (size_t)c * INW + g * 4); }
    }
    if (MODE == 1 && !prefilled) {
        LAS f32x4* wr = (LAS f32x4*)F.lds; const f32x4* src = (const f32x4*)ARG_IN(I_WROUTER);
        f32x4 tv[16];
#pragma unroll
        for (int k = 0; k < 16; ++k) tv[k] = src[F.tid + k * NTHREADS];
        __builtin_amdgcn_sched_barrier(0);
#pragma unroll
        for (int k = 0; k < 16; ++k) { const int i = F.tid + k * NTHREADS, c = i >> 2, g = i & 3; wr[((g * 4 + (c & 3)) * 8 + (c >> 8)) * 64 + ((c >> 2) & 63)] = tv[k]; }
    }
    __syncthreads();
    const int ntask = T / 8;
    constexpr bool FIRST = (MODE == 0 && !COMBINE);
    const float* modp = (const float*)(F.ws + WS_MODP);
    if (FIRST) {
        for (int wt = F.vcu * NWAVES + F.wave; wt < 2048; wt += F.G * NWAVES)
            if (lane < 24) { const size_t idx = (size_t)wt * 96 + 4 * lane; *(f32x4*)((float*)(F.ws + WS_MOD) + idx) = modp_sum(modp, idx); }
    }
    for (int wt = F.vcu * NWAVES + F.wave; wt < ntask; wt += F.G * NWAVES) {
        const int row0 = wt * 8, b = row0 / SEQ;
        f32x4 A[8], Sh[8], Gm[8];
        {
            const float* nrm = (MODE == 0) ? ARG_IN(I_NMIX) + (size_t)l * DM : (MODE == 1) ? ARG_IN(I_NMOE) + (size_t)l * DM : ARG_IN(I_NFINAL);
            const float* mb = mod + ((size_t)(MODE == 2 ? 0 : l) * 8 + b) * MODW;
#pragma unroll
            for (int j = 0; j < 8; ++j) { const int c = 256 * j + 4 * lane; const f32x4 g = *(const f32x4*)(nrm + c);
                if (MODE == 2) { A[j] = g; Sh[j] = (f32x4){0.f, 0.f, 0.f, 0.f}; }
                else if (FIRST) { const size_t mi = (size_t)b * MODW + c; const f32x4 sc = modp_sum(modp, mi + DM); Sh[j] = modp_sum(modp, mi); A[j] = g * (1.0f + sc); }
                else { const f32x4 sc = *(const f32x4*)(mb + (MODE == 0 ? 1 : 4) * DM + c); Sh[j] = *(const f32x4*)(mb + (MODE == 0 ? 0 : 3) * DM + c); A[j] = g * (1.0f + sc); }
                if (COMBINE) Gm[j] = *(const f32x4*)(mod + ((size_t)lprev * 8 + b) * MODW + 5 * DM + c); }
        }
        int te_l = 0, tp_l = 0; float tw_l = 0.f;
        if (COMBINE) { if (lane < 16) { te_l = ((const int*)(F.ws + WS_TOKE))[row0 * 2 + lane]; tw_l = ((const float*)(F.ws + WS_TOKW))[row0 * 2 + lane]; tp_l = ((const int*)(F.ws + WS_TOKP))[row0 * 2 + lane]; } }
        for (int r = 0; r < 8; ++r) {
            const int row = row0 + r;
            f32x4 x[8];
#pragma unroll
            for (int j = 0; j < 8; ++j) {
                if (xf32) x[j] = __builtin_nontemporal_load((const f32x4*)(xin + (size_t)row * DM + 256 * j + 4 * lane));
                else { const u32x2 p = __builtin_nontemporal_load((const u32x2*)(XB + (size_t)row * DM + 256 * j + 4 * lane)); x[j] = (f32x4){bf_lo(p.x), bf_hi(p.x), bf_lo(p.y), bf_hi(p.y)}; } }
            if (COMBINE) {
                const int e0 = __builtin_amdgcn_readlane(te_l, 2 * r), e1 = __builtin_amdgcn_readlane(te_l, 2 * r + 1);
                const float w0 = __int_as_float(__builtin_amdgcn_readlane(__float_as_int(tw_l), 2 * r)), w1 = __int_as_float(__builtin_amdgcn_readlane(__float_as_int(tw_l), 2 * r + 1));
                const size_t s0 = (size_t)misc[8 + e0] * 256 + __builtin_amdgcn_readlane(tp_l, 2 * r), s1 = (size_t)misc[8 + e1] * 256 + __builtin_amdgcn_readlane(tp_l, 2 * r + 1);
                const bf16* y0p = (const bf16*)(F.ws + WS_YB) + s0 * 2048; const bf16* y1p = (const bf16*)(F.ws + WS_YB) + s1 * 2048;
                unsigned yq0[8], yq1[8];
                if (YB_FP8) {
#pragma unroll
                    for (int j = 0; j < 8; ++j) { yq0[j] = __builtin_nontemporal_load((const unsigned*)((const unsigned char*)(F.ws + WS_YB) + s0 * 2048 + 256 * j + 4 * lane)); yq1[j] = __builtin_nontemporal_load((const unsigned*)((const unsigned char*)(F.ws + WS_YB) + s1 * 2048 + 256 * j + 4 * lane)); }
                    __builtin_amdgcn_sched_barrier(0);
                }
#pragma unroll
                for (int j = 0; j < 8; ++j) { f32x4 y0, y1;
                    if (YB_FP8) { y0 = unpk4_fp8(yq0[j]); y1 = unpk4_fp8(yq1[j]); }
                    else { const u32x2 p0 = *(const u32x2*)(y0p + 256 * j + 4 * lane), p1 = *(const u32x2*)(y1p + 256 * j + 4 * lane);
                        y0 = (f32x4){bf_lo(p0.x), bf_hi(p0.x), bf_lo(p0.y), bf_hi(p0.y)}; y1 = (f32x4){bf_lo(p1.x), bf_hi(p1.x), bf_lo(p1.y), bf_hi(p1.y)}; }
                    x[j] += Gm[j] * (w0 * y0 + w1 * y1); }
                if (MODE != 2) {
#pragma unroll
                    for (int j = 0; j < 8; ++j) { u32x2 w; w.x = cvt_pk_bf16(x[j].x, x[j].y); w.y = cvt_pk_bf16(x[j].z, x[j].w); *(u32x2*)(XB + (size_t)row * DM + 256 * j + 4 * lane) = w; }
                }
            }
            if (MODE == 1) {
                const bf16* dl = (const bf16*)(F.ws + WS_DL) + (size_t)row * DM;
#pragma unroll
                for (int j = 0; j < 8; ++j) { const u32x2 p = __builtin_nontemporal_load((const u32x2*)(dl + 256 * j + 4 * lane)); x[j] += (f32x4){bf_lo(p.x), bf_hi(p.x), bf_lo(p.y), bf_hi(p.y)}; }
#pragma unroll
                for (int j = 0; j < 8; ++j) { u32x2 w; w.x = cvt_pk_bf16(x[j].x, x[j].y); w.y = cvt_pk_bf16(x[j].z, x[j].w); *(u32x2*)(XB + (size_t)row * DM + 256 * j + 4 * lane) = w; }
            }
            float ss = 0.f;
#pragma unroll
            for (int j = 0; j < 8; ++j) ss += (x[j].x * x[j].x + x[j].y * x[j].y) + (x[j].z * x[j].z + x[j].w * x[j].w);
            const float rstd = 1.0f / sqrtf(wave_sum_u(ss) * (1.0f / DM) + EPS);
#pragma unroll
            for (int j = 0; j < 8; ++j) x[j] = x[j] * rstd * A[j] + Sh[j];
            if (MODE == 2) {
#pragma unroll
                for (int j = 0; j < 8; ++j) __builtin_nontemporal_store(x[j], (f32x4*)(out + (size_t)row * DM + 256 * j + 4 * lane));
                continue;
            }
#pragma unroll
            for (int j = 0; j < 8; ++j) {
                constexpr bool W8 = (MODE == 1 && MOE_FP8) || (MODE == 0 && G1_FP8 >= 1), W16 = (MODE == 1 && !MOE_FP8) || (MODE == 0 && G1_FP8 != 2);
                if (W8) *(unsigned*)(F.ws + WS_H8 + (size_t)row * DM + 256 * j + 4 * lane) = pk4_fp8(x[j].x, x[j].y, x[j].z, x[j].w);
                if (W16) { u32x2 w; w.x = cvt_pk_bf16(x[j].x, x[j].y); w.y = cvt_pk_bf16(x[j].z, x[j].w); *(u32x2*)(H + (size_t)row * DM + 256 * j + 4 * lane) = w; } }
            if (MODE == 0) {
                const LAS float* wf = (const LAS float*)F.lds;
                float fl[8];
#pragma unroll
                for (int q = 0; q < 8; ++q) fl[q] = 0.f;
#pragma unroll
                for (int j = 0; j < 8; ++j)
#pragma unroll
                    for (int i = 0; i < 4; ++i) { const f32x4 w0 = *((const LAS f32x4*)wf + ((0 * 4 + i) * 8 + j) * 64 + lane), w1 = *((const LAS f32x4*)wf + ((1 * 4 + i) * 8 + j) * 64 + lane); const float xv = x[j][i];
#pragma unroll
                        for (int q = 0; q < 4; ++q) { fl[q] += xv * w0[q]; fl[4 + q] += xv * w1[q]; }
                        if (i == 3) asm volatile("" ::: "memory"); }
#pragma unroll
                for (int q = 0; q < 8; ++q) fl[q] = wave_sum_u(fl[q]);
                if (lane < 8) { float z = 0.f;
#pragma unroll
                    for (int q = 0; q < 8; ++q) z = (lane == q) ? fl[q] : z;
                    z += ARG_IN(I_BF)[l * 8 + lane];
                    const float ls = fminf(z, 0.f) - log1pf(expf(-fabsf(z)));
                    ((float*)(F.ws + WS_LS))[(size_t)row * 8 + lane] = ls; }
            }
            if (MODE == 1) {
                const LAS float* wr = (const LAS float*)F.lds;
                float lg[16];
#pragma unroll
                for (int q = 0; q < 16; ++q) lg[q] = 0.f;
#pragma unroll
                for (int j = 0; j < 8; ++j)
#pragma unroll
                    for (int i = 0; i < 4; ++i) { const float xv = x[j][i];
#pragma unroll
                        for (int q4 = 0; q4 < 4; ++q4) { const f32x4 w = *((const LAS f32x4*)wr + ((q4 * 4 + i) * 8 + j) * 64 + lane);
#pragma unroll
                            for (int q = 0; q < 4; ++q) lg[4 * q4 + q] += xv * w[q]; }
                        if (i == 3) asm volatile("" ::: "memory"); }
#pragma unroll
                for (int q = 0; q < 16; ++q) lg[q] = wave_sum_u(lg[q]);
                float mx = lg[0];
#pragma unroll
                for (int q = 1; q < 16; ++q) mx = fmaxf(mx, lg[q]);
                float pr[16], se = 0.f;
#pragma unroll
                for (int q = 0; q < 16; ++q) { pr[q] = expf(lg[q] - mx); se += pr[q]; }
                const float inv = 1.0f / se;
                float sel[16];
#pragma unroll
                for (int q = 0; q < 16; ++q) { pr[q] *= inv; sel[q] = pr[q] + ARG_IN(I_BROUTER)[q]; }
                float bestS = -3.0e38f; int be0 = 0, be1 = 1;
#pragma unroll
                for (int g = 0; g < 4; ++g) {
                    float v1 = sel[4 * g]; int i1 = 0;
#pragma unroll
                    for (int i = 1; i < 4; ++i) if (sel[4 * g + i] > v1) { v1 = sel[4 * g + i]; i1 = i; }
                    float v2 = -3.0e38f; int i2 = 0;
#pragma unroll
                    for (int i = 0; i < 4; ++i) if (i != i1 && sel[4 * g + i] > v2) { v2 = sel[4 * g + i]; i2 = i; }
                    const float sc = v1 + v2;
                    if (sc > bestS) { bestS = sc; be0 = 4 * g + i1; be1 = 4 * g + i2; }
                }
                float p0 = 0.f, p1 = 0.f;
#pragma unroll
                for (int q = 0; q < 16; ++q) { p0 = (q == be0) ? pr[q] : p0; p1 = (q == be1) ? pr[q] : p1; }
                const float gs = 1.0f / (p0 + p1);
                if (lane == 0) {
                    int* te = (int*)(F.ws + WS_TOKE) + row * 2; float* tw = (float*)(F.ws + WS_TOKW) + row * 2;
                    te[0] = be0; te[1] = be1; tw[0] = p0 * gs; tw[1] = p1 * gs;
                    volatile LAS int* asg = (volatile LAS int*)(F.lds + X_ASG);
                    asg[(F.wave * 8 + r) * 2] = be0; asg[(F.wave * 8 + r) * 2 + 1] = be1;
                }
            }
        }
        if (MODE == 1) {
            __syncthreads();
            if (!DRY) {
                volatile LAS int* asg = (volatile LAS int*)(F.lds + X_ASG);
                const int a0 = asg[lane], a1 = asg[64 + lane];
                const int eA = F.wave * 2, eB = eA + 1;
                const unsigned long long mA0 = __ballot(a0 == eA), mA1 = __ballot(a1 == eA), mB0 = __ballot(a0 == eB), mB1 = __ballot(a1 == eB);
                const int nA0 = __popcll(mA0), nA = nA0 + __popcll(mA1), nB0 = __popcll(mB0), nB = nB0 + __popcll(mB1);
                unsigned base_l = 0u;
                if (lane < 2) { const int nn = lane ? nB : nA; if (nn) base_l = __hip_atomic_fetch_add((unsigned*)(F.ws + WS_CTL) + CW_CNT + (l * 16 + eA + lane) * 64, (unsigned)nn, RLX_AGENT); }
                const unsigned baseA = (unsigned)__builtin_amdgcn_readlane((int)base_l, 0), baseB = (unsigned)__builtin_amdgcn_readlane((int)base_l, 1);
                const unsigned long long lt = (1ull << lane) - 1ull;
                const int blk_row0 = (wt - F.wave) * 8;
                int* list = (int*)(F.ws + WS_LIST); int* tp = (int*)(F.ws + WS_TOKP);
                if (a0 == eA || a0 == eB) { const bool isA = a0 == eA; const unsigned slot = isA ? baseA + (unsigned)__popcll(mA0 & lt) : baseB + (unsigned)__popcll(mB0 & lt);
                    const int row = blk_row0 + (lane >> 1); list[(isA ? eA : eB) * LIST_CAP + slot] = row; tp[row * 2 + (lane & 1)] = (int)slot; }
                if (a1 == eA || a1 == eB) { const bool isA = a1 == eA; const unsigned slot = isA ? baseA + (unsigned)nA0 + (unsigned)__popcll(mA1 & lt) : baseB + (unsigned)nB0 + (unsigned)__popcll(mB1 & lt);
                    const int row = blk_row0 + 32 + (lane >> 1); list[(isA ? eA : eB) * LIST_CAP + slot] = row; tp[row * 2 + (lane & 1)] = (int)slot; }
            }
            __syncthreads();
        }
    }
}

template <int W>
__device__ __forceinline__ void pool_tile_w(Frame& F, int pm, int g, int half) {
    const bf16* U = (const bf16*)(F.ws + WS_U); bf16* PL = (bf16*)(F.ws + WS_PL);
    const int cc = F.tid & 31, rg = F.tid >> 5;
    const int col = g * 256 + cc * 8 + half * 4;
    const int r0 = pm * 256 + rg * 16, t0 = r0 % SEQ;
    u32x2 cur[16], prv[W - 1];
#pragma unroll
    for (int r = 0; r < 16; ++r) cur[r] = *(const u32x2*)(U + (size_t)(r0 + r) * 1024 + col);
#pragma unroll
    for (int j = 1; j < W; ++j) { const bool ok = t0 - j >= 0; const u32x2 v = *(const u32x2*)(U + (size_t)(ok ? r0 - j : r0) * 1024 + col); prv[j - 1] = ok ? v : (u32x2){0u, 0u}; }
    __builtin_amdgcn_sched_barrier(0);
    f32x4 s = {0.f, 0.f, 0.f, 0.f};
#pragma unroll
    for (int j = 1; j < W; ++j) s += (f32x4){bf_lo(prv[j - 1].x), bf_hi(prv[j - 1].x), bf_lo(prv[j - 1].y), bf_hi(prv[j - 1].y)};
#pragma unroll
    for (int r = 0; r < 16; ++r) {
        const int t = t0 + r; const f32x4 a = {bf_lo(cur[r].x), bf_hi(cur[r].x), bf_lo(cur[r].y), bf_hi(cur[r].y)};
        s += a;
        const float inv = 1.0f / (float)(t + 1 < W ? t + 1 : W);
        const f32x4 o = s * inv - a;
        u32x2 w; w.x = cvt_pk_bf16(o[0], o[1]); w.y = cvt_pk_bf16(o[2], o[3]);
        *(u32x2*)(PL + (size_t)(r0 + r) * 1024 + col) = w;
        {
            const u32x2 q = r - W + 1 >= 0 ? cur[r - W + 1 >= 0 ? r - W + 1 : 0] : prv[r - W + 1 >= 0 ? 0 : W - 2 - r];
            s -= (f32x4){bf_lo(q.x), bf_hi(q.x), bf_lo(q.y), bf_hi(q.y)}; }
    }
}
__device__ __forceinline__ void pool_tile(Frame& F, int pm, int g) {
    if (g == 0) { pool_tile_w<2>(F, pm, g, 0); pool_tile_w<2>(F, pm, g, 1); }
    else if (g == 1) { pool_tile_w<4>(F, pm, g, 0); pool_tile_w<4>(F, pm, g, 1); }
    else if (g == 2) { pool_tile_w<8>(F, pm, g, 0); pool_tile_w<8>(F, pm, g, 1); }
    else { pool_tile_w<16>(F, pm, g, 0); pool_tile_w<16>(F, pm, g, 1); }
}

__device__ __forceinline__ void forget_cumsum(Frame& F, int b, int h, LAS float* Fl, LAS float* tmp, const float L2E, const LAS float* staged = nullptr) {
    const float* LS = (const float*)(F.ws + WS_LS) + (size_t)b * SEQ * 8 + h;
    const int t4 = F.tid * 4;
    float v0, v1, v2, v3;
    if (staged) { const f32x4 q = *(const LAS f32x4*)(staged + t4); v0 = q.x; v1 = q.y; v2 = q.z; v3 = q.w; }
    else { v0 = LS[(size_t)(t4 + 0) * 8]; v1 = LS[(size_t)(t4 + 1) * 8]; v2 = LS[(size_t)(t4 + 2) * 8]; v3 = LS[(size_t)(t4 + 3) * 8]; }
    v1 += v0; v2 += v1; v3 += v2;
    float tot = v3;
#pragma unroll
    for (int o = 1; o < 64; o <<= 1) { const float n = __shfl_up(tot, o); if (F.lane >= o) tot += n; }
    if (F.lane == 63) tmp[F.wave] = tot;
    __syncthreads();
    float off = 0.f;
    for (int w = 0; w < F.wave; ++w) off += tmp[w];
    const float base = off + tot - v3;
    *(LAS f32x4*)(Fl + t4) = (f32x4){(base + v0) * L2E, (base + v1) * L2E, (base + v2) * L2E, (base + v3) * L2E};
    __syncthreads();
}

#if ATTN_FAST
namespace att {
constexpr int D = 128, LD = 1024, NW = 8, QBLK = 32, KVBLK = 64, QB = NW * QBLK;
constexpr int SHM_V = KVBLK * D * 2, SHM_K = KVBLK * D * 2;
constexpr int OFF_WS = 2 * SHM_V + 2 * SHM_K;
constexpr int OFF_FN = OFF_WS + NW * 64 * 4;
constexpr int OFF_TMP = OFF_FN + 2048 * 4;
constexpr float SCALE = 0.08838834764831845f, C2 = 1.4426950408889634f * SCALE, THR = 8.f;
typedef short s16x4 __attribute__((ext_vector_type(4)));
typedef float f32x16 __attribute__((ext_vector_type(16)));
#define KSWZ(row, colB) ((row) * 256 + ((colB) ^ (((row) & 7) << 4)))
#define SBAR() __builtin_amdgcn_sched_barrier(0)
__device__ __forceinline__ int v_st(int k, int c) { const int kk = (k & ~0xC) | ((k & 4) << 1) | ((k & 8) >> 1); return ((kk >> 3) * 4 + (c >> 5)) * 512 + ((kk & 7) * 32 + (c & 31)) * 2; }
__device__ __forceinline__ int v_rd_base(int lane) { return ((lane & 3) << 3) | (((lane >> 2) & 3) << 6) | (((lane >> 4) & 1) << 5) | (((lane >> 5) & 1) << 8); }
constexpr int v_rd_off(int d0, int ks, int half) { return d0 * 512 + ks * 4096 + half * 2048; }
__device__ __forceinline__ int crow(int r, int hi) { return (r & 3) + 8 * (r >> 2) + 4 * hi; }
__device__ __forceinline__ unsigned cvtpk(float lo, float hi) { return cvt_pk_bf16(lo, hi); }
__device__ __forceinline__ bf16x8 load8(const bf16* p) { return *reinterpret_cast<const bf16x8*>(p); }
__device__ __forceinline__ void mask_tile(f32x16& p0, f32x16& p1, int dq) {
    const float NEG = -__builtin_inff();
#pragma unroll
    for (int r = 0; r < 16; ++r) { const int c = (r & 3) + 8 * (r >> 2); if (dq - c < 0) p0[r] = NEG; if (dq - c - 32 < 0) p1[r] = NEG; }
}
__device__ __forceinline__ void partialSM(f32x16& p0, f32x16& p1, float& m_reg, float& mn, float& alpha) {
    float pmax = p0[0]; for (int r = 1; r < 16; ++r) pmax = fmaxf(pmax, p0[r]); for (int r = 0; r < 16; ++r) pmax = fmaxf(pmax, p1[r]);
    { auto rr = __builtin_amdgcn_permlane32_swap(__float_as_uint(pmax), __float_as_uint(pmax), false, false);
      pmax = fmaxf(__uint_as_float(rr[0]), __uint_as_float(rr[1])); }
    if (__builtin_expect(__all((pmax - m_reg) * SCALE <= THR), 1)) { mn = m_reg; alpha = 1.f; }
    else { mn = fmaxf(m_reg, pmax); alpha = __builtin_amdgcn_exp2f((m_reg - mn) * C2); m_reg = mn; }
    const float mnL = -mn * C2;
    for (int r = 0; r < 16; ++r) p0[r] = fmaf(p0[r], C2, mnL); for (int r = 0; r < 16; ++r) p1[r] = fmaf(p1[r], C2, mnL);
    for (int r = 0; r < 16; ++r) p0[r] = __builtin_amdgcn_exp2f(p0[r]);
}
__device__ __forceinline__ void finishSM(f32x16& p0, f32x16& p1, float alpha, float& l_reg, bf16x8& pa0, bf16x8& pa1, bf16x8& pa2, bf16x8& pa3) {
    for (int r = 0; r < 16; ++r) p1[r] = __builtin_amdgcn_exp2f(p1[r]);
    float ps = 0; for (int r = 0; r < 16; ++r) ps += p0[r]; for (int r = 0; r < 16; ++r) ps += p1[r];
    { auto rr = __builtin_amdgcn_permlane32_swap(__float_as_uint(ps), __float_as_uint(ps), false, false);
      ps = __uint_as_float(rr[0]) + __uint_as_float(rr[1]); }
    l_reg = l_reg * alpha + ps;
#define PK4(P, B_, OUT) do { unsigned a0 = cvtpk(P[B_+0], P[B_+1]), a1 = cvtpk(P[B_+2], P[B_+3]);                          \
        unsigned b0 = cvtpk(P[B_+4], P[B_+5]), b1 = cvtpk(P[B_+6], P[B_+7]);                                             \
        auto r0 = __builtin_amdgcn_permlane32_swap(a0, b0, false, false); auto r1 = __builtin_amdgcn_permlane32_swap(a1, b1, false, false); \
        u32x4 w = {r0[0], r1[0], r0[1], r1[1]}; OUT = *reinterpret_cast<bf16x8*>(&w); } while (0)
    PK4(p0, 0, pa0); PK4(p0, 8, pa1); PK4(p1, 0, pa2); PK4(p1, 8, pa3);
#undef PK4
}
template <int KB>
__device__ __forceinline__ void qkt(f32x16& p0, f32x16& p1, const char* K_lds, int r32, int hi, const bf16x8* qr, const LAS float* nbt) {
#pragma unroll
    for (int g = 0; g < 4; ++g) { const f32x4 b0 = *(const LAS f32x4*)(nbt + 8 * g), b1 = *(const LAS f32x4*)(nbt + 32 + 8 * g);
#pragma unroll
        for (int i = 0; i < 4; ++i) { p0[4 * g + i] = b0[i]; p1[4 * g + i] = b1[i]; } }
    const char* kb[4];
#pragma unroll
    for (int dd = 0; dd < 4; ++dd) kb[dd] = K_lds + KB * SHM_K + KSWZ(r32, (dd * 16 + hi * 8) * 2);
#pragma unroll
    for (int d0 = 0; d0 < 8; ++d0) { const char* a = kb[d0 & 3] + (d0 >> 2) * 128;
        bf16x8 b0 = *reinterpret_cast<const bf16x8*>(a);
        bf16x8 b1 = *reinterpret_cast<const bf16x8*>(a + 32 * 256);
        p0 = __builtin_amdgcn_mfma_f32_32x32x16_bf16(b0, qr[d0], p0, 0, 0, 0);
        p1 = __builtin_amdgcn_mfma_f32_32x32x16_bf16(b1, qr[d0], p1, 0, 0, 0); }
}
template <int VB>
__device__ __forceinline__ void pv_tile(f32x16* o, int vb0, bf16x8 pa0, bf16x8 pa1, bf16x8 pa2, bf16x8 pa3) {
#define TRRD(dst, off) asm volatile("ds_read_b64_tr_b16 %0, %1 offset:%2" : "=&v"(dst) : "v"(vb0), "i"(off) : "memory")
#define PV_D0(d0) do { s16x4 l0, l1, l2, l3, h0, h1, h2, h3; constexpr int b_ = VB * SHM_V + v_rd_off(d0, 0, 0); \
        TRRD(l0, b_); TRRD(h0, b_ + 2048); TRRD(l1, b_ + 4096); TRRD(h1, b_ + 6144); TRRD(l2, b_ + 8192); TRRD(h2, b_ + 10240); TRRD(l3, b_ + 12288); TRRD(h3, b_ + 14336); \
        asm volatile("s_waitcnt lgkmcnt(0)" ::: "memory"); SBAR();   \
        o[d0] = __builtin_amdgcn_mfma_f32_32x32x16_bf16(pa0, (bf16x8){l0[0], l0[1], l0[2], l0[3], h0[0], h0[1], h0[2], h0[3]}, o[d0], 0, 0, 0);   \
        o[d0] = __builtin_amdgcn_mfma_f32_32x32x16_bf16(pa1, (bf16x8){l1[0], l1[1], l1[2], l1[3], h1[0], h1[1], h1[2], h1[3]}, o[d0], 0, 0, 0);   \
        o[d0] = __builtin_amdgcn_mfma_f32_32x32x16_bf16(pa2, (bf16x8){l2[0], l2[1], l2[2], l2[3], h2[0], h2[1], h2[2], h2[3]}, o[d0], 0, 0, 0);   \
        o[d0] = __builtin_amdgcn_mfma_f32_32x32x16_bf16(pa3, (bf16x8){l3[0], l3[1], l3[2], l3[3], h3[0], h3[1], h3[2], h3[3]}, o[d0], 0, 0, 0); } while (0)
    PV_D0(0); PV_D0(1); PV_D0(2); PV_D0(3);
#undef PV_D0
#undef TRRD
}
struct BlockRef { const bf16* Q; const bf16* K; const bf16* V; bf16* O; int P0; unsigned char* O8; };
struct Seam { bf16x8 qr[8]; bf16x8 st_v0, st_v1, st_k0, st_k1; };
#define ROW(p, k0, rr) ((p) + (size_t)((k0) + (rr)) * LD + sc)
#define VMW() asm volatile("s_waitcnt vmcnt(0)" ::: "memory")
#define VMWN(n) asm volatile("s_waitcnt vmcnt(%0)" :: "i"(n) : "memory")
#define SLOAD_H(Kp, Vp, k0) do { S.st_v0 = load8(ROW(Vp, k0, sr)); S.st_v1 = load8(ROW(Vp, k0, 32 + sr)); S.st_k0 = load8(ROW(Kp, k0, sr)); S.st_k1 = load8(ROW(Kp, k0, 32 + sr)); } while (0)
#define SWRITE_HK(bf) do { *(bf16x8*)(K_lds + (bf) * SHM_K + kws) = S.st_k0; *(bf16x8*)(K_lds + (bf) * SHM_K + kws + 32 * 256) = S.st_k1; } while (0)
#define SWRITE_HV(bf) do { *(bf16x8*)(V_lds + (bf) * SHM_V + vst0) = S.st_v0; *(bf16x8*)(V_lds + (bf) * SHM_V + vst1) = S.st_v1; } while (0)
#define SWRITE_H(bf) do { SWRITE_HV(bf); SWRITE_HK(bf); } while (0)
__device__ __forceinline__ void prime(const BlockRef& cur, char* lds, Seam& S, int tid) {
    const int wid = __builtin_amdgcn_readfirstlane(tid >> 6), lane = tid & 63, r32 = lane & 31, hi = lane >> 5;
    const int sr = tid >> 4, sc = (tid & 15) * 8, kws = KSWZ(sr, sc * 2); char* K_lds = lds + 2 * SHM_V;
    for (int d0 = 0; d0 < 8; ++d0) S.qr[d0] = load8(cur.Q + (size_t)(wid * QBLK + r32) * LD + d0 * 16 + hi * 8);
    SLOAD_H(cur.K, cur.V, 0); VMW(); SWRITE_HK(0);
    __syncthreads();
}
__device__ __forceinline__ void block(const BlockRef& cur, const BlockRef& nxt, char* lds, Seam& S, int tid) {
    const int wid = __builtin_amdgcn_readfirstlane(tid >> 6), lane = tid & 63, r32 = lane & 31, hi = lane >> 5;
    const int NT = (cur.P0 + QB - 1) / KVBLK + 1;
    const int qlo = cur.P0 + wid * QBLK, qm = qlo + r32 - 4 * hi;
    char* V_lds = lds; char* K_lds = lds + 2 * SHM_V;
    float* ws = (float*)(lds + OFF_WS) + wid * 64; float* li_l = ws, * al_l = ws + 32;
    const LAS float* nbl = (const LAS float*)((LAS unsigned char*)lds_raw + OFF_FN) + 4 * hi;
    float m_reg = -1e30f, l_reg = 0; f32x16 o[4] = {};
    const int sr = tid >> 4, sc = (tid & 15) * 8, vst0 = v_st(sr, sc), vst1 = v_st(32 + sr, sc), kws = KSWZ(sr, sc * 2);
    const int vb0 = (int)(uintptr_t)V_lds + v_rd_base(lane);
    const bf16* Kh = cur.K; const bf16* Vh = cur.V;
#define RESC(a) do { if (__any((a) < 1.f)) { if (hi == 0) al_l[r32] = (a); asm volatile("s_waitcnt lgkmcnt(0)" ::: "memory");              \
                     for (int d_ = 0; d_ < 4; ++d_) for (int r = 0; r < 16; ++r) o[d_][r] *= al_l[crow(r, hi)]; } } while (0)
#define KBASE(t) ((t) * KVBLK)
#define MASKT(P0_, P1_, t) do { const int kb_ = KBASE(t); if (kb_ + KVBLK - 1 > qlo) mask_tile(P0_, P1_, qm - kb_); } while (0)
    constexpr int NQL = 8;
#define SEAM_K0() do { VMWN(NQL); SWRITE_HK(0); SBAR(); } while (0)
    f32x16 pA0, pA1, pB0, pB1; float mnA, mnB, alA, alB; bf16x8 pa0, pa1, pa2, pa3;
    SWRITE_HV(0); SBAR();
    if (NT > 1) { SLOAD_H(Kh, Vh, KBASE(1)); }
    SBAR(); qkt<0>(pA0, pA1, K_lds, r32, hi, S.qr, nbl);
    MASKT(pA0, pA1, 0); partialSM(pA0, pA1, m_reg, mnA, alA);
    if (NT > 1) { VMW(); SWRITE_H(1); }
    __syncthreads();
#define HALF_STEP(PX0, PX1, mnX, alX, PY0, PY1, alY, t, KB, VB, SB) do {                                                      \
        SBAR(); qkt<KB>(PX0, PX1, K_lds, r32, hi, S.qr, nbl + KBASE(t));                                             \
        finishSM(PY0, PY1, alY, l_reg, pa0, pa1, pa2, pa3); SBAR();                                                           \
        if ((t) + 1 < NT) { SLOAD_H(Kh, Vh, KBASE((t) + 1)); SBAR(); }                                               \
        pv_tile<VB>(o, vb0, pa0, pa1, pa2, pa3); MASKT(PX0, PX1, (t)); partialSM(PX0, PX1, m_reg, mnX, alX);                                        \
        __syncthreads();                                                                                                      \
        if ((t) + 1 < NT) { VMW(); SWRITE_H(SB); }                                                                          \
        RESC(alX); __syncthreads(); } while (0)
    for (int t = 1; t + 1 < NT; t += 2) {
        HALF_STEP(pB0, pB1, mnB, alB, pA0, pA1, alA, t, 1, 0, 0);
        HALF_STEP(pA0, pA1, mnA, alA, pB0, pB1, alB, t + 1, 0, 1, 1);
    }
    const bool even = (NT & 1) == 0;
    if (even) { SBAR(); qkt<1>(pB0, pB1, K_lds, r32, hi, S.qr, nbl + KBASE(NT - 1)); SBAR(); }
    SLOAD_H(nxt.K, nxt.V, 0); SBAR();
#pragma unroll
    for (int d0 = 0; d0 < 8; ++d0) S.qr[d0] = load8(nxt.Q + (size_t)(wid * QBLK + r32) * LD + d0 * 16 + hi * 8);
    SBAR();
    finishSM(pA0, pA1, alA, l_reg, pa0, pa1, pa2, pa3); SBAR();
    pv_tile<0>(o, vb0, pa0, pa1, pa2, pa3);
    if (even) { MASKT(pB0, pB1, NT - 1); partialSM(pB0, pB1, m_reg, mnB, alB); __syncthreads(); RESC(alB);
        finishSM(pB0, pB1, alB, l_reg, pa0, pa1, pa2, pa3); SBAR(); pv_tile<1>(o, vb0, pa0, pa1, pa2, pa3); }
    SBAR(); SEAM_K0();
    if (hi == 0) li_l[r32] = l_reg; asm volatile("s_waitcnt lgkmcnt(0)" ::: "memory");
    float rli[16];
#pragma unroll
    for (int r = 0; r < 16; ++r) rli[r] = __builtin_amdgcn_rcpf(li_l[crow(r, hi)]);
    bf16* Ow = cur.O + (size_t)(wid * QBLK) * LD;
#pragma unroll
    for (int r = 0; r < 16; ++r) { const int orow = crow(r, hi);
#pragma unroll
        for (int d0 = 0; d0 < 4; ++d0) { const float v = o[d0][r] * rli[r]; const float vn = __shfl_xor(v, 1);
            if ((r32 & 1) == 0) *(unsigned*)(Ow + (size_t)orow * LD + d0 * 32 + r32) = cvtpk(v, vn); } }
    __syncthreads();
#undef RESC
#undef KBASE
#undef MASKT
#undef SEAM_K0
#undef HALF_STEP
}
__device__ __forceinline__ void block_lean(const BlockRef& cur, char* lds, int tid) {
    const int wid = __builtin_amdgcn_readfirstlane(tid >> 6), lane = tid & 63, r32 = lane & 31, hi = lane >> 5;
    const int NT = (cur.P0 + QB - 1) / KVBLK + 1;
    const int qlo = cur.P0 + wid * QBLK, qm = qlo + r32 - 4 * hi;
    char* V_lds = lds; char* K_lds = lds + 2 * SHM_V;
    float* ws = (float*)(lds + OFF_WS) + wid * 64; float* li_l = ws, * al_l = ws + 32;
    const LAS float* nbl = (const LAS float*)((LAS unsigned char*)lds_raw + OFF_FN) + 4 * hi;
    const int sr = tid >> 4, sc = (tid & 15) * 8, vst0 = v_st(sr, sc), vst1 = v_st(32 + sr, sc), kws = KSWZ(sr, sc * 2);
    const int vb0 = (int)(uintptr_t)V_lds + v_rd_base(lane);
    const bf16* Kh = cur.K; const bf16* Vh = cur.V;
    Seam S;
#pragma unroll
    for (int d0 = 0; d0 < 8; ++d0) S.qr[d0] = load8(cur.Q + (size_t)(wid * QBLK + r32) * LD + d0 * 16 + hi * 8);
    SLOAD_H(Kh, Vh, 0); VMW(); SWRITE_H(0);
    if (NT > 1) { SLOAD_H(Kh, Vh, KVBLK); VMW(); SWRITE_H(1); }
    if (NT > 2) SLOAD_H(Kh, Vh, 2 * KVBLK);
    __syncthreads();
    float m_reg = -1e30f, l_reg = 0; f32x16 o[4] = {};
    f32x16 p0, p1; float mn, al; bf16x8 pa0, pa1, pa2, pa3;
#define RESC(a) do { if (__any((a) < 1.f)) { if (hi == 0) al_l[r32] = (a); asm volatile("s_waitcnt lgkmcnt(0)" ::: "memory");              \
                     for (int d_ = 0; d_ < 4; ++d_) for (int r = 0; r < 16; ++r) o[d_][r] *= al_l[crow(r, hi)]; } } while (0)
#define LSTEP(t, B) do { const int kb_ = (t) * KVBLK;                                                                      \
        SBAR(); qkt<B>(p0, p1, K_lds, r32, hi, S.qr, nbl + kb_);                                                            \
        if (kb_ + KVBLK - 1 > qlo) mask_tile(p0, p1, qm - kb_);                                                             \
        partialSM(p0, p1, m_reg, mn, al); RESC(al);                                                                         \
        finishSM(p0, p1, al, l_reg, pa0, pa1, pa2, pa3); SBAR();                                                            \
        pv_tile<B>(o, vb0, pa0, pa1, pa2, pa3);                                                                             \
        __syncthreads();                                                                                                    \
        if ((t) + 2 < NT) { VMW(); SWRITE_H(B); if ((t) + 3 < NT) SLOAD_H(Kh, Vh, ((t) + 3) * KVBLK); } } while (0)
    for (int t = 0; t < NT; t += 2) { LSTEP(t, 0); if (t + 1 < NT) LSTEP(t + 1, 1); }
    if (hi == 0) li_l[r32] = l_reg; asm volatile("s_waitcnt lgkmcnt(0)" ::: "memory");
    float rli[16];
#pragma unroll
    for (int r = 0; r < 16; ++r) rli[r] = __builtin_amdgcn_rcpf(li_l[crow(r, hi)]);
    bf16* Ow = cur.O + (size_t)(wid * QBLK) * LD;
#pragma unroll
    for (int r = 0; r < 16; ++r) { const int orow = crow(r, hi);
#pragma unroll
        for (int d0 = 0; d0 < 4; ++d0) { const float v = o[d0][r] * rli[r]; const float vn = __shfl_xor(v, 1);
            if (cur.O8) { const float v2 = __shfl_xor(v, 2), v3 = __shfl_xor(vn, 2);
                if ((r32 & 3) == 0) *(unsigned*)(cur.O8 + (size_t)(wid * QBLK + orow) * LD + d0 * 32 + r32) = pk4_fp8(v, vn, v2, v3); }
            else if ((r32 & 1) == 0) *(unsigned*)(Ow + (size_t)orow * LD + d0 * 32 + r32) = cvtpk(v, vn); } }
    __syncthreads();
#undef RESC
#undef LSTEP
}
#undef ROW
#undef VMW
#undef VMWN
#undef SLOAD_H
#undef SWRITE_HK
#undef SWRITE_HV
#undef SWRITE_H
#undef KSWZ
#undef SBAR
}

constexpr int X_FSTAGE = 90112;
__device__ __forceinline__ void attn_fast(Frame& F, bool pre = false) {
    const bf16* Q = (const bf16*)(F.ws + WS_Q); const bf16* Kp = (const bf16*)(F.ws + WS_K); const bf16* V = (const bf16*)(F.ws + WS_V); bf16* AO = (bf16*)(F.ws + WS_AO);
    char* lds = (char*)lds_raw;
    {   const int item = F.vcu;
        const int bh = item >> 2, b = bh >> 3, h = bh & 7, x = item & 3;
        __syncthreads();
        {
            LAS float* Fl = (LAS float*)(F.lds + att::OFF_FN); LAS float* tmp = (LAS float*)(F.lds + att::OFF_TMP);
            forget_cumsum(F, b, h, Fl, tmp, -1.0f / att::SCALE, pre ? (const LAS float*)(F.lds + X_FSTAGE) : (const LAS float*)nullptr);
        }
        const size_t seq0 = (size_t)b * SEQ * 1024 + h * 128;
        att::BlockRef r0, r1;
        unsigned char* AO8 = G2_FP8 ? (unsigned char*)(F.ws + WS_AO) : (unsigned char*)nullptr;
        r0.Q = Q + seq0 + (size_t)(x * 256) * 1024; r0.O = AO + seq0 + (size_t)(x * 256) * 1024; r0.K = Kp + seq0; r0.V = V + seq0; r0.P0 = x * 256; r0.O8 = AO8 ? AO8 + seq0 + (size_t)(x * 256) * 1024 : AO8;
        r1.Q = Q + seq0 + (size_t)((7 - x) * 256) * 1024; r1.O = AO + seq0 + (size_t)((7 - x) * 256) * 1024; r1.K = Kp + seq0; r1.V = V + seq0; r1.P0 = (7 - x) * 256; r1.O8 = AO8 ? AO8 + seq0 + (size_t)((7 - x) * 256) * 1024 : AO8;
#if ATTN_FAST == 2
        att::Seam S;
        att::prime(r0, lds, S, F.tid);
        att::block(r0, r1, lds, S, F.tid);
        att::block(r1, r1, lds, S, F.tid);
#else
        att::block_lean(r0, lds, F.tid);
        att::block_lean(r1, lds, F.tid);
#endif
    }
    __syncthreads();
}
#endif

#if !ATTN_FAST
__device__ __forceinline__ void attn_simple(Frame& F) {
    const bf16* Q = (const bf16*)(F.ws + WS_Q); const bf16* Kp = (const bf16*)(F.ws + WS_K); const bf16* V = (const bf16*)(F.ws + WS_V); bf16* AO = (bf16*)(F.ws + WS_AO);
    LAS float* Fl = (LAS float*)F.lds;
    LAS float* tmp = (LAS float*)(F.lds + 8192);
    LAS float* sc = (LAS float*)(F.lds + 16384 + F.wave * 8192);
    LAS float* qf = (LAS float*)(F.lds + 16384 + 65536 + F.wave * 512);
    const float L2E = 1.4426950408889634f, scale = 0.08838834764831845f;
    {   const int item = F.vcu;
        const int bh = item >> 2, b = bh >> 3, h = bh & 7, q0 = (item & 3) * 512;
        __syncthreads();
        forget_cumsum(F, b, h, Fl, tmp, 1.4426950408889634f);
        for (int t = q0 + F.wave; t < q0 + 512; t += NWAVES) {
            const size_t row = (size_t)b * SEQ + t;
            { const unsigned qw = *(const unsigned*)(Q + row * 1024 + h * 128 + 2 * F.lane); qf[2 * F.lane] = bf_lo(qw); qf[2 * F.lane + 1] = bf_hi(qw); }
            LDS_WAIT();
            float mx = -3.0e38f;
            for (int j = F.lane; j <= t; j += 64) {
                const bf16* kr = Kp + ((size_t)b * SEQ + j) * 1024 + h * 128; float d = 0.f;
#pragma unroll 2
                for (int c = 0; c < 16; ++c) { const u32x4 kw = *(const u32x4*)(kr + 8 * c); f32x4 k0, k1; pg8::unpack8(kw, k0, k1); const f32x4 q0v = *(const LAS f32x4*)(qf + 8 * c), q1v = *(const LAS f32x4*)(qf + 8 * c + 4);
                    d += (k0[0] * q0v[0] + k0[1] * q0v[1]) + (k0[2] * q0v[2] + k0[3] * q0v[3]) + (k1[0] * q1v[0] + k1[1] * q1v[1]) + (k1[2] * q1v[2] + k1[3] * q1v[3]); }
                const float s = d * scale * L2E + (Fl[t] - Fl[j]);
                sc[j] = s; mx = fmaxf(mx, s);
            }
            mx = wave_max(mx);
            float sum = 0.f;
            for (int j = F.lane; j <= t; j += 64) { const float p = __builtin_amdgcn_exp2f(sc[j] - mx); sc[j] = p; sum += p; }
            sum = wave_sum(sum);
            LDS_WAIT();
            float o0 = 0.f, o1 = 0.f;
            const bf16* vb = V + (size_t)b * SEQ * 1024 + h * 128 + 2 * F.lane;
            for (int j = 0; j <= t; ++j) { const unsigned vw = *(const unsigned*)(vb + (size_t)j * 1024); const float p = sc[j]; o0 += p * bf_lo(vw); o1 += p * bf_hi(vw); }
            const float inv = 1.0f / sum;
            *(unsigned*)(AO + row * 1024 + h * 128 + 2 * F.lane) = cvt_pk_bf16(o0 * inv, o1 * inv);
        }
    }
    __syncthreads();
}
#endif

__device__ __forceinline__ unsigned char* layer_w(const Frame& F, int l) { return F.ws + WS_W + (size_t)l * W_LAYER; }
__device__ __forceinline__ void ph_p0() { Frame F; frame_refresh(F); p0_prologue(F); }
__device__ __forceinline__ void ph_r1(int l, bool pre = false) { Frame F; frame_refresh(F); if (l == 0) rows_phase<0, false>(F, l, pre); else rows_phase<0, true>(F, l, pre); }
__device__ __forceinline__ void ph_r2(int l, bool pre = false) { Frame F; frame_refresh(F); rows_phase<1, false>(F, l, pre); }
__device__ __forceinline__ void ph_r2_dry(int l) { Frame F; frame_refresh(F); rows_phase<1, false, true>(F, l); }
__device__ __forceinline__ void ph_final() { Frame F; frame_refresh(F); rows_phase<2, true>(F, 0);
}
__device__ __forceinline__ void ph_g1(int l) {
    Frame F; frame_refresh(F);
    const LAS int* tt = (const LAS int*)(F.lds + X_TOK);
#if G1_FP8 == 2
    pg8::Gemm g{(const bf16*)(F.ws + WS_H8), (const bf16*)(layer_w(F, l) + WO_PG)};
    typedef pg8::StaticOrder<T, 8192, DM / 2, DM / 2> Order; Order S; S.init(F.G, (int)blockIdx.x);
    pg8::EpiProj E{(bf16*)(F.ws + WS_U), (bf16*)(F.ws + WS_G), ARG_IN(I_BGATE) + (size_t)l * 4096, W8_INV, 0};
    pg8::gemm_phase<pg8::EpiProj, Order, false, DM / 2, DM / 2, DM / 2, true>(F.lds, g, S, E, tt);
#elif G1_FP8 == 1
    {   pg8::Gemm g{(const bf16*)(F.ws + WS_H), (const bf16*)(layer_w(F, l) + WO_PG)};
        typedef pg8::StaticOrder<T, 4096, DM, DM> Order; Order S; S.init(F.G, (int)blockIdx.x);
        pg8::EpiProj E{(bf16*)(F.ws + WS_U), (bf16*)(F.ws + WS_G), ARG_IN(I_BGATE) + (size_t)l * 4096, 1.0f, 0};
        pg8::gemm_phase<pg8::EpiProj, Order, false, DM, DM, DM>(F.lds, g, S, E, tt); }
    {   pg8::Gemm g{(const bf16*)(F.ws + WS_H8), (const bf16*)(layer_w(F, l) + WO_PG + 16 * MiB)};
        typedef pg8::StaticOrder<T, 4096, DM / 2, DM / 2> Order; Order S; S.init(F.G, (int)blockIdx.x);
        pg8::EpiProj E{(bf16*)(F.ws + WS_U), (bf16*)(F.ws + WS_G), ARG_IN(I_BGATE) + (size_t)l * 4096, W8_INV, 16};
        pg8::gemm_phase<pg8::EpiProj, Order, false, DM / 2, DM / 2, DM / 2, true>(F.lds, g, S, E, tt); }
#else
    pg8::Gemm g{(const bf16*)(F.ws + WS_H), (const bf16*)(layer_w(F, l) + WO_PG)};
    typedef pg8::StaticOrder<T, 8192, DM, DM> Order; Order S; S.init(F.G, (int)blockIdx.x);
    pg8::EpiProj E{(bf16*)(F.ws + WS_U), (bf16*)(F.ws + WS_G), ARG_IN(I_BGATE) + (size_t)l * 4096, 1.0f, 0};
    pg8::gemm_phase<pg8::EpiProj, Order, false, DM, DM, DM>(F.lds, g, S, E, tt);
#endif
}
__device__ __forceinline__ void ph_at(int l, bool pre = false) {
    Frame F; frame_refresh(F);
#if !ATTN_FAST
    attn_simple(F);
#else
    attn_fast(F, pre);
#endif
    {
        frame_refresh(F);
        const int pu = F.vcu, pm = pu >> 2, g = pu & 3;
        pool_tile(F, pm, g);
        VM_WAIT(); __syncthreads();
    }
    {
        frame_refresh(F);
        const int pu = F.vcu, pm = pu >> 2, g = pu & 3;
        pg8::Gemm gg{(const bf16*)(F.ws + WS_PL), (const bf16*)(layer_w(F, l) + WO_POOL)};
        pg8::OneUnit S; S.u0.pm = pm; S.u0.pn = 0; S.u0.ti = 0; S.u0.aoff = (unsigned)pm * (256u * 1024u * 2u) + (unsigned)g * 512u; S.u0.boff = (unsigned)g * (256u * 256u * 2u); S.u0.aoff2 = 0u; S.u0.boff2 = 0u;
        pg8::EpiPool E{(bf16*)(F.ws + WS_PO), ARG_IN(I_PSCALE) + (size_t)l * 1024, g, G2_FP8 ? (unsigned char*)(F.ws + WS_PO) : (unsigned char*)nullptr};
        pg8::gemm_phase<pg8::EpiPool, pg8::OneUnit, false, 1024, 256, 256>(F.lds, gg, S, E, (const LAS int*)(F.lds + X_TOK));
        __syncthreads();
    }
}
__device__ __forceinline__ void ph_g2(int l) {
    Frame F; frame_refresh(F);
    unsigned char* mg8 = G3_FP8 ? (unsigned char*)(F.ws + WS_MG8) : (unsigned char*)nullptr;
    pg8::Gemm g{(const bf16*)(F.ws + WS_PO), (const bf16*)(layer_w(F, l) + WO_BR)};
#if G2_FP8
    typedef pg8::SplitOrder<pg8::StaticOrder<T, DM, 512, 512>> Order;
    Order S; S.S0.init(F.G, (int)blockIdx.x); S.a2 = (unsigned)(WS_AO - WS_PO); S.b2 = 2048u * 1024u;
    pg8::EpiMerge E{(bf16*)(F.ws + WS_MG), (const unsigned char*)(F.ws + WS_G), mg8, W8_INV};
    pg8::gemm_phase<pg8::EpiMerge, Order, false, 512, 512, 1024, true, 8>(F.lds, g, S, E, (const LAS int*)(F.lds + X_TOK));
#else
    typedef pg8::SplitOrder<pg8::StaticOrder<T, DM, 1024, 1024>> Order;
    Order S; S.S0.init(F.G, (int)blockIdx.x); S.a2 = (unsigned)(WS_AO - WS_PO); S.b2 = 2048u * 1024u * 2u;
    pg8::EpiMerge E{(bf16*)(F.ws + WS_MG), (const unsigned char*)(F.ws + WS_G), mg8, 1.0f};
    pg8::gemm_phase<pg8::EpiMerge, Order, false, 1024, 1024, 2048, false, 16>(F.lds, g, S, E, (const LAS int*)(F.lds + X_TOK));
#endif
}
__device__ __forceinline__ void ph_g3(int l) {
    Frame F; frame_refresh(F);
    const float* gate = (const float*)(F.ws + WS_MOD) + (size_t)l * 8 * MODW + 2 * DM;
#if G3_FP8
    pg8::Gemm g{(const bf16*)(F.ws + WS_MG8), (const bf16*)(layer_w(F, l) + WO_OUT)};
    typedef pg8::StaticOrder<T, DM, DM / 2, DM / 2> Order; Order S; S.init(F.G, (int)blockIdx.x);
    pg8::EpiOut E{(bf16*)(F.ws + WS_DL), gate, W8_INV};
    pg8::gemm_phase<pg8::EpiOut, Order, false, DM / 2, DM / 2, DM / 2, true>(F.lds, g, S, E, (const LAS int*)(F.lds + X_TOK));
#else
    pg8::Gemm g{(const bf16*)(F.ws + WS_MG), (const bf16*)(layer_w(F, l) + WO_OUT)};
    typedef pg8::StaticOrder<T, DM, DM, DM> Order; Order S; S.init(F.G, (int)blockIdx.x);
    pg8::EpiOut E{(bf16*)(F.ws + WS_DL), gate, 1.0f};
    pg8::gemm_phase<pg8::EpiOut, Order, false, DM, DM, DM>(F.lds, g, S, E, (const LAS int*)(F.lds + X_TOK));
#endif
}
__device__ __forceinline__ void ph_m1(int l) {
    Frame F; frame_refresh(F);
    load_expert_tables(F, l);
    const LAS int* misc = (const LAS int*)(F.lds + X_MISC);
    pg8::MoeOrder S; S.G = F.G; S.c = (int)blockIdx.x; S.NT = misc[24]; S.tpre = misc + 8; S.a_tile_bytes = 0u; S.b_exp_bytes = 2048u * 2048u * (MOE_FP8 ? 1u : 2u); S.b_tile_bytes = 256u * 2048u * (MOE_FP8 ? 1u : 2u);
    {
        LAS int* tt = (LAS int*)(F.lds + X_TOK); const int* list = (const int*)(F.ws + WS_LIST);
        pg8::Unit u;
        int tv[8];
#pragma unroll
        for (int i = 0; i < 8; ++i) { tv[i] = -1;
            if (S.next(i, u)) {
                int e = 0;
                for (int j = 1; j < 16; ++j) e += (u.pm >= misc[8 + j]) ? 1 : 0;
                const int mt = u.pm - misc[8 + e], n = misc[32 + e];
                if (F.tid < 256) { int idx = mt * 256 + F.tid; idx = idx < n ? idx : n - 1; tv[i] = list[e * LIST_CAP + idx]; } } }
        __builtin_amdgcn_sched_barrier(0);
#pragma unroll
        for (int i = 0; i < 8; ++i) if (tv[i] >= 0) tt[i * 256 + F.tid] = tv[i];
        VM_WAIT(); __syncthreads();
    }
    pg8::Gemm g{(const bf16*)(F.ws + (MOE_FP8 ? WS_H8 : WS_H)), (const bf16*)(layer_w(F, l) + WO_GU)};
#if MOE_FP8
    pg8::EpiSwiglu8 E{(unsigned char*)(F.ws + WS_ACT)};
    pg8::gemm_phase<pg8::EpiSwiglu8, pg8::MoeOrder, true, DM / 2, DM / 2, DM / 2, true>(F.lds, g, S, E, (const LAS int*)(F.lds + X_TOK));
    frame_refresh(F);
    if (l == 0) cvt_queue_drain(F, 0, Q_FIRST, Q_1); else cvt_queue_drain(F, 2, Q_FIRST + Q_A, Q_B);
#else
    pg8::EpiSwiglu E{(bf16*)(F.ws + WS_ACT)};
    pg8::gemm_phase<pg8::EpiSwiglu, pg8::MoeOrder, true, DM, DM, DM>(F.lds, g, S, E, (const LAS int*)(F.lds + X_TOK));
#endif
}
__device__ __forceinline__ void ph_m2(int l) {
    Frame F; frame_refresh(F);
    if (!MK_ONE_LAUNCH) load_expert_tables(F, l);
    const LAS int* misc = (const LAS int*)(F.lds + X_MISC);
    pg8::MoeOrder S; S.G = F.G; S.c = (int)blockIdx.x; S.NT = misc[24]; S.tpre = misc + 8; S.a_tile_bytes = 256u * 1024u * (MOE_FP8 ? 1u : 2u); S.b_exp_bytes = 2048u * 1024u * (MOE_FP8 ? 1u : 2u); S.b_tile_bytes = 256u * 1024u * (MOE_FP8 ? 1u : 2u);
    pg8::Gemm g{(const bf16*)(F.ws + WS_ACT), (const bf16*)(layer_w(F, l) + WO_D)};
    pg8::EpiDown E{(bf16*)(F.ws + WS_YB), MOE_FP8 ? W8_INV : 1.0f};
#if MOE_FP8
    pg8::gemm_phase<pg8::EpiDown, pg8::MoeOrder, false, DE / 2, DE / 2, DE / 2, true>(F.lds, g, S, E, (const LAS int*)(F.lds + X_TOK));
    if (l == 0) { frame_refresh(F); cvt_queue_drain(F, 1, Q_FIRST + Q_1, Q_A - Q_1); }
#else
    pg8::gemm_phase<pg8::EpiDown, pg8::MoeOrder, false, DE, DE, DE>(F.lds, g, S, E, (const LAS int*)(F.lds + X_TOK));
#endif
}
__device__ __forceinline__ void grid_seam() {
    XcdBarrier bar; bar.bar = (unsigned*)((unsigned char*)arg_in(21) + WS_CTL) + CW_BAR; bar.x = xb_xcc_id(); bar.st = (volatile LAS unsigned*)((LAS unsigned char*)lds_raw + X_MISC);
    xcd_barrier(bar);
}

template <int MODE>
__device__ __forceinline__ void grid_seam_fill(int l) {
    XcdBarrier b; b.bar = (unsigned*)((unsigned char*)arg_in(21) + WS_CTL) + CW_BAR; b.x = xb_xcc_id(); b.st = (volatile LAS unsigned*)((LAS unsigned char*)lds_raw + X_MISC);
    asm volatile("s_waitcnt vmcnt(0)" ::: "memory");
    __syncthreads();
    if (threadIdx.x == 0) {
        unsigned* bar = b.bar;
        __builtin_amdgcn_s_waitcnt(0);
        unsigned nloc = b.st[0], nx = b.st[1];
        if (nloc == 0u) { xcd_barrier_complete(bar, b.x, nloc, nx); b.st[0] = nloc; b.st[1] = nx; }
        const unsigned old = xb_add(&bar[XB_XSUB(b.x)], 1u);
        const unsigned gen = old / nloc;
        if (old + 1u == (gen + 1u) * nloc) {
            __builtin_amdgcn_fence(__ATOMIC_RELEASE, "agent");
            asm volatile("s_waitcnt vmcnt(0)" ::: "memory");
            const unsigned og = xb_add(&bar[XB_TOP], 1u);
            const unsigned tg = og / nx;
            if (og + 1u == (tg + 1u) * nx) xb_add(&bar[XB_TOPGEN], 1u);
            else XB_SPIN(xb_ld(&bar[XB_TOPGEN]) == tg, bar);
            __builtin_amdgcn_fence(__ATOMIC_ACQUIRE, "agent");
            xb_add(&bar[XB_XGEN(b.x)], 1u);
            asm volatile("s_waitcnt vmcnt(0)" ::: "memory");
        } else {
            XB_SPIN(xb_ld(&bar[XB_XGEN(b.x)]) == gen, bar);
            __builtin_amdgcn_fence(__ATOMIC_ACQUIRE, "agent");
            asm volatile("s_waitcnt vmcnt(0)" ::: "memory");
        }
    } else if (threadIdx.x >= 64) {
        const int t = opaque_tid() - 64;
        LAS f32x4* tab = (LAS f32x4*)lds_raw;
        if (MODE == 1) {
            const f32x4* src = (const f32x4*)ARG_IN(I_WROUTER);
            f32x4 tv[19];
#pragma unroll
            for (int k = 0; k < 19; ++k) { const int i = t + k * 448; tv[k] = src[i < DM * 4 ? i : 0]; }
            __builtin_amdgcn_sched_barrier(0);
#pragma unroll
            for (int k = 0; k < 19; ++k) { const int i = t + k * 448; if (i < DM * 4) { const int c = i >> 2, g = i & 3; tab[((g * 4 + (c & 3)) * 8 + (c >> 8)) * 64 + ((c >> 2) & 63)] = tv[k]; } }
        } else if (MODE == 2) {
            const int bx = blockIdx.x, G = gridDim.x, vcu = (G % 8 == 0) ? (bx % 8) * (G / 8) + bx / 8 : bx, bh = vcu >> 2;
            const float* LS = (const float*)((const unsigned char*)arg_in(21) + WS_LS) + (size_t)(bh >> 3) * SEQ * 8 + (bh & 7);
            LAS float* st = (LAS float*)((LAS unsigned char*)lds_raw + 90112);
            float tv[5];
#pragma unroll
            for (int k = 0; k < 5; ++k) { const int i = t + k * 448; tv[k] = LS[(size_t)(i < SEQ ? i : 0) * 8]; }
            __builtin_amdgcn_sched_barrier(0);
#pragma unroll
            for (int k = 0; k < 5; ++k) { const int i = t + k * 448; if (i < SEQ) st[i] = tv[k]; }
        } else {
            const float* src = ARG_IN(I_WIN) + (size_t)l * DM * INW + 4096;
            f32x4 tv[10];
#pragma unroll
            for (int k = 0; k < 10; ++k) { const int i = t + k * 448, ii = i < DM * 2 ? i : 0, c = ii >> 1, g = ii & 1; tv[k] = *(const f32x4*)(src + (size_t)c * INW + g * 4); }
            __builtin_amdgcn_sched_barrier(0);
#pragma unroll
            for (int k = 0; k < 10; ++k) { const int i = t + k * 448; if (i < DM * 2) { const int c = i >> 1, g = i & 1; tab[((g * 4 + (c & 3)) * 8 + (c >> 8)) * 64 + ((c >> 2) & 63)] = tv[k]; } }
        }
    }
    __syncthreads();
}

constexpr int N_PHASES = 18;
#ifndef PHMASK
#define PHMASK 0xFFFF
#endif
#define EN(j) ((PHMASK >> (j)) & 1)
#ifndef DUPMASK
#define DUPMASK 0
#endif
#define DUP(j) ((DUPMASK >> (j)) & 1)
__global__ void __launch_bounds__(NTHREADS, 2) mk_fwd(Args args) {
    {
        LAS unsigned char* lds = (LAS unsigned char*)lds_raw;
        for (int u = threadIdx.x; u < (LDS_BYTES - EXTRA_OFF) / 4; u += NTHREADS) ((LAS unsigned*)(lds + EXTRA_OFF))[u] = 0u;
        __syncthreads();
        if (args.ph_hi - args.ph_lo > 1) (void)xcd_barrier_post((unsigned*)(args.ws + WS_CTL) + CW_BAR, (volatile LAS unsigned*)(lds + X_MISC));
    }
#define IN(k) (arg_i32(176) <= (k) && (k) < arg_i32(180))
#define SEAM(k) do { if (IN(k) && IN((k) + 1)) grid_seam(); } while (0)
    if (EN(0) && IN(0)) ph_p0();
    if (DUP(0) && IN(0)) ph_p0();
    constexpr bool PRE = MK_ONE_LAUNCH != 0;
#define SEAM_FILL(k, MODE, ll) do { if (IN(k) && IN((k) + 1)) { if (PRE) grid_seam_fill<MODE>(ll); else grid_seam(); } } while (0)
    SEAM_FILL(0, 0, 0);
    for (int l = 0; l < DEPTH; ++l) {
        const int pb = 1 + 8 * l;
        if (EN(1) && IN(pb + 0)) ph_r1(l, PRE);
        if (DUP(1) && l == 0 && IN(pb + 0)) { ph_r1(l); ph_r1(l); }
        SEAM(pb + 0);
        if (EN(2) && IN(pb + 1)) ph_g1(l);
        if (DUP(2) && IN(pb + 1)) ph_g1(l);
        SEAM_FILL(pb + 1, 2, l);
        if (EN(3) && IN(pb + 2)) ph_at(l, PRE);
        if (DUP(3) && IN(pb + 2)) ph_at(l);
        SEAM(pb + 2);
        if (EN(4) && IN(pb + 3)) ph_g2(l);
        if (DUP(4) && IN(pb + 3)) ph_g2(l);
        SEAM(pb + 3);
        if (EN(5) && IN(pb + 4)) ph_g3(l);
        if (DUP(5) && l == 0 && IN(pb + 4)) { ph_g3(l); ph_g3(l); }
        SEAM_FILL(pb + 4, 1, l);
        if (EN(6) && IN(pb + 5)) ph_r2(l, PRE);
        if (DUP(6) && l == 0 && IN(pb + 5)) { ph_r2_dry(l); ph_r2_dry(l); }
        SEAM(pb + 5);
        if (EN(7) && IN(pb + 6)) ph_m1(l);
        if (DUP(7) && IN(pb + 6)) ph_m1(l);
        SEAM(pb + 6);
        if (EN(8) && IN(pb + 7)) ph_m2(l);
        if (DUP(8) && IN(pb + 7)) ph_m2(l);
        if (l + 1 < DEPTH) SEAM_FILL(pb + 7, 0, l + 1); else SEAM(pb + 7);
    }
    if (EN(9) && IN(17)) ph_final();
#undef IN
#undef SEAM
#undef SEAM_FILL
}

extern "C" void kernel_launch(void* const* d_in, const int* in_sizes, int n_in, void* d_out, int out_size, void* d_ws, size_t ws_size, hipStream_t stream) {
    static int grid = 0;
    if (grid == 0) {
        if (n_in != 20 || out_size != T * DM || ws_size < WS_END) { fprintf(stderr, "kernel_launch: unexpected shapes (n_in %d out %d ws %zu)\n", n_in, out_size, ws_size); grid = -1; return; }
        int dev = 0, cus = 0, per_cu = 0;
        if (hipGetDevice(&dev) != hipSuccess || hipDeviceGetAttribute(&cus, hipDeviceAttributeMultiprocessorCount, dev) != hipSuccess) { grid = -1; return; }
        if (hipFuncSetAttribute((const void*)mk_fwd, hipFuncAttributeMaxDynamicSharedMemorySize, LDS_BYTES) != hipSuccess) { fprintf(stderr, "kernel_launch: hipFuncSetAttribute failed\n"); grid = -1; return; }
        if (hipOccupancyMaxActiveBlocksPerMultiprocessor(&per_cu, (const void*)mk_fwd, NTHREADS, LDS_BYTES) != hipSuccess || per_cu < 1) { fprintf(stderr, "kernel_launch: occupancy query says %d\n", per_cu); }
        (void)hipGetLastError();
        grid = cus;
    }
    if (grid < 0) return;
    (void)hipMemsetAsync((char*)d_ws + WS_CTL, 0, CTL_ZERO_BYTES, stream);
    Args a{};
    for (int i = 0; i < 20; ++i) a.in[i] = (const float*)d_in[i];
    a.out = (float*)d_out; a.ws = (unsigned char*)d_ws;
#if MK_ONE_LAUNCH
    a.ph_lo = 0; a.ph_hi = N_PHASES;
    hipLaunchKernelGGL(mk_fwd, dim3(grid), dim3(NTHREADS), LDS_BYTES, stream, a);
#else
    for (int p = 0; p < N_PHASES; ++p) { a.ph_lo = p; a.ph_hi = p + 1; hipLaunchKernelGGL(mk_fwd, dim3(grid), dim3(NTHREADS), LDS_BYTES, stream, a); }
#endif
}
```

```cpp
#include <hip/hip_runtime.h>
#include <stdio.h>
#include <stdint.h>

#ifndef MK_ONE_LAUNCH
#define MK_ONE_LAUNCH 1
#endif
#ifndef MOE_FP8
#define MOE_FP8 1
#endif
#ifndef G1_FP8
#define G1_FP8 2
#endif
#ifndef G3_FP8
#define G3_FP8 1
#endif
#ifndef G2_FP8
#define G2_FP8 1
#endif
#ifndef YB_FP8
#define YB_FP8 1
#endif
#ifndef GEMM_FAST
#define GEMM_FAST 1
#endif
#ifndef ATTN_FAST
#define ATTN_FAST 1
#endif

#define GAS __attribute__((address_space(1)))
#define LAS __attribute__((address_space(3)))
typedef unsigned short bf16;
typedef short bf16x8 __attribute__((ext_vector_type(8)));
typedef float f32x4 __attribute__((ext_vector_type(4)));
typedef float f32x2 __attribute__((ext_vector_type(2)));
typedef unsigned u32x4 __attribute__((ext_vector_type(4)));
typedef unsigned u32x2 __attribute__((ext_vector_type(2)));
typedef GAS unsigned gu32;
#define RLX_AGENT __ATOMIC_RELAXED, __HIP_MEMORY_SCOPE_AGENT
#define LDS_WAIT() asm volatile("s_waitcnt lgkmcnt(0)" ::: "memory")
#define VM_WAIT() asm volatile("s_waitcnt vmcnt(0)" ::: "memory")

constexpr int DM = 2048, BATCH = 8, SEQ = 2048, T = BATCH * SEQ, DEPTH = 2;
constexpr int PW = 1024, AW = 1024, NH = 8, HD = 128, INW = 4104, NE = 16, DE = 1024, NMOD = 6;
constexpr int MODW = NMOD * DM;
constexpr float EPS = 1e-6f;
constexpr int NWAVES = 8, NTHREADS = 512;
constexpr int LIST_CAP = 16384;
constexpr int MAX_RT = 144;

constexpr size_t MiB = 1u << 20;
constexpr size_t WS_CTL = 0, CTL_ZERO_BYTES = 128 * 1024;
constexpr size_t WS_MOD = 1 * MiB;
constexpr size_t WS_W = 2 * MiB, W_LAYER = 241 * MiB;
constexpr size_t WO_PG = 0, WO_POOL = 32 * MiB, WO_BR = 33 * MiB, WO_OUT = 41 * MiB, WO_GU = 49 * MiB, WO_D = 177 * MiB;
constexpr size_t WS_H = 484 * MiB;
constexpr size_t WS_U = 548 * MiB, WS_Q = 580 * MiB, WS_K = 612 * MiB, WS_V = 644 * MiB;
constexpr size_t WS_G = 676 * MiB;
constexpr size_t WS_PL = 804 * MiB, WS_PO = 836 * MiB, WS_AO = 868 * MiB;
constexpr size_t WS_MG = 900 * MiB;
constexpr size_t WS_DL = 804 * MiB;
constexpr size_t WS_ACT = 804 * MiB;
constexpr size_t WS_YB = 548 * MiB;
constexpr size_t WS_LS = 964 * MiB;
constexpr size_t WS_TOKE = 965 * MiB;
constexpr size_t WS_TOKW = WS_TOKE + 128 * 1024;
constexpr size_t WS_TOKP = WS_TOKW + 128 * 1024;
constexpr size_t WS_LIST = 966 * MiB;
constexpr size_t WS_MODP = 968 * MiB;
constexpr size_t WS_H8 = 972 * MiB;
constexpr size_t WS_XB = 1004 * MiB;
constexpr size_t WS_MG8 = 1068 * MiB;
constexpr size_t WS_END = 1100 * MiB;
constexpr int CW_BAR = 4096;
constexpr int CW_CNT = 16384;

constexpr int RING_BYTES = 131072;
constexpr int EXTRA_OFF = 135168;
constexpr int LDS_BYTES = 147456;
constexpr int X_MISC = EXTRA_OFF;
constexpr int X_TOK = EXTRA_OFF + 1024;
constexpr int X_ASG = EXTRA_OFF + 9216;

typedef __bf16 bf16x2_t __attribute__((ext_vector_type(2)));
__device__ __forceinline__ unsigned cvt_pk_bf16(float lo, float hi) { f32x2 v = {lo, hi}; bf16x2_t b = __builtin_convertvector(v, bf16x2_t); return __builtin_bit_cast(unsigned, b); }
typedef int i32x8 __attribute__((ext_vector_type(8)));
typedef int i32x4 __attribute__((ext_vector_type(4)));
__device__ __forceinline__ unsigned pk4_fp8(float a, float b, float c, float d) { int w = __builtin_amdgcn_cvt_pk_fp8_f32(a, b, 0, false); w = __builtin_amdgcn_cvt_pk_fp8_f32(c, d, w, true); return (unsigned)w; }
__device__ __forceinline__ unsigned pk4_unorm8(const f32x4 v) { unsigned w = 0;
    w = __builtin_amdgcn_cvt_pk_u8_f32(__builtin_floorf(v[0] * 255.0f + 0.5f), 0, w); w = __builtin_amdgcn_cvt_pk_u8_f32(__builtin_floorf(v[1] * 255.0f + 0.5f), 1, w);
    w = __builtin_amdgcn_cvt_pk_u8_f32(__builtin_floorf(v[2] * 255.0f + 0.5f), 2, w); w = __builtin_amdgcn_cvt_pk_u8_f32(__builtin_floorf(v[3] * 255.0f + 0.5f), 3, w); return w; }
__device__ __forceinline__ f32x4 unpk4_u8(unsigned w) { return (f32x4){(float)(w & 0xffu), (float)((w >> 8) & 0xffu), (float)((w >> 16) & 0xffu), (float)(w >> 24)}; }
__device__ __forceinline__ f32x4 unpk4_unorm8(unsigned w) { return (f32x4){(float)(w & 0xffu), (float)((w >> 8) & 0xffu), (float)((w >> 16) & 0xffu), (float)(w >> 24)} * (1.0f / 255.0f); }
__device__ __forceinline__ f32x4 unpk4_fp8(unsigned w) { const f32x2 lo = __builtin_amdgcn_cvt_pk_f32_fp8((int)w, false), hi = __builtin_amdgcn_cvt_pk_f32_fp8((int)w, true); return (f32x4){lo.x, lo.y, hi.x, hi.y}; }
constexpr float W8_SCALE = 32.0f, W8_INV = 1.0f / 32.0f;
__device__ __forceinline__ float bf_lo(unsigned w) { return __uint_as_float(w << 16); }
__device__ __forceinline__ float bf_hi(unsigned w) { return __uint_as_float(w & 0xffff0000u); }
__device__ __forceinline__ float wave_sum(float v) {
#pragma unroll
    for (int o = 1; o < 64; o <<= 1) v += __shfl_xor(v, o);
    return v;
}
template <int CTRL, int ROW_MASK> __device__ __forceinline__ float dpp_get(float v) { return __int_as_float(__builtin_amdgcn_update_dpp(0, __float_as_int(v), CTRL, ROW_MASK, 0xf, false)); }
__device__ __forceinline__ float wave_sum_u(float v) {
    v += dpp_get<0xB1, 0xf>(v);
    v += dpp_get<0x4E, 0xf>(v);
    v += dpp_get<0x141, 0xf>(v);
    v += dpp_get<0x140, 0xf>(v);
    v += dpp_get<0x142, 0xa>(v);
    v += dpp_get<0x143, 0xc>(v);
    return __int_as_float(__builtin_amdgcn_readlane(__float_as_int(v), 63));
}
__device__ __forceinline__ float wave_max(float v) {
#pragma unroll
    for (int o = 1; o < 64; o <<= 1) v = fmaxf(v, __shfl_xor(v, o));
    return v;
}
__device__ __forceinline__ float sigmoidf_(float x) { return __builtin_amdgcn_rcpf(1.0f + __builtin_amdgcn_exp2f(-1.4426950408889634f * x)); }

__device__ __forceinline__ int opaque_tid() { int t = threadIdx.x; asm volatile("" : "+v"(t)); return t; }

#define XB_TMO      128
#define XB_XCNT(j)  (256  + 64 * (j))
#define XB_XSUB(j)  (1280 + 64 * (j))
#define XB_XGEN(j)  (2304 + 64 * (j))
#define XB_TOP      3328
#define XB_TOPGEN   3392
#define XCD_BAR_WORDS 3456
#define XB_SPIN_CAP (1u << 24)
__device__ __forceinline__ unsigned xb_ld(unsigned* p)              { return __hip_atomic_load(p, __ATOMIC_RELAXED, __HIP_MEMORY_SCOPE_AGENT); }
__device__ __forceinline__ unsigned xb_add(unsigned* p, unsigned v) { return __hip_atomic_fetch_add(p, v, __ATOMIC_RELAXED, __HIP_MEMORY_SCOPE_AGENT); }
__device__ __forceinline__ unsigned xb_xcc_id() { return (unsigned)__builtin_amdgcn_s_getreg((3 << 11) | 20) & 0xFu; }
#define XB_SPIN(cond, bar) do { unsigned _sp = 0; while (cond) { __builtin_amdgcn_s_sleep(1); \
    if ((++_sp & 255u) == 0u) { if (xb_ld(&(bar)[XB_TMO])) break; if (_sp > XB_SPIN_CAP) { atomicAdd(&(bar)[XB_TMO], 1u); break; } } } } while (0)
struct XcdBarrier { unsigned* bar; unsigned x; volatile LAS unsigned* st; };
__device__ __forceinline__ XcdBarrier xcd_barrier_post(unsigned* bar, volatile LAS unsigned* st) {
    XcdBarrier b; b.bar = bar; b.x = xb_xcc_id(); b.st = st;
    if (threadIdx.x == 0) (void)xb_add(&bar[XB_XCNT(b.x)], 1u);
    return b;
}
__device__ __forceinline__ void xcd_barrier_complete(unsigned* bar, unsigned x, unsigned& nloc, unsigned& nx) {
    const unsigned G = gridDim.x * gridDim.y * gridDim.z;
    unsigned sum, cnt, mine, sp = 0u;
    for (;;) {
        sum = 0u; cnt = 0u; mine = 0u;
#pragma unroll
        for (unsigned j = 0; j < 16; ++j) { const unsigned c = xb_ld(&bar[XB_XCNT(j)]); sum += c; cnt += (c > 0u) ? 1u : 0u; mine = (j == x) ? c : mine; }
        if (sum == G) break;
        __builtin_amdgcn_s_sleep(1);
        if ((++sp & 255u) == 0u) { if (xb_ld(&bar[XB_TMO])) break; if (sp > XB_SPIN_CAP) { atomicAdd(&bar[XB_TMO], 1u); break; } }
    }
    nloc = mine > 0u ? mine : 1u; nx = cnt > 0u ? cnt : 1u;
}
__device__ __forceinline__ void xcd_barrier(const XcdBarrier& b) {
    asm volatile("s_waitcnt vmcnt(0)" ::: "memory");
    __syncthreads();
    if (threadIdx.x == 0) {
        unsigned* bar = b.bar;
        __builtin_amdgcn_s_waitcnt(0);
        unsigned nloc = b.st[0], nx = b.st[1];
        if (nloc == 0u) { xcd_barrier_complete(bar, b.x, nloc, nx); b.st[0] = nloc; b.st[1] = nx; }
        const unsigned old = xb_add(&bar[XB_XSUB(b.x)], 1u);
        const unsigned gen = old / nloc;
        if (old + 1u == (gen + 1u) * nloc) {
            __builtin_amdgcn_fence(__ATOMIC_RELEASE, "agent");
            asm volatile("s_waitcnt vmcnt(0)" ::: "memory");
            const unsigned og = xb_add(&bar[XB_TOP], 1u);
            const unsigned tg = og / nx;
            if (og + 1u == (tg + 1u) * nx) xb_add(&bar[XB_TOPGEN], 1u);
            else XB_SPIN(xb_ld(&bar[XB_TOPGEN]) == tg, bar);
            __builtin_amdgcn_fence(__ATOMIC_ACQUIRE, "agent");
            xb_add(&bar[XB_XGEN(b.x)], 1u);
            asm volatile("s_waitcnt vmcnt(0)" ::: "memory");
        } else {
            XB_SPIN(xb_ld(&bar[XB_XGEN(b.x)]) == gen, bar);
            __builtin_amdgcn_fence(__ATOMIC_ACQUIRE, "agent");
            asm volatile("s_waitcnt vmcnt(0)" ::: "memory");
        }
    }
    __syncthreads();
}

namespace pg8 {
constexpr int BM = 256, BK = 64, HALF = 128, HTB = HALF * BK * 2, STAGE_BYTES = 8 * HTB, NXCD = 8, WGM = 8;
__device__ __forceinline__ int lds_byte(int r, int c) { const int st = (r >> 4) * 2 + (c >> 5), rr = r & 15, cc = c & 31, ob = rr * 64 + cc * 2; return st * 1024 + (ob ^ (((ob >> 9) & 1) << 5)); }
__device__ __forceinline__ void stage_rc(int b, int& R, int& C) { const int st = b / 1024, sb = b % 1024, swz = sb ^ (((sb >> 9) & 1) << 5); R = (st >> 1) * 16 + swz / 64; C = (st & 1) * 32 + (swz % 64) / 2; }
__device__ __forceinline__ int perm32(int rho) { const int n = rho >> 4, i = rho & 15; return 8 * (i >> 2) + 4 * n + (i & 3); }

struct Unit { int pm, pn, ti; unsigned aoff, boff, aoff2, boff2; };
struct Gemm { const bf16* A; const bf16* Bt; };

template <int M_, int N_, int LDA, int LDB> struct StaticOrder {
    static constexpr int nM = M_ / BM, nN = N_ / BM, nwg = nM * nN;
    int G, c;
    __device__ void init(int G_, int c_) { G = G_; c = c_; }
    __device__ bool next(int i, Unit& u) const {
        const int L = i * G + c; if (L >= nwg) return false;
        int wgid = L; { constexpr int q = nwg / NXCD, r = nwg % NXCD; const int xcd = wgid % NXCD, off = wgid / NXCD; wgid = (xcd < r ? xcd * (q + 1) : r * (q + 1) + (xcd - r) * q) + off; }
        constexpr int nig = WGM * nN; const int gid = wgid / nig, fm = gid * WGM, gsz = (nM - fm) < WGM ? (nM - fm) : WGM;
        u.pm = fm + ((wgid % nig) % gsz); u.pn = (wgid % nig) / gsz; u.ti = i;
        u.aoff = (unsigned)u.pm * (unsigned)(BM * LDA * 2); u.boff = (unsigned)u.pn * (unsigned)(BM * LDB * 2); u.aoff2 = 0u; u.boff2 = 0u;
        return true;
    }
};
template <class Base> struct BranchOrder {
    Base S0; unsigned a_step, b_step;
    __device__ bool next(int i, Unit& u) const { if (!S0.next(i >> 1, u)) return false; const unsigned p = (unsigned)(i & 1); u.ti = (int)p; u.aoff += p * a_step; u.boff += p * b_step; return true; }
};
template <class Base> struct SplitOrder {
    Base S0; unsigned a2, b2;
    __device__ bool next(int i, Unit& u) const { if (!S0.next(i, u)) return false; u.aoff2 = u.aoff + a2; u.boff2 = u.boff + b2; return true; }
};
struct OneUnit {
    Unit u0;
    __device__ bool next(int i, Unit& u) const { if (i > 0) return false; u = u0; return true; }
};
struct MoeOrder {
    int G, c, NT; const LAS int* tpre; unsigned a_tile_bytes, b_exp_bytes, b_tile_bytes;
    __device__ bool next(int i, Unit& u) const {
        const int L = i * G + c; const int x = L & 7, a = L >> 3, pn = a & 7, q = a >> 3;
        const int rt = (G == 256) ? 32 * i + 4 * x + (c >> 6) : q * 8 + x;
        if (rt >= NT) return false;
        int e = 0;
#pragma unroll
        for (int j = 1; j < 16; ++j) e += (rt >= tpre[j]) ? 1 : 0;
        e = __builtin_amdgcn_readfirstlane(e);
        u.pm = rt; u.pn = pn; u.ti = i; u.aoff = (unsigned)rt * a_tile_bytes; u.boff = (unsigned)e * b_exp_bytes + (unsigned)pn * b_tile_bytes; u.aoff2 = 0u; u.boff2 = 0u;
        return true;
    }
};

#if !GEMM_FAST
template <class Epi, class Sched, bool GATHER, int LDA, int LDB, int KK>
__device__ __forceinline__ void gemm_phase(LAS unsigned char* lds, const Gemm g, const Sched& S, const Epi& E, const LAS int* tokTab) {
    const int tid = opaque_tid(), wid = __builtin_amdgcn_readfirstlane(tid >> 6), lane = tid & 63, wr = wid >> 2, wc = wid & 3, fr = lane & 15, fq = lane >> 4;
    Unit u;
    for (int i = 0; S.next(i, u); ++i) {
        f32x4 acc[2][2][4][2];
#pragma unroll
        for (int a = 0; a < 2; ++a)
#pragma unroll
            for (int b = 0; b < 2; ++b)
#pragma unroll
                for (int m = 0; m < 4; ++m)
#pragma unroll
                    for (int n = 0; n < 2; ++n) acc[a][b][m][n] = (f32x4){0.f, 0.f, 0.f, 0.f};
        const char* Ab = (const char*)g.A + u.aoff; const char* Bb = (const char*)g.Bt + u.boff;
        unsigned arow[2][4], brow[2][2];
#pragma unroll
        for (int ai = 0; ai < 2; ++ai)
#pragma unroll
            for (int m = 0; m < 4; ++m) { const int r = ai * HALF + wr * 64 + m * 16 + fr;
                arow[ai][m] = (GATHER ? (unsigned)tokTab[u.ti * 256 + r] : (unsigned)r) * (unsigned)(LDA * 2); }
#pragma unroll
        for (int bj = 0; bj < 2; ++bj)
#pragma unroll
            for (int n = 0; n < 2; ++n) { const int slot = 16 * n + fr; const int rb = bj * HALF + wc * 32 + (Epi::PERM ? perm32(slot) : slot); brow[bj][n] = (unsigned)rb * (unsigned)(LDB * 2); }
#pragma nounroll
        for (int k0 = 0; k0 < KK; k0 += 32) {
            bf16x8 Bf[2][2];
            const unsigned kb = (unsigned)(k0 + fq * 8) * 2u;
#pragma unroll
            for (int bj = 0; bj < 2; ++bj)
#pragma unroll
                for (int n = 0; n < 2; ++n) Bf[bj][n] = *(const bf16x8*)(Bb + brow[bj][n] + kb);
#pragma unroll
            for (int ai = 0; ai < 2; ++ai) {
                bf16x8 Af[4];
#pragma unroll
                for (int m = 0; m < 4; ++m) Af[m] = *(const bf16x8*)(Ab + arow[ai][m] + kb);
#pragma unroll
                for (int bj = 0; bj < 2; ++bj)
#pragma unroll
                    for (int m = 0; m < 4; ++m)
#pragma unroll
                        for (int n = 0; n < 2; ++n) acc[ai][bj][m][n] = __builtin_amdgcn_mfma_f32_16x16x32_bf16(Bf[bj][n], Af[m], acc[ai][bj][m][n], 0, 0, 0);
                asm volatile("" ::: "memory");
            }
        }
        E(acc, u, wr, wc, fr, fq);
    }
    (void)lds;
}
#else
template <class Epi, class Sched, bool GATHER, int LDA, int LDB, int KK, bool FP8 = false, int KSPLIT = 0>
__device__ __forceinline__ void gemm_phase(LAS unsigned char* lds, const Gemm g, const Sched& S, const Epi& E, const LAS int* tokTab) {
    constexpr bool ALIGN_EPI = true; constexpr int KS = KSPLIT;
    const int tid = opaque_tid(), wid = __builtin_amdgcn_readfirstlane(tid >> 6), lane = tid & 63, wr = wid >> 2, wc = wid & 3, fr = lane & 15, fq = lane >> 4;
    constexpr int nt = KK / BK;
    unsigned voffA[2], voffB[2];
#pragma unroll
    for (int i = 0; i < 2; ++i) { int R, C; stage_rc(tid * 16 + i * 8192, R, C); const int Rb = Epi::PERM ? ((R & ~31) + perm32(R & 31)) : R;
        voffA[i] = (unsigned)(R * LDA + C) * 2u; voffB[i] = (unsigned)(Rb * LDB + C) * 2u; }
    constexpr unsigned rowA = (unsigned)LDA * 2u;
    constexpr unsigned kstep = (unsigned)(BK * 2);
    constexpr unsigned hstepA = (unsigned)HALF * LDA * 2u, hstepB = (unsigned)HALF * LDB * 2u;
    const unsigned ldsw = (unsigned)wid * 1024u;
    const int aoff = lds_byte(wr * 64 + fr, fq * 8), boff = lds_byte(wc * 32 + fr, fq * 8);
#define PG8_SA(b, h) (((b) * 2 + (h)) * HTB)
#define PG8_SB(b, h) ((4 + (b) * 2 + (h)) * HTB)
#define PG8_STAGE(bufoff, gbase, uoff, voff) do { _Pragma("unroll") for (int _i = 0; _i < 2; ++_i) \
        __builtin_amdgcn_global_load_lds((const unsigned*)((const char*)(gbase) + (size_t)(unsigned)((uoff) + (voff)[_i])), (LAS unsigned*)(lds + (bufoff) + ldsw + _i * 8192), 16, 0, 0); } while (0)
#define PG8_STAGE_A(bufoff, p, hh, VA) do { if constexpr (GATHER) { PG8_STAGE(bufoff, g.A, p, VA[hh]); } else { PG8_STAGE(bufoff, g.A, (p) + (hh) * hstepA, voffA); } } while (0)
#define PG8_STAGE_B(bufoff, p) PG8_STAGE(bufoff, g.Bt, p, voffB)
#define PG8_LD32(p) __builtin_shufflevector(*(const LAS i32x4*)(p), *(const LAS i32x4*)((p) + 1024), 0, 1, 2, 3, 4, 5, 6, 7)
#define PG8_LDA(dst, b, h) do { if constexpr (FP8) { _Pragma("unroll") for (int m = 0; m < 4; ++m) dst##8[m] = PG8_LD32(lds + PG8_SA(b, h) + aoff + m * 2048); } \
        else { _Pragma("unroll") for (int m = 0; m < 4; ++m) _Pragma("unroll") for (int k = 0; k < 2; ++k) dst[m][k] = *(const LAS bf16x8*)(lds + PG8_SA(b, h) + aoff + m * 2048 + k * 1024); } } while (0)
#define PG8_LDB(dst, b, h) do { if constexpr (FP8) { _Pragma("unroll") for (int n = 0; n < 2; ++n) dst##8[n] = PG8_LD32(lds + PG8_SB(b, h) + boff + n * 2048); } \
        else { _Pragma("unroll") for (int n = 0; n < 2; ++n) _Pragma("unroll") for (int k = 0; k < 2; ++k) dst[n][k] = *(const LAS bf16x8*)(lds + PG8_SB(b, h) + boff + n * 2048 + k * 1024); } } while (0)
#define PG8_MMA(ai, bj, At, Bt) do { __builtin_amdgcn_s_setprio(1); _Pragma("unroll") for (int m = 0; m < 4; ++m) _Pragma("unroll") for (int n = 0; n < 2; ++n) { \
        if constexpr (FP8) { asm volatile("v_mfma_f32_16x16x128_f8f6f4 %0, %1, %2, %0" : "+v"(acc[ai][bj][m][n]) : "v"(Bt##8[n]), "v"(At##8[m])); }   \
        else { _Pragma("unroll") for (int k = 0; k < 2; ++k) acc[ai][bj][m][n] = __builtin_amdgcn_mfma_f32_16x16x32_bf16(Bt[n][k], At[m][k], acc[ai][bj][m][n], 0, 0, 0); } } \
        __builtin_amdgcn_s_setprio(0); } while (0)
#define PG8_WAIT_V(n) asm volatile("s_waitcnt vmcnt(" #n ")" ::: "memory")
#define PG8_WAIT_L(n) asm volatile("s_waitcnt lgkmcnt(" #n ")" ::: "memory")
#define PG8_BAR __builtin_amdgcn_s_barrier()
#define PG8_SCHED __builtin_amdgcn_sched_barrier(0)
#define PG8_AOFFS(dst, uu) do { _Pragma("unroll") for (int _i = 0; _i < 2; ++_i) { int _R, _C; stage_rc(tid * 16 + _i * 8192, _R, _C); _Pragma("unroll") for (int _h = 0; _h < 2; ++_h) \
        dst[_h][_i] = (unsigned)tokTab[(uu).ti * 256 + _h * HALF + _R] * rowA + (unsigned)_C * 2u; } } while (0)
#define PG8_TRIP(VC, V2) do { \
        PG8_LDB(B0, 0, 0); PG8_LDB(B1, 0, 1); PG8_SCHED; PG8_LDA(At, 0, 0); PG8_STAGE_A(PG8_SA(1, 1), a1, 1, VC); \
        PG8_WAIT_V(8); PG8_WAIT_L(0); PG8_BAR; PG8_MMA(0, 0, At, B0); PG8_MMA(0, 1, At, B1); PG8_BAR; PG8_SCHED; \
        PG8_LDA(At, 0, 1); PG8_STAGE_B(PG8_SB(0, 0), b2); PG8_STAGE_B(PG8_SB(0, 1), b2 + hstepB); PG8_STAGE_A(PG8_SA(0, 0), a2, 0, V2); \
        PG8_WAIT_V(8); PG8_WAIT_L(0); PG8_BAR; PG8_MMA(1, 0, At, B0); PG8_MMA(1, 1, At, B1); PG8_BAR; PG8_SCHED; \
        PG8_LDB(B0, 1, 0); PG8_LDB(B1, 1, 1); PG8_SCHED; PG8_LDA(At, 1, 0); PG8_STAGE_A(PG8_SA(0, 1), a2, 1, V2); \
        PG8_WAIT_V(8); PG8_WAIT_L(0); PG8_BAR; PG8_MMA(0, 0, At, B0); PG8_MMA(0, 1, At, B1); PG8_BAR; PG8_SCHED; \
        PG8_LDA(At, 1, 1); PG8_STAGE_B(PG8_SB(1, 0), b3); PG8_STAGE_B(PG8_SB(1, 1), b3 + hstepB); PG8_STAGE_A(PG8_SA(1, 0), a3, 0, V2); \
        PG8_WAIT_V(8); PG8_WAIT_L(0); PG8_BAR; PG8_MMA(1, 0, At, B0); PG8_MMA(1, 1, At, B1); PG8_BAR; PG8_SCHED; } while (0)
    Unit cur, nxt; int ui = 0;
    if (!S.next(0, cur)) return;
    f32x4 acc[2][2][4][2];
#pragma unroll
    for (int a = 0; a < 2; ++a)
#pragma unroll
        for (int b = 0; b < 2; ++b)
#pragma unroll
            for (int m = 0; m < 4; ++m)
#pragma unroll
                for (int n = 0; n < 2; ++n) acc[a][b][m][n] = (f32x4){0.f, 0.f, 0.f, 0.f};
    bf16x8 At[4][2], B0[2][2], B1[2][2]; i32x8 At8[4], B08[2], B18[2];
    unsigned vAc[2][2] = {{0u, 0u}, {0u, 0u}}, vAn[2][2] = {{0u, 0u}, {0u, 0u}};
    if constexpr (GATHER) { PG8_AOFFS(vAn, cur); vAc[1][0] = vAn[1][0]; vAc[1][1] = vAn[1][1]; }
    unsigned cA = cur.aoff, cB = cur.boff, cA2 = cur.aoff2, cB2 = cur.boff2;
#define PG8_KOFF(b1, b2, kt) ((KS != 0 && (kt) >= KS) ? (b2) + (unsigned)((kt) - KS) * kstep : (b1) + (unsigned)(kt) * kstep)
    PG8_STAGE_B(PG8_SB(0, 0), cB); PG8_STAGE_B(PG8_SB(0, 1), cB + hstepB); PG8_STAGE_A(PG8_SA(0, 0), cA, 0, vAn); PG8_STAGE_A(PG8_SA(0, 1), cA, 1, vAn);
    if (wr == 1) PG8_BAR;
    PG8_WAIT_V(2); PG8_BAR;
    PG8_STAGE_B(PG8_SB(1, 0), cB + kstep); PG8_STAGE_A(PG8_SA(1, 0), cA + kstep, 0, vAn); PG8_STAGE_B(PG8_SB(1, 1), cB + hstepB + kstep);
    PG8_WAIT_V(6); PG8_BAR;
    for (;;) {
        const bool has_next = S.next(ui + 1, nxt);
        const unsigned nA = has_next ? nxt.aoff : cA, nB = has_next ? nxt.boff : cB;
#pragma nounroll
        for (int t = 0; t < nt; t += 2) {
            const bool last = (t == nt - 2);
            const unsigned a1 = PG8_KOFF(cA, cA2, t + 1);
            const unsigned a2 = last ? nA : PG8_KOFF(cA, cA2, t + 2), b2 = last ? nB : PG8_KOFF(cB, cB2, t + 2);
            const unsigned a3 = a2 + kstep, b3 = b2 + kstep;
            if constexpr (GATHER) { if (last && has_next) { PG8_AOFFS(vAn, nxt); } }
            if constexpr (KS != 0) { if (t == KS) {
                if constexpr (FP8) asm volatile("s_nop 15\n\ts_nop 15" ::: "memory");
                E.mid(acc, cur, wr, wc, fr, fq); } }
            PG8_TRIP(vAc, vAn);
        }
        if constexpr (ALIGN_EPI) { if (wr == 0) PG8_BAR; }
        if constexpr (FP8) asm volatile("s_nop 15\n\ts_nop 15" ::: "memory");
        E(acc, cur, wr, wc, fr, fq);
        if (!has_next) break;
#pragma unroll
        for (int a = 0; a < 2; ++a)
#pragma unroll
            for (int b = 0; b < 2; ++b)
#pragma unroll
                for (int m = 0; m < 4; ++m)
#pragma unroll
                    for (int n = 0; n < 2; ++n) acc[a][b][m][n] = (f32x4){0.f, 0.f, 0.f, 0.f};
        cur = nxt; cA = nA; cB = nB; cA2 = cur.aoff2; cB2 = cur.boff2; ++ui;
        if constexpr (GATHER) { vAc[1][0] = vAn[1][0]; vAc[1][1] = vAn[1][1]; }
        if constexpr (ALIGN_EPI) { if (wr == 1) PG8_BAR; }
    }
    PG8_WAIT_V(0);
    if constexpr (!ALIGN_EPI) { if (wr == 0) PG8_BAR; }
    PG8_BAR;
#undef PG8_SA
#undef PG8_SB
#undef PG8_STAGE
#undef PG8_STAGE_A
#undef PG8_STAGE_B
#undef PG8_LDA
#undef PG8_LD32
#undef PG8_LDB
#undef PG8_MMA
#undef PG8_WAIT_V
#undef PG8_WAIT_L
#undef PG8_BAR
#undef PG8_SCHED
#undef PG8_AOFFS
#undef PG8_TRIP
#undef PG8_KOFF
    (void)rowA; (void)vAn;
}
#endif

typedef f32x4 Acc[2][2][4][2];
__device__ __forceinline__ u32x4 pack8(const f32x4 v0, const f32x4 v1) { u32x4 w; w.x = cvt_pk_bf16(v0[0], v0[1]); w.y = cvt_pk_bf16(v0[2], v0[3]); w.z = cvt_pk_bf16(v1[0], v1[1]); w.w = cvt_pk_bf16(v1[2], v1[3]); return w; }
__device__ __forceinline__ void unpack8(const u32x4 w, f32x4& v0, f32x4& v1) { v0 = (f32x4){bf_lo(w.x), bf_hi(w.x), bf_lo(w.y), bf_hi(w.y)}; v1 = (f32x4){bf_lo(w.z), bf_hi(w.z), bf_lo(w.w), bf_hi(w.w)}; }

struct EpiProj {
    static constexpr bool PERM = true;
    bf16* UQKV; bf16* Gt; const float* bgate; float mul; int pn_off;
    __device__ __forceinline__ void operator()(const Acc& acc, const Unit& u, int wr, int wc, int fr, int fq) const {
        const int row0 = u.pm * BM + wr * 64 + fr; const int pn = u.pn + pn_off;
        if (pn < 16) {
            bf16* base = UQKV + (size_t)(pn >> 2) * ((size_t)T * 1024) + (pn & 3) * 256 + wc * 32 + 8 * fq;
#pragma unroll
            for (int ai = 0; ai < 2; ++ai)
#pragma unroll
                for (int m = 0; m < 4; ++m) { bf16* rowp = base + (size_t)(row0 + ai * HALF + m * 16) * 1024;
#pragma unroll
                    for (int bj = 0; bj < 2; ++bj) *(u32x4*)(rowp + bj * HALF) = pack8(acc[ai][bj][m][0] * mul, acc[ai][bj][m][1] * mul); }
        } else {
            const int gc = (pn - 16) * 256 + wc * 32 + 8 * fq;
            f32x4 bv[2][2];
#pragma unroll
            for (int bj = 0; bj < 2; ++bj)
#pragma unroll
                for (int n = 0; n < 2; ++n) bv[bj][n] = *(const f32x4*)(bgate + gc + bj * HALF + 4 * n);
#pragma unroll
            for (int ai = 0; ai < 2; ++ai)
#pragma unroll
                for (int m = 0; m < 4; ++m) { unsigned char* rowp = (unsigned char*)Gt + (size_t)(row0 + ai * HALF + m * 16) * 4096 + gc;
#pragma unroll
                    for (int bj = 0; bj < 2; ++bj) { f32x4 v0 = acc[ai][bj][m][0] * mul + bv[bj][0], v1 = acc[ai][bj][m][1] * mul + bv[bj][1];
#pragma unroll
                        for (int j = 0; j < 4; ++j) { v0[j] = sigmoidf_(v0[j]); v1[j] = sigmoidf_(v1[j]); }
                        u32x2 w; w.x = pk4_unorm8(v0); w.y = pk4_unorm8(v1); *(u32x2*)(rowp + bj * HALF) = w; } }
        }
    }
};
struct EpiPool {
    static constexpr bool PERM = true;
    bf16* PO; const float* pscale; int g; unsigned char* PO8;
    __device__ __forceinline__ void operator()(const Acc& acc, const Unit& u, int wr, int wc, int fr, int fq) const {
        const int row0 = u.pm * BM + wr * 64 + fr; const int c0 = g * 256 + wc * 32 + 8 * fq;
        f32x4 sv[2][2];
#pragma unroll
        for (int bj = 0; bj < 2; ++bj)
#pragma unroll
            for (int n = 0; n < 2; ++n) sv[bj][n] = *(const f32x4*)(pscale + c0 + bj * HALF + 4 * n);
#pragma unroll
        for (int ai = 0; ai < 2; ++ai)
#pragma unroll
            for (int m = 0; m < 4; ++m) { const size_t ro = (size_t)(row0 + ai * HALF + m * 16) * 1024 + c0;
#pragma unroll
                for (int bj = 0; bj < 2; ++bj) { const f32x4 v0 = acc[ai][bj][m][0] * sv[bj][0], v1 = acc[ai][bj][m][1] * sv[bj][1];
                    if (PO8) { u32x2 w; w.x = pk4_fp8(v0[0], v0[1], v0[2], v0[3]); w.y = pk4_fp8(v1[0], v1[1], v1[2], v1[3]); *(u32x2*)(PO8 + ro + bj * HALF) = w; }
                    else *(u32x4*)(PO + ro + bj * HALF) = pack8(v0, v1); } }
    }
};
template <bool SECOND> struct EpiBranch {
    static constexpr bool PERM = true;
    bf16* MG; const bf16* Gt;
    __device__ __forceinline__ void operator()(const Acc& acc, const Unit& u, int wr, int wc, int fr, int fq) const {
        const int row0 = u.pm * BM + wr * 64 + fr; const int c0 = u.pn * BM + wc * 32 + 8 * fq;
#pragma unroll
        for (int ai = 0; ai < 2; ++ai)
#pragma unroll
            for (int m = 0; m < 4; ++m) { const size_t row = (size_t)(row0 + ai * HALF + m * 16);
#pragma unroll
                for (int bj = 0; bj < 2; ++bj) {
                    const u32x4 gw = *(const u32x4*)(Gt + row * 4096 + (SECOND ? 2048 : 0) + c0 + bj * HALF);
                    f32x4 g0, g1; unpack8(gw, g0, g1);
                    f32x4 v0 = acc[ai][bj][m][0] * g0, v1 = acc[ai][bj][m][1] * g1;
                    bf16* p = MG + row * 2048 + c0 + bj * HALF;
                    if (SECOND) { const u32x4 ow = *(const u32x4*)p; f32x4 o0, o1; unpack8(ow, o0, o1); v0 += o0; v1 += o1; }
                    *(u32x4*)p = pack8(v0, v1); } }
    }
};
struct EpiBranchRT {
    static constexpr bool PERM = true;
    bf16* MG; const bf16* Gt; unsigned char* MG8; float mul;
    __device__ __forceinline__ void operator()(const Acc& acc, const Unit& u, int wr, int wc, int fr, int fq) const {
        const int row0 = u.pm * BM + wr * 64 + fr; const int c0 = u.pn * BM + wc * 32 + 8 * fq; const bool second = u.ti != 0;
#pragma unroll
        for (int ai = 0; ai < 2; ++ai)
#pragma unroll
            for (int m = 0; m < 4; ++m) { const size_t row = (size_t)(row0 + ai * HALF + m * 16);
#pragma unroll
                for (int bj = 0; bj < 2; ++bj) {
                    const u32x2 gw = *(const u32x2*)((const unsigned char*)Gt + row * 4096 + (second ? 2048 : 0) + c0 + bj * HALF);
                    const f32x4 g0 = unpk4_unorm8(gw.x), g1 = unpk4_unorm8(gw.y);
                    f32x4 v0 = acc[ai][bj][m][0] * mul * g0, v1 = acc[ai][bj][m][1] * mul * g1;
                    bf16* p = MG + row * 2048 + c0 + bj * HALF;
                    if (second) { const u32x4 ow = *(const u32x4*)p; f32x4 o0, o1; unpack8(ow, o0, o1); v0 += o0; v1 += o1; }
                    if (second && MG8) { u32x2 w; w.x = pk4_fp8(v0[0], v0[1], v0[2], v0[3]); w.y = pk4_fp8(v1[0], v1[1], v1[2], v1[3]); *(u32x2*)(MG8 + row * 2048 + c0 + bj * HALF) = w; }
                    else *(u32x4*)p = pack8(v0, v1); } }
    }
};
struct EpiMerge {
    static constexpr bool PERM = true;
    bf16* MG; const unsigned char* G8; unsigned char* MG8; float mul;
    __device__ __forceinline__ void mid(Acc& acc, const Unit& u, int wr, int wc, int fr, int fq) const {
        const unsigned o0 = (unsigned)(u.pm * BM + wr * 64 + fr) * 4096u + (unsigned)(u.pn * BM + wc * 32 + 8 * fq);
#pragma unroll
        for (int am = 0; am < 4; ++am) { const int ai = am >> 1, m0 = (am & 1) * 2;
            u32x2 ga[2][2], gb[2][2];
#pragma unroll
            for (int mm = 0; mm < 2; ++mm) { const unsigned char* gp = G8 + (o0 + (unsigned)((ai * HALF + (m0 + mm) * 16) * 4096));
                ga[mm][0] = *(const u32x2*)(gp); gb[mm][0] = *(const u32x2*)(gp + 2048); ga[mm][1] = *(const u32x2*)(gp + HALF); gb[mm][1] = *(const u32x2*)(gp + 2048 + HALF); }
            __builtin_amdgcn_sched_barrier(0);
#pragma unroll
            for (int mm = 0; mm < 2; ++mm) { const int m = m0 + mm;
#pragma unroll
                for (int bj = 0; bj < 2; ++bj) { const u32x2 a = ga[mm][bj], b = gb[mm][bj];
                    const f32x4 g00 = unpk4_u8(a.x), g01 = unpk4_u8(a.y); f32x4 g10 = unpk4_u8(b.x), g11 = unpk4_u8(b.y);
#pragma unroll
                    for (int j = 0; j < 4; ++j) { acc[ai][bj][m][0][j] *= g00[j] * __builtin_amdgcn_rcpf(fmaxf(g10[j], 1.0f)); acc[ai][bj][m][1][j] *= g01[j] * __builtin_amdgcn_rcpf(fmaxf(g11[j], 1.0f)); } } }
            __builtin_amdgcn_sched_barrier(0);
        }
    }
    __device__ __forceinline__ void operator()(const Acc& acc, const Unit& u, int wr, int wc, int fr, int fq) const {
        const int row0 = u.pm * BM + wr * 64 + fr; const int c0 = u.pn * BM + wc * 32 + 8 * fq;
#pragma unroll
        for (int ai = 0; ai < 2; ++ai)
#pragma unroll
            for (int m = 0; m < 4; ++m) { const size_t row = (size_t)(row0 + ai * HALF + m * 16);
#pragma unroll
                for (int bj = 0; bj < 2; ++bj) { const u32x2 b = *(const u32x2*)(G8 + row * 4096 + 2048 + c0 + bj * HALF);
                    f32x4 g10 = unpk4_unorm8(b.x), g11 = unpk4_unorm8(b.y);
#pragma unroll
                    for (int j = 0; j < 4; ++j) { g10[j] = fmaxf(g10[j], 1.0f / 255.0f) * mul; g11[j] = fmaxf(g11[j], 1.0f / 255.0f) * mul; }
                    const f32x4 v0 = acc[ai][bj][m][0] * g10, v1 = acc[ai][bj][m][1] * g11;
                    if (MG8) { u32x2 w; w.x = pk4_fp8(v0[0], v0[1], v0[2], v0[3]); w.y = pk4_fp8(v1[0], v1[1], v1[2], v1[3]); *(u32x2*)(MG8 + row * 2048 + c0 + bj * HALF) = w; }
                    else *(u32x4*)(MG + row * 2048 + c0 + bj * HALF) = pack8(v0, v1); } }
    }
};
struct EpiOut {
    static constexpr bool PERM = true;
    bf16* DL; const float* gate; float mul;
    __device__ __forceinline__ void operator()(const Acc& acc, const Unit& u, int wr, int wc, int fr, int fq) const {
        const int row0 = u.pm * BM + wr * 64 + fr, c0 = u.pn * BM + wc * 32 + 8 * fq;
        const float* gp = gate + (size_t)(u.pm >> 3) * MODW + c0;
        f32x4 gv[2][2];
#pragma unroll
        for (int bj = 0; bj < 2; ++bj)
#pragma unroll
            for (int n = 0; n < 2; ++n) gv[bj][n] = *(const f32x4*)(gp + bj * HALF + 4 * n) * mul;
#pragma unroll
        for (int ai = 0; ai < 2; ++ai)
#pragma unroll
            for (int m = 0; m < 4; ++m) { bf16* rowp = DL + (size_t)(row0 + ai * HALF + m * 16) * DM + c0;
#pragma unroll
                for (int bj = 0; bj < 2; ++bj) *(u32x4*)(rowp + bj * HALF) = pack8(acc[ai][bj][m][0] * gv[bj][0], acc[ai][bj][m][1] * gv[bj][1]); }
    }
};
struct EpiSwiglu {
    static constexpr bool PERM = true;
    bf16* ACT;
    __device__ __forceinline__ void operator()(const Acc& acc, const Unit& u, int wr, int wc, int fr, int fq) const {
        const int row0 = u.pm * BM + wr * 64 + fr; const int c0 = u.pn * 128 + wc * 32 + 8 * fq;
#pragma unroll
        for (int ai = 0; ai < 2; ++ai)
#pragma unroll
            for (int m = 0; m < 4; ++m) { f32x4 v[2];
#pragma unroll
                for (int n = 0; n < 2; ++n)
#pragma unroll
                    for (int j = 0; j < 4; ++j) { const float a = acc[ai][0][m][n][j]; v[n][j] = a * sigmoidf_(a) * acc[ai][1][m][n][j]; }
                *(u32x4*)(ACT + (size_t)(row0 + ai * HALF + m * 16) * 1024 + c0) = pack8(v[0], v[1]); }
    }
};
struct EpiSwiglu8 {
    static constexpr bool PERM = true;
    unsigned char* ACT8;
    __device__ __forceinline__ void operator()(const Acc& acc, const Unit& u, int wr, int wc, int fr, int fq) const {
        const int row0 = u.pm * BM + wr * 64 + fr; const int c0 = u.pn * 128 + wc * 32 + 8 * fq;
#pragma unroll
        for (int ai = 0; ai < 2; ++ai)
#pragma unroll
            for (int m = 0; m < 4; ++m) { f32x4 v[2];
#pragma unroll
                for (int n = 0; n < 2; ++n)
#pragma unroll
                    for (int j = 0; j < 4; ++j) { const float a = acc[ai][0][m][n][j] * W8_INV; v[n][j] = a * sigmoidf_(a) * (acc[ai][1][m][n][j] * W8_INV); }
                u32x2 w; w.x = pk4_fp8(v[0][0], v[0][1], v[0][2], v[0][3]); w.y = pk4_fp8(v[1][0], v[1][1], v[1][2], v[1][3]);
                *(u32x2*)(ACT8 + (size_t)(row0 + ai * HALF + m * 16) * 1024 + c0) = w; }
    }
};
struct EpiDown {
    static constexpr bool PERM = true;
    bf16* YB; float mul;
    __device__ __forceinline__ void operator()(const Acc& acc, const Unit& u, int wr, int wc, int fr, int fq) const {
        const int row0 = u.pm * BM + wr * 64 + fr; const int c0 = u.pn * BM + wc * 32 + 8 * fq;
#pragma unroll
        for (int ai = 0; ai < 2; ++ai)
#pragma unroll
            for (int m = 0; m < 4; ++m) { bf16* rowp = YB + (size_t)(row0 + ai * HALF + m * 16) * 2048 + c0;
#pragma unroll
                for (int bj = 0; bj < 2; ++bj) { const f32x4 v0 = acc[ai][bj][m][0] * mul, v1 = acc[ai][bj][m][1] * mul;
                    if (YB_FP8) { u32x2 w; w.x = pk4_fp8(v0[0], v0[1], v0[2], v0[3]); w.y = pk4_fp8(v1[0], v1[1], v1[2], v1[3]); *(u32x2*)((unsigned char*)YB + (size_t)(row0 + ai * HALF + m * 16) * 2048 + c0 + bj * HALF) = w; }
                    else *(u32x4*)(rowp + bj * HALF) = pack8(v0, v1); } }
    }
};
}

struct Args { const float* in[20]; float* out; unsigned char* ws; int ph_lo, ph_hi; };
enum { I_X = 0, I_C, I_WADA, I_BADA, I_NMIX, I_NMOE, I_WIN, I_BF, I_WPOOL, I_PSCALE, I_WBR, I_WGATE, I_BGATE, I_WOUT, I_WROUTER, I_BROUTER, I_WEG, I_WEU, I_WED, I_NFINAL };

__device__ __forceinline__ const __attribute__((address_space(4))) char* kernarg_opaque() {
    const __attribute__((address_space(4))) char* kp = (const __attribute__((address_space(4))) char*)__builtin_amdgcn_kernarg_segment_ptr();
    asm volatile("" : "+s"(kp));
    return kp;
}
__device__ __forceinline__ const float* arg_in(int k) { return *(const float* const __attribute__((address_space(4)))*)(kernarg_opaque() + 8 * k); }
__device__ __forceinline__ int arg_i32(int byte_off) { return *(const int __attribute__((address_space(4)))*)(kernarg_opaque() + byte_off); }
#define ARG_IN(k) arg_in(k)
extern __shared__ __attribute__((aligned(16))) unsigned char lds_raw[];
struct Frame {
    LAS unsigned char* lds;
    int tid, lane, wave, vcu, G;
    float* out;
    unsigned char* ws;
};
__device__ __forceinline__ void frame_refresh(Frame& F) {
    F.lds = (LAS unsigned char*)lds_raw;
    F.tid = opaque_tid(); F.lane = F.tid & 63; F.wave = __builtin_amdgcn_readfirstlane(F.tid >> 6);
    F.G = gridDim.x; { const int bx = blockIdx.x; F.vcu = (F.G % 8 == 0) ? (bx % 8) * (F.G / 8) + bx / 8 : bx; }
    F.out = (float*)arg_in(20); F.ws = (unsigned char*)arg_in(21);
}

struct CvtItem { const float* src; bf16* dst; int srcStride, dstK, k0, n0, rowBase, mode, fp8; };
constexpr int CVT_PER_LAYER = 256 + 256 + 8 + 128 + 128 + 1024 + 1024 + 1024;
__device__ __forceinline__ CvtItem cvt_item(const Frame& F, int it) {
    const int l = it / CVT_PER_LAYER; int r = it % CVT_PER_LAYER;
    unsigned char* wl = F.ws + WS_W + (size_t)l * W_LAYER;
    CvtItem c; c.mode = 0; c.rowBase = 0; c.fp8 = 0;
    if (r < 256) { c.src = ARG_IN(I_WIN) + (size_t)l * DM * INW; c.srcStride = INW; c.dst = (bf16*)(wl + WO_PG); c.dstK = DM; c.k0 = 128 * (r >> 4); c.n0 = 256 * (r & 15); c.fp8 = (G1_FP8 == 2); return c; } r -= 256;
    if (r < 256) { c.src = ARG_IN(I_WGATE) + (size_t)l * DM * 4096; c.srcStride = 4096; c.dst = (bf16*)(wl + WO_PG + (G1_FP8 == 1 ? 16 * MiB : 0)); c.dstK = DM; c.k0 = 128 * (r >> 4); c.n0 = 256 * (r & 15); c.rowBase = (G1_FP8 == 1 ? 0 : 4096); c.fp8 = (G1_FP8 >= 1); return c; } r -= 256;
    if (r < 8) { const int g = r >> 1; c.src = ARG_IN(I_WPOOL) + ((size_t)l * 4 + g) * 65536; c.srcStride = 256; c.dst = (bf16*)(wl + WO_POOL) + (size_t)g * 65536; c.dstK = 256; c.k0 = 128 * (r & 1); c.n0 = 0; return c; } r -= 8;
    if (r < 128) { const int n = r >> 6, q = r & 63; c.src = ARG_IN(I_WBR) + ((size_t)l * 2 + n) * 1024 * 2048; c.srcStride = 2048; c.dst = G2_FP8 ? (bf16*)(wl + WO_BR + (size_t)n * 2048 * 1024) : (bf16*)(wl + WO_BR) + (size_t)n * 2048 * 1024; c.dstK = 1024; c.fp8 = G2_FP8; c.k0 = 128 * (q >> 3); c.n0 = 256 * (q & 7); return c; } r -= 128;
    if (r < 128) { c.src = ARG_IN(I_WOUT) + (size_t)l * DM * DM; c.srcStride = DM; c.dst = (bf16*)(wl + WO_OUT); c.dstK = DM; c.k0 = 128 * (r >> 3); c.n0 = 256 * (r & 7); c.fp8 = G3_FP8; return c; } r -= 128;
    if (r < 2048) { const int up = r >= 1024; if (up) r -= 1024; const int e = r >> 6, q = r & 63;
        c.src = (up ? ARG_IN(I_WEU) : ARG_IN(I_WEG)) + ((size_t)l * NE + e) * DM * DE; c.srcStride = DE; c.dst = MOE_FP8 ? (bf16*)(wl + WO_GU + (size_t)e * 2048 * 2048) : (bf16*)(wl + WO_GU) + (size_t)e * 2048 * 2048; c.dstK = DM; c.fp8 = MOE_FP8; c.k0 = 128 * (q >> 2); c.n0 = 256 * (q & 3); c.mode = up ? 2 : 1; return c; } r -= 2048;
    { const int e = r >> 6, q = r & 63; c.src = ARG_IN(I_WED) + ((size_t)l * NE + e) * DE * DM; c.srcStride = DM; c.dst = MOE_FP8 ? (bf16*)(wl + WO_D + (size_t)e * 2048 * 1024) : (bf16*)(wl + WO_D) + (size_t)e * 2048 * 1024; c.dstK = DE; c.fp8 = MOE_FP8; c.k0 = 128 * (q >> 3); c.n0 = 256 * (q & 7); return c; }
}
__device__ __forceinline__ void cvt_load(const CvtItem& c, int wave, int lane, f32x4 (&v)[16]) {
    const float* p = c.src + (size_t)(c.k0 + wave * 16) * c.srcStride + c.n0 + 4 * lane;
#pragma unroll
    for (int j = 0; j < 16; ++j) v[j] = __builtin_nontemporal_load((const f32x4*)(p + (size_t)j * c.srcStride));
}
__device__ __forceinline__ void p0_mod_task(Frame& F, int q, const LAS float* cact) {
    const int ks = q & 3, cgq = q >> 2, l = cgq / 192, col0 = (cgq % 192) * 64, kq = F.lane >> 4, cl = (F.lane & 15) * 4;
    const int kbase = ks * 512;
    const float* wp = ARG_IN(I_WADA) + ((size_t)l * DM + kbase + kq) * MODW + col0 + cl;
    f32x4 acc[8];
#pragma unroll
    for (int b = 0; b < 8; ++b) acc[b] = (f32x4){0.f, 0.f, 0.f, 0.f};
    for (int i0 = 0; i0 < 128; i0 += 8) {
        f32x4 w[8];
#pragma unroll
        for (int j = 0; j < 8; ++j) w[j] = __builtin_nontemporal_load((const f32x4*)(wp + (size_t)(4 * (i0 + j)) * MODW));
#pragma unroll
        for (int j = 0; j < 8; ++j) { const int k = kbase + 4 * (i0 + j) + kq; const f32x4 c0 = *(const LAS f32x4*)(cact + k * 8), c1 = *(const LAS f32x4*)(cact + k * 8 + 4);
#pragma unroll
            for (int b = 0; b < 4; ++b) { acc[b] += c0[b] * w[j]; acc[4 + b] += c1[b] * w[j]; } }
    }
#pragma unroll
    for (int b = 0; b < 8; ++b)
#pragma unroll
        for (int j = 0; j < 4; ++j) { float v = acc[b][j]; v += __shfl_xor(v, 16); v += __shfl_xor(v, 32); acc[b][j] = v; }
    if (kq == 0) {
        f32x4 bv = (f32x4){0.f, 0.f, 0.f, 0.f};
        if (ks == 0) bv = *(const f32x4*)(ARG_IN(I_BADA) + (size_t)l * MODW + col0 + cl);
        float* mp = (float*)(F.ws + WS_MODP) + ((size_t)ks * 2 + l) * 8 * MODW + col0 + cl;
#pragma unroll
        for (int b = 0; b < 8; ++b) *(f32x4*)(mp + (size_t)b * MODW) = acc[b] + bv;
    }
}
__device__ __forceinline__ f32x4 modp_sum(const float* modp, size_t idx) {
    constexpr size_t Q = (size_t)2 * 8 * MODW;
    const f32x4 a = *(const f32x4*)(modp + idx), b = *(const f32x4*)(modp + Q + idx), c = *(const f32x4*)(modp + 2 * Q + idx), d = *(const f32x4*)(modp + 3 * Q + idx);
    return ((a + b) + c) + d;
}
__device__ __forceinline__ void cvt_to_lds(const CvtItem& c, const f32x4 (&v)[16], LAS unsigned char* tile, int wave, int lane) {
    if (c.fp8) {
#pragma unroll
        for (int i = 0; i < 4; ++i) { u32x4 w;
            w.x = pk4_fp8(v[0][i] * W8_SCALE, v[1][i] * W8_SCALE, v[2][i] * W8_SCALE, v[3][i] * W8_SCALE); w.y = pk4_fp8(v[4][i] * W8_SCALE, v[5][i] * W8_SCALE, v[6][i] * W8_SCALE, v[7][i] * W8_SCALE);
            w.z = pk4_fp8(v[8][i] * W8_SCALE, v[9][i] * W8_SCALE, v[10][i] * W8_SCALE, v[11][i] * W8_SCALE); w.w = pk4_fp8(v[12][i] * W8_SCALE, v[13][i] * W8_SCALE, v[14][i] * W8_SCALE, v[15][i] * W8_SCALE);
            *(LAS u32x4*)(tile + (4 * lane + i) * 144 + wave * 16) = w; }
    } else {
#pragma unroll
        for (int i = 0; i < 4; ++i)
#pragma unroll
            for (int o = 0; o < 2; ++o) { u32x4 w; w.x = cvt_pk_bf16(v[8 * o + 0][i], v[8 * o + 1][i]); w.y = cvt_pk_bf16(v[8 * o + 2][i], v[8 * o + 3][i]); w.z = cvt_pk_bf16(v[8 * o + 4][i], v[8 * o + 5][i]); w.w = cvt_pk_bf16(v[8 * o + 6][i], v[8 * o + 7][i]);
                *(LAS u32x4*)(tile + (4 * lane + i) * 272 + (wave * 16 + 8 * o) * 2) = w; }
    }
}
__device__ __forceinline__ void cvt_store(const CvtItem& cc, const LAS unsigned char* tile, int tid) {
    if (cc.fp8) {
#pragma unroll
        for (int qq = 0; qq < 4; ++qq) { const int ch = tid + 512 * qq, nn = ch >> 3, c16 = ch & 7; const int n = cc.n0 + nn;
            const int drow = cc.mode == 0 ? cc.rowBase + n : 256 * (n >> 7) + (n & 127) + (cc.mode == 2 ? 128 : 0);
            const u32x4 w = *(const LAS u32x4*)(tile + nn * 144 + c16 * 16);
            *(u32x4*)((unsigned char*)cc.dst + (size_t)drow * cc.dstK + cc.k0 + c16 * 16) = w; }
    } else {
#pragma unroll
        for (int qq = 0; qq < 8; ++qq) { const int ch = tid + 512 * qq, nn = ch >> 4, c16 = ch & 15; const int n = cc.n0 + nn;
            const int drow = cc.mode == 0 ? cc.rowBase + n : 256 * (n >> 7) + (n & 127) + (cc.mode == 2 ? 128 : 0);
            const u32x4 w = *(const LAS u32x4*)(tile + nn * 272 + c16 * 16);
            *(u32x4*)(cc.dst + (size_t)drow * cc.dstK + cc.k0 + c16 * 8) = w; }
    }
}
#ifndef Q_A
#define Q_A 1152
#endif
#ifndef Q_1
#define Q_1 768
#endif
constexpr int Q_B = 1024, Q_COUNT = Q_A + Q_B, Q_FIRST = 2 * CVT_PER_LAYER - Q_COUNT, CW_QUEUE = 12800;
__device__ __forceinline__ void cvt_queue_drain(Frame& F, int which, int first, int count) {
    LAS unsigned char* tile = F.lds;
    volatile LAS int* slot = (volatile LAS int*)(F.lds + X_MISC) + 60;
    unsigned* q = (unsigned*)(F.ws + WS_CTL) + CW_QUEUE + 64 * which;
    __syncthreads();
    int t_next = 0;
    if (F.tid == 0) { const int ta = (int)__hip_atomic_fetch_add(q, 1u, __ATOMIC_RELAXED, __HIP_MEMORY_SCOPE_AGENT); t_next = (int)__hip_atomic_fetch_add(q, 1u, __ATOMIC_RELAXED, __HIP_MEMORY_SCOPE_AGENT); slot[0] = ta < count ? ta : -1; }
    __syncthreads();
    int qi = __builtin_amdgcn_readfirstlane(slot[0]);
    f32x4 v[16];
    CvtItem c = cvt_item(F, first + (qi >= 0 ? qi : 0));
    if (qi >= 0) cvt_load(c, F.wave, F.lane, v);
    while (qi >= 0) {
        if (F.tid == 0) { slot[0] = t_next < count ? t_next : -1; t_next = (int)__hip_atomic_fetch_add(q, 1u, __ATOMIC_RELAXED, __HIP_MEMORY_SCOPE_AGENT); }
        cvt_to_lds(c, v, tile, F.wave, F.lane);
        __syncthreads();
        const CvtItem cc = c;
        const int nq = __builtin_amdgcn_readfirstlane(slot[0]);
        if (nq >= 0) { c = cvt_item(F, first + nq); cvt_load(c, F.wave, F.lane, v); }
        cvt_store(cc, tile, F.tid);
        __syncthreads();
        qi = nq;
    }
}
__device__ __forceinline__ void p0_prologue(Frame& F) {
    LAS float* cact = (LAS float*)(F.lds);
    LAS unsigned char* tile = F.lds + 65536;
    {   const float* cin = ARG_IN(I_C);
#pragma unroll
        for (int h = 0; h < 2; ++h) { float cv[16];
#pragma unroll
            for (int k = 0; k < 16; ++k) cv[k] = cin[F.tid + (h * 16 + k) * NTHREADS];
            __builtin_amdgcn_sched_barrier(0);
#pragma unroll
            for (int k = 0; k < 16; ++k) { const int i = F.tid + (h * 16 + k) * NTHREADS, b = i / DM, kk = i % DM; cact[kk * 8 + b] = cv[k] * sigmoidf_(cv[k]); }
            __builtin_amdgcn_sched_barrier(0); } }
    __syncthreads();
    { const int q = F.wave * F.G + F.vcu; if (q < 1536) p0_mod_task(F, q, cact); }
    constexpr int NITEMS = Q_FIRST;
    int it = F.vcu;
    f32x4 v[16];
    CvtItem c = cvt_item(F, it < NITEMS ? it : 0);
    if (it < NITEMS) cvt_load(c, F.wave, F.lane, v);
    while (it < NITEMS) {
        cvt_to_lds(c, v, tile, F.wave, F.lane);
        __syncthreads();
        const CvtItem cc = c;
        const int nit = it + F.G;
        if (nit < NITEMS) { c = cvt_item(F, nit); cvt_load(c, F.wave, F.lane, v); }
        cvt_store(cc, tile, F.tid);
        __syncthreads();
        it = nit;
    }
}

__device__ __forceinline__ void load_expert_tables(Frame& F, int lc) {
    volatile LAS int* misc = (volatile LAS int*)(F.lds + X_MISC);
    if (F.tid < 16) {
        const int c = (int)__hip_atomic_load((unsigned*)(F.ws + WS_CTL) + CW_CNT + (lc * 16 + F.tid) * 64, RLX_AGENT);
        misc[32 + F.tid] = c;
        const int v = (c + 255) >> 8; int incl = v;
#pragma unroll
        for (int o = 1; o < 16; o <<= 1) { const int nb = __shfl_up(incl, o); if (F.tid >= o) incl += nb; }
        misc[8 + F.tid] = incl - v;
        if (F.tid == 15) misc[24] = incl;
    }
    __syncthreads();
}
template <int MODE, bool COMBINE, bool DRY = false>
__device__ __forceinline__ void rows_phase(Frame& F, int l, bool prefilled = false) {
    const int lane = F.lane;
    float* out = F.out;
    const bool xf32 = (MODE == 0 && !COMBINE) || (MODE == 1 && l == 0);
    const float* xin = ARG_IN(I_X); bf16* XB = (bf16*)(F.ws + WS_XB);
    const float* mod = (const float*)(F.ws + WS_MOD);
    bf16* H = (bf16*)(F.ws + WS_H);
    const int lprev = (MODE == 2) ? DEPTH - 1 : l - 1;
    if (COMBINE && !MK_ONE_LAUNCH) load_expert_tables(F, lprev);
    volatile LAS int* misc = (volatile LAS int*)(F.lds + X_MISC);
    if (MODE == 0 && !prefilled) {
        LAS f32x4* wf = (LAS f32x4*)F.lds; const float* src = ARG_IN(I_WIN) + (size_t)l * DM * INW + 4096;
#pragma unroll 8
        for (int i = F.tid; i < DM * 2; i += NTHREADS) { const int c = i >> 1, g = i & 1; wf[((g * 4 + (c & 3)) * 8 + (c >> 8)) * 64 + ((c >> 2) & 63)] = *(const f32x4*)(src + (size_t)c * INW + g * 4); }
    }
    if (MODE == 1 && !prefilled) {
        LAS f32x4* wr = (LAS f32x4*)F.lds; const f32x4* src = (const f32x4*)ARG_IN(I_WROUTER);
        f32x4 tv[16];
#pragma unroll
        for (int k = 0; k < 16; ++k) tv[k] = src[F.tid + k * NTHREADS];
        __builtin_amdgcn_sched_barrier(0);
#pragma unroll
        for (int k = 0; k < 16; ++k) { const int i = F.tid + k * NTHREADS, c = i >> 2, g = i & 3; wr[((g * 4 + (c & 3)) * 8 + (c >> 8)) * 64 + ((c >> 2) & 63)] = tv[k]; }
    }
    __syncthreads();
    const int ntask = T / 8;
    constexpr bool FIRST = (MODE == 0 && !COMBINE);
    const float* modp = (const float*)(F.ws + WS_MODP);
    if (FIRST) {
        for (int wt = F.vcu * NWAVES + F.wave; wt < 2048; wt += F.G * NWAVES)
            if (lane < 24) { const size_t idx = (size_t)wt * 96 + 4 * lane; *(f32x4*)((float*)(F.ws + WS_MOD) + idx) = modp_sum(modp, idx); }
    }
    for (int wt = F.vcu * NWAVES + F.wave; wt < ntask; wt += F.G * NWAVES) {
        const int row0 = wt * 8, b = row0 / SEQ;
        f32x4 A[8], Sh[8], Gm[8];
        {
            const float* nrm = (MODE == 0) ? ARG_IN(I_NMIX) + (size_t)l * DM : (MODE == 1) ? ARG_IN(I_NMOE) + (size_t)l * DM : ARG_IN(I_NFINAL);
            const float* mb = mod + ((size_t)(MODE == 2 ? 0 : l) * 8 + b) * MODW;
#pragma unroll
            for (int j = 0; j < 8; ++j) { const int c = 256 * j + 4 * lane; const f32x4 g = *(const f32x4*)(nrm + c);
                if (MODE == 2) { A[j] = g; Sh[j] = (f32x4){0.f, 0.f, 0.f, 0.f}; }
                else if (FIRST) { const size_t mi = (size_t)b * MODW + c; const f32x4 sc = modp_sum(modp, mi + DM); Sh[j] = modp_sum(modp, mi); A[j] = g * (1.0f + sc); }
                else { const f32x4 sc = *(const f32x4*)(mb + (MODE == 0 ? 1 : 4) * DM + c); Sh[j] = *(const f32x4*)(mb + (MODE == 0 ? 0 : 3) * DM + c); A[j] = g * (1.0f + sc); }
                if (COMBINE) Gm[j] = *(const f32x4*)(mod + ((size_t)lprev * 8 + b) * MODW + 5 * DM + c); }
        }
        int te_l = 0, tp_l = 0; float tw_l = 0.f;
        if (COMBINE) { if (lane < 16) { te_l = ((const int*)(F.ws + WS_TOKE))[row0 * 2 + lane]; tw_l = ((const float*)(F.ws + WS_TOKW))[row0 * 2 + lane]; tp_l = ((const int*)(F.ws + WS_TOKP))[row0 * 2 + lane]; } }
        for (int r = 0; r < 8; ++r) {
            const int row = row0 + r;
            f32x4 x[8];
#pragma unroll
            for (int j = 0; j < 8; ++j) {
                if (xf32) x[j] = __builtin_nontemporal_load((const f32x4*)(xin + (size_t)row * DM + 256 * j + 4 * lane));
                else { const u32x2 p = __builtin_nontemporal_load((const u32x2*)(XB + (size_t)row * DM + 256 * j + 4 * lane)); x[j] = (f32x4){bf_lo(p.x), bf_hi(p.x), bf_lo(p.y), bf_hi(p.y)}; } }
            if (COMBINE) {
                const int e0 = __builtin_amdgcn_readlane(te_l, 2 * r), e1 = __builtin_amdgcn_readlane(te_l, 2 * r + 1);
                const float w0 = __int_as_float(__builtin_amdgcn_readlane(__float_as_int(tw_l), 2 * r)), w1 = __int_as_float(__builtin_amdgcn_readlane(__float_as_int(tw_l), 2 * r + 1));
                const size_t s0 = (size_t)misc[8 + e0] * 256 + __builtin_amdgcn_readlane(tp_l, 2 * r), s1 = (size_t)misc[8 + e1] * 256 + __builtin_amdgcn_readlane(tp_l, 2 * r + 1);
                const bf16* y0p = (const bf16*)(F.ws + WS_YB) + s0 * 2048; const bf16* y1p = (const bf16*)(F.ws + WS_YB) + s1 * 2048;
                unsigned yq0[8], yq1[8];
                if (YB_FP8) {
#pragma unroll
                    for (int j = 0; j < 8; ++j) { yq0[j] = __builtin_nontemporal_load((const unsigned*)((const unsigned char*)(F.ws + WS_YB) + s0 * 2048 + 256 * j + 4 * lane)); yq1[j] = __builtin_nontemporal_load((const unsigned*)((const unsigned char*)(F.ws + WS_YB) + s1 * 2048 + 256 * j + 4 * lane)); }
                    __builtin_amdgcn_sched_barrier(0);
                }
#pragma unroll
                for (int j = 0; j < 8; ++j) { f32x4 y0, y1;
                    if (YB_FP8) { y0 = unpk4_fp8(yq0[j]); y1 = unpk4_fp8(yq1[j]); }
                    else { const u32x2 p0 = *(const u32x2*)(y0p + 256 * j + 4 * lane), p1 = *(const u32x2*)(y1p + 256 * j + 4 * lane);
                        y0 = (f32x4){bf_lo(p0.x), bf_hi(p0.x), bf_lo(p0.y), bf_hi(p0.y)}; y1 = (f32x4){bf_lo(p1.x), bf_hi(p1.x), bf_lo(p1.y), bf_hi(p1.y)}; }
                    x[j] += Gm[j] * (w0 * y0 + w1 * y1); }
                if (MODE != 2) {
#pragma unroll
                    for (int j = 0; j < 8; ++j) { u32x2 w; w.x = cvt_pk_bf16(x[j].x, x[j].y); w.y = cvt_pk_bf16(x[j].z, x[j].w); *(u32x2*)(XB + (size_t)row * DM + 256 * j + 4 * lane) = w; }
                }
            }
            if (MODE == 1) {
                const bf16* dl = (const bf16*)(F.ws + WS_DL) + (size_t)row * DM;
#pragma unroll
                for (int j = 0; j < 8; ++j) { const u32x2 p = __builtin_nontemporal_load((const u32x2*)(dl + 256 * j + 4 * lane)); x[j] += (f32x4){bf_lo(p.x), bf_hi(p.x), bf_lo(p.y), bf_hi(p.y)}; }
#pragma unroll
                for (int j = 0; j < 8; ++j) { u32x2 w; w.x = cvt_pk_bf16(x[j].x, x[j].y); w.y = cvt_pk_bf16(x[j].z, x[j].w); *(u32x2*)(XB + (size_t)row * DM + 256 * j + 4 * lane) = w; }
            }
            float ss = 0.f;
#pragma unroll
            for (int j = 0; j < 8; ++j) ss += (x[j].x * x[j].x + x[j].y * x[j].y) + (x[j].z * x[j].z + x[j].w * x[j].w);
            const float rstd = 1.0f / sqrtf(wave_sum_u(ss) * (1.0f / DM) + EPS);
#pragma unroll
            for (int j = 0; j < 8; ++j) x[j] = x[j] * rstd * A[j] + Sh[j];
            if (MODE == 2) {
#pragma unroll
                for (int j = 0; j < 8; ++j) __builtin_nontemporal_store(x[j], (f32x4*)(out + (size_t)row * DM + 256 * j + 4 * lane));
                continue;
            }
#pragma unroll
            for (int j = 0; j < 8; ++j) {
                constexpr bool W8 = (MODE == 1 && MOE_FP8) || (MODE == 0 && G1_FP8 >= 1), W16 = (MODE == 1 && !MOE_FP8) || (MODE == 0 && G1_FP8 != 2);
                if (W8) *(unsigned*)(F.ws + WS_H8 + (size_t)row * DM + 256 * j + 4 * lane) = pk4_fp8(x[j].x, x[j].y, x[j].z, x[j].w);
                if (W16) { u32x2 w; w.x = cvt_pk_bf16(x[j].x, x[j].y); w.y = cvt_pk_bf16(x[j].z, x[j].w); *(u32x2*)(H + (size_t)row * DM + 256 * j + 4 * lane) = w; } }
            if (MODE == 0) {
                const LAS float* wf = (const LAS float*)F.lds;
                float fl[8];
#pragma unroll
                for (int q = 0; q < 8; ++q) fl[q] = 0.f;
#pragma unroll
                for (int j = 0; j < 8; ++j)
#pragma unroll
                    for (int i = 0; i < 4; ++i) { const f32x4 w0 = *((const LAS f32x4*)wf + ((0 * 4 + i) * 8 + j) * 64 + lane), w1 = *((const LAS f32x4*)wf + ((1 * 4 + i) * 8 + j) * 64 + lane); const float xv = x[j][i];
#pragma unroll
                        for (int q = 0; q < 4; ++q) { fl[q] += xv * w0[q]; fl[4 + q] += xv * w1[q]; }
                        if (i == 3) asm volatile("" ::: "memory"); }
#pragma unroll
                for (int q = 0; q < 8; ++q) fl[q] = wave_sum_u(fl[q]);
                if (lane < 8) { float z = 0.f;
#pragma unroll
                    for (int q = 0; q < 8; ++q) z = (lane == q) ? fl[q] : z;
                    z += ARG_IN(I_BF)[l * 8 + lane];
                    const float ls = fminf(z, 0.f) - log1pf(expf(-fabsf(z)));
                    ((float*)(F.ws + WS_LS))[(size_t)row * 8 + lane] = ls; }
            }
            if (MODE == 1) {
                const LAS float* wr = (const LAS float*)F.lds;
                float lg[16];
#pragma unroll
                for (int q = 0; q < 16; ++q) lg[q] = 0.f;
#pragma unroll
                for (int j = 0; j < 8; ++j)
#pragma unroll
                    for (int i = 0; i < 4; ++i) { const float xv = x[j][i];
#pragma unroll
                        for (int q4 = 0; q4 < 4; ++q4) { const f32x4 w = *((const LAS f32x4*)wr + ((q4 * 4 + i) * 8 + j) * 64 + lane);
#pragma unroll
                            for (int q = 0; q < 4; ++q) lg[4 * q4 + q] += xv * w[q]; }
                        if (i == 3) asm volatile("" ::: "memory"); }
#pragma unroll
                for (int q = 0; q < 16; ++q) lg[q] = wave_sum_u(lg[q]);
                float mx = lg[0];
#pragma unroll
                for (int q = 1; q < 16; ++q) mx = fmaxf(mx, lg[q]);
                float pr[16], se = 0.f;
#pragma unroll
                for (int q = 0; q < 16; ++q) { pr[q] = expf(lg[q] - mx); se += pr[q]; }
                const float inv = 1.0f / se;
                float sel[16];
#pragma unroll
                for (int q = 0; q < 16; ++q) { pr[q] *= inv; sel[q] = pr[q] + ARG_IN(I_BROUTER)[q]; }
                float bestS = -3.0e38f; int be0 = 0, be1 = 1;
#pragma unroll
                for (int g = 0; g < 4; ++g) {
                    float v1 = sel[4 * g]; int i1 = 0;
#pragma unroll
                    for (int i = 1; i < 4; ++i) if (sel[4 * g + i] > v1) { v1 = sel[4 * g + i]; i1 = i; }
                    float v2 = -3.0e38f; int i2 = 0;
#pragma unroll
                    for (int i = 0; i < 4; ++i) if (i != i1 && sel[4 * g + i] > v2) { v2 = sel[4 * g + i]; i2 = i; }
                    const float sc = v1 + v2;
                    if (sc > bestS) { bestS = sc; be0 = 4 * g + i1; be1 = 4 * g + i2; }
                }
                float p0 = 0.f, p1 = 0.f;
#pragma unroll
                for (int q = 0; q < 16; ++q) { p0 = (q == be0) ? pr[q] : p0; p1 = (q == be1) ? pr[q] : p1; }
                const float gs = 1.0f / (p0 + p1);
                if (lane == 0) {
                    int* te = (int*)(F.ws + WS_TOKE) + row * 2; float* tw = (float*)(F.ws + WS_TOKW) + row * 2;
                    te[0] = be0; te[1] = be1; tw[0] = p0 * gs; tw[1] = p1 * gs;
                    volatile LAS int* asg = (volatile LAS int*)(F.lds + X_ASG);
                    asg[(F.wave * 8 + r) * 2] = be0; asg[(F.wave * 8 + r) * 2 + 1] = be1;
                }
            }
        }
        if (MODE == 1) {
            __syncthreads();
            if (!DRY) {
                volatile LAS int* asg = (volatile LAS int*)(F.lds + X_ASG);
                const int a0 = asg[lane], a1 = asg[64 + lane];
                const int eA = F.wave * 2, eB = eA + 1;
                const unsigned long long mA0 = __ballot(a0 == eA), mA1 = __ballot(a1 == eA), mB0 = __ballot(a0 == eB), mB1 = __ballot(a1 == eB);
                const int nA0 = __popcll(mA0), nA = nA0 + __popcll(mA1), nB0 = __popcll(mB0), nB = nB0 + __popcll(mB1);
                unsigned base_l = 0u;
                if (lane < 2) { const int nn = lane ? nB : nA; if (nn) base_l = __hip_atomic_fetch_add((unsigned*)(F.ws + WS_CTL) + CW_CNT + (l * 16 + eA + lane) * 64, (unsigned)nn, RLX_AGENT); }
                const unsigned baseA = (unsigned)__builtin_amdgcn_readlane((int)base_l, 0), baseB = (unsigned)__builtin_amdgcn_readlane((int)base_l, 1);
                const unsigned long long lt = (1ull << lane) - 1ull;
                const int blk_row0 = (wt - F.wave) * 8;
                int* list = (int*)(F.ws + WS_LIST); int* tp = (int*)(F.ws + WS_TOKP);
                if (a0 == eA || a0 == eB) { const bool isA = a0 == eA; const unsigned slot = isA ? baseA + (unsigned)__popcll(mA0 & lt) : baseB + (unsigned)__popcll(mB0 & lt);
                    const int row = blk_row0 + (lane >> 1); list[(isA ? eA : eB) * LIST_CAP + slot] = row; tp[row * 2 + (lane & 1)] = (int)slot; }
                if (a1 == eA || a1 == eB) { const bool isA = a1 == eA; const unsigned slot = isA ? baseA + (unsigned)nA0 + (unsigned)__popcll(mA1 & lt) : baseB + (unsigned)nB0 + (unsigned)__popcll(mB1 & lt);
                    const int row = blk_row0 + 32 + (lane >> 1); list[(isA ? eA : eB) * LIST_CAP + slot] = row; tp[row * 2 + (lane & 1)] = (int)slot; }
            }
            __syncthreads();
        }
    }
}

template <int W>
__device__ __forceinline__ void pool_tile_w(Frame& F, int pm, int g, int half) {
    const bf16* U = (const bf16*)(F.ws + WS_U); bf16* PL = (bf16*)(F.ws + WS_PL);
    const int cc = F.tid & 31, rg = F.tid >> 5;
    const int col = g * 256 + cc * 8 + half * 4;
    const int r0 = pm * 256 + rg * 16, t0 = r0 % SEQ;
    u32x2 cur[16], prv[W - 1];
#pragma unroll
    for (int r = 0; r < 16; ++r) cur[r] = *(const u32x2*)(U + (size_t)(r0 + r) * 1024 + col);
#pragma unroll
    for (int j = 1; j < W; ++j) { const bool ok = t0 - j >= 0; const u32x2 v = *(const u32x2*)(U + (size_t)(ok ? r0 - j : r0) * 1024 + col); prv[j - 1] = ok ? v : (u32x2){0u, 0u}; }
    __builtin_amdgcn_sched_barrier(0);
    f32x4 s = {0.f, 0.f, 0.f, 0.f};
#pragma unroll
    for (int j = 1; j < W; ++j) s += (f32x4){bf_lo(prv[j - 1].x), bf_hi(prv[j - 1].x), bf_lo(prv[j - 1].y), bf_hi(prv[j - 1].y)};
#pragma unroll
    for (int r = 0; r < 16; ++r) {
        const int t = t0 + r; const f32x4 a = {bf_lo(cur[r].x), bf_hi(cur[r].x), bf_lo(cur[r].y), bf_hi(cur[r].y)};
        s += a;
        const float inv = 1.0f / (float)(t + 1 < W ? t + 1 : W);
        const f32x4 o = s * inv - a;
        u32x2 w; w.x = cvt_pk_bf16(o[0], o[1]); w.y = cvt_pk_bf16(o[2], o[3]);
        *(u32x2*)(PL + (size_t)(r0 + r) * 1024 + col) = w;
        {
            const u32x2 q = r - W + 1 >= 0 ? cur[r - W + 1 >= 0 ? r - W + 1 : 0] : prv[r - W + 1 >= 0 ? 0 : W - 2 - r];
            s -= (f32x4){bf_lo(q.x), bf_hi(q.x), bf_lo(q.y), bf_hi(q.y)}; }
    }
}
__device__ __forceinline__ void pool_tile(Frame& F, int pm, int g) {
    if (g == 0) { pool_tile_w<2>(F, pm, g, 0); pool_tile_w<2>(F, pm, g, 1); }
    else if (g == 1) { pool_tile_w<4>(F, pm, g, 0); pool_tile_w<4>(F, pm, g, 1); }
    else if (g == 2) { pool_tile_w<8>(F, pm, g, 0); pool_tile_w<8>(F, pm, g, 1); }
    else { pool_tile_w<16>(F, pm, g, 0); pool_tile_w<16>(F, pm, g, 1); }
}

__device__ __forceinline__ void forget_cumsum(Frame& F, int b, int h, LAS float* Fl, LAS float* tmp, const float L2E, const LAS float* staged = nullptr) {
    const float* LS = (const float*)(F.ws + WS_LS) + (size_t)b * SEQ * 8 + h;
    const int t4 = F.tid * 4;
    float v0, v1, v2, v3;
    if (staged) { const f32x4 q = *(const LAS f32x4*)(staged + t4); v0 = q.x; v1 = q.y; v2 = q.z; v3 = q.w; }
    else { v0 = LS[(size_t)(t4 + 0) * 8]; v1 = LS[(size_t)(t4 + 1) * 8]; v2 = LS[(size_t)(t4 + 2) * 8]; v3 = LS[(size_t)(t4 + 3) * 8]; }
    v1 += v0; v2 += v1; v3 += v2;
    float tot = v3;
#pragma unroll
    for (int o = 1; o < 64; o <<= 1) { const float n = __shfl_up(tot, o); if (F.lane >= o) tot += n; }
    if (F.lane == 63) tmp[F.wave] = tot;
    __syncthreads();
    float off = 0.f;
    for (int w = 0; w < F.wave; ++w) off += tmp[w];
    const float base = off + tot - v3;
    *(LAS f32x4*)(Fl + t4) = (f32x4){(base + v0) * L2E, (base + v1) * L2E, (base + v2) * L2E, (base + v3) * L2E};
    __syncthreads();
}

#if ATTN_FAST
namespace att {
constexpr int D = 128, LD = 1024, NW = 8, QBLK = 32, KVBLK = 64, QB = NW * QBLK;
constexpr int SHM_V = KVBLK * D * 2, SHM_K = KVBLK * D * 2;
constexpr int OFF_WS = 2 * SHM_V + 2 * SHM_K;
constexpr int OFF_FN = OFF_WS + NW * 64 * 4;
constexpr int OFF_TMP = OFF_FN + 2048 * 4;
constexpr float SCALE = 0.08838834764831845f, C2 = 1.4426950408889634f * SCALE, THR = 8.f;
typedef short s16x4 __attribute__((ext_vector_type(4)));
typedef float f32x16 __attribute__((ext_vector_type(16)));
#define KSWZ(row, colB) ((row) * 256 + ((colB) ^ (((row) & 7) << 4)))
#define SBAR() __builtin_amdgcn_sched_barrier(0)
__device__ __forceinline__ int v_st(int k, int c) { const int kk = (k & ~0xC) | ((k & 4) << 1) | ((k & 8) >> 1); return ((kk >> 3) * 4 + (c >> 5)) * 512 + ((kk & 7) * 32 + (c & 31)) * 2; }
__device__ __forceinline__ int v_rd_base(int lane) { return ((lane & 3) << 3) | (((lane >> 2) & 3) << 6) | (((lane >> 4) & 1) << 5) | (((lane >> 5) & 1) << 8); }
constexpr int v_rd_off(int d0, int ks, int half) { return d0 * 512 + ks * 4096 + half * 2048; }
__device__ __forceinline__ int crow(int r, int hi) { return (r & 3) + 8 * (r >> 2) + 4 * hi; }
__device__ __forceinline__ unsigned cvtpk(float lo, float hi) { return cvt_pk_bf16(lo, hi); }
__device__ __forceinline__ bf16x8 load8(const bf16* p) { return *reinterpret_cast<const bf16x8*>(p); }
__device__ __forceinline__ void mask_tile(f32x16& p0, f32x16& p1, int dq) {
    const float NEG = -__builtin_inff();
#pragma unroll
    for (int r = 0; r < 16; ++r) { const int c = (r & 3) + 8 * (r >> 2); if (dq - c < 0) p0[r] = NEG; if (dq - c - 32 < 0) p1[r] = NEG; }
}
__device__ __forceinline__ void partialSM(f32x16& p0, f32x16& p1, float& m_reg, float& mn, float& alpha) {
    float pmax = p0[0]; for (int r = 1; r < 16; ++r) pmax = fmaxf(pmax, p0[r]); for (int r = 0; r < 16; ++r) pmax = fmaxf(pmax, p1[r]);
    { auto rr = __builtin_amdgcn_permlane32_swap(__float_as_uint(pmax), __float_as_uint(pmax), false, false);
      pmax = fmaxf(__uint_as_float(rr[0]), __uint_as_float(rr[1])); }
    if (__builtin_expect(__all((pmax - m_reg) * SCALE <= THR), 1)) { mn = m_reg; alpha = 1.f; }
    else { mn = fmaxf(m_reg, pmax); alpha = __builtin_amdgcn_exp2f((m_reg - mn) * C2); m_reg = mn; }
    const float mnL = -mn * C2;
    for (int r = 0; r < 16; ++r) p0[r] = fmaf(p0[r], C2, mnL); for (int r = 0; r < 16; ++r) p1[r] = fmaf(p1[r], C2, mnL);
    for (int r = 0; r < 16; ++r) p0[r] = __builtin_amdgcn_exp2f(p0[r]);
}
__device__ __forceinline__ void finishSM(f32x16& p0, f32x16& p1, float alpha, float& l_reg, bf16x8& pa0, bf16x8& pa1, bf16x8& pa2, bf16x8& pa3) {
    for (int r = 0; r < 16; ++r) p1[r] = __builtin_amdgcn_exp2f(p1[r]);
    float ps = 0; for (int r = 0; r < 16; ++r) ps += p0[r]; for (int r = 0; r < 16; ++r) ps += p1[r];
    { auto rr = __builtin_amdgcn_permlane32_swap(__float_as_uint(ps), __float_as_uint(ps), false, false);
      ps = __uint_as_float(rr[0]) + __uint_as_float(rr[1]); }
    l_reg = l_reg * alpha + ps;
#define PK4(P, B_, OUT) do { unsigned a0 = cvtpk(P[B_+0], P[B_+1]), a1 = cvtpk(P[B_+2], P[B_+3]);                          \
        unsigned b0 = cvtpk(P[B_+4], P[B_+5]), b1 = cvtpk(P[B_+6], P[B_+7]);                                             \
        auto r0 = __builtin_amdgcn_permlane32_swap(a0, b0, false, false); auto r1 = __builtin_amdgcn_permlane32_swap(a1, b1, false, false); \
        u32x4 w = {r0[0], r1[0], r0[1], r1[1]}; OUT = *reinterpret_cast<bf16x8*>(&w); } while (0)
    PK4(p0, 0, pa0); PK4(p0, 8, pa1); PK4(p1, 0, pa2); PK4(p1, 8, pa3);
#undef PK4
}
template <int KB>
__device__ __forceinline__ void qkt(f32x16& p0, f32x16& p1, const char* K_lds, int r32, int hi, const bf16x8* qr, const LAS float* nbt) {
#pragma unroll
    for (int g = 0; g < 4; ++g) { const f32x4 b0 = *(const LAS f32x4*)(nbt + 8 * g), b1 = *(const LAS f32x4*)(nbt + 32 + 8 * g);
#pragma unroll
        for (int i = 0; i < 4; ++i) { p0[4 * g + i] = b0[i]; p1[4 * g + i] = b1[i]; } }
    const char* kb[4];
#pragma unroll
    for (int dd = 0; dd < 4; ++dd) kb[dd] = K_lds + KB * SHM_K + KSWZ(r32, (dd * 16 + hi * 8) * 2);
#pragma unroll
    for (int d0 = 0; d0 < 8; ++d0) { const char* a = kb[d0 & 3] + (d0 >> 2) * 128;
        bf16x8 b0 = *reinterpret_cast<const bf16x8*>(a);
        bf16x8 b1 = *reinterpret_cast<const bf16x8*>(a + 32 * 256);
        p0 = __builtin_amdgcn_mfma_f32_32x32x16_bf16(b0, qr[d0], p0, 0, 0, 0);
        p1 = __builtin_amdgcn_mfma_f32_32x32x16_bf16(b1, qr[d0], p1, 0, 0, 0); }
}
template <int VB>
__device__ __forceinline__ void pv_tile(f32x16* o, int vb0, bf16x8 pa0, bf16x8 pa1, bf16x8 pa2, bf16x8 pa3) {
#define TRRD(dst, off) asm volatile("ds_read_b64_tr_b16 %0, %1 offset:%2" : "=&v"(dst) : "v"(vb0), "i"(off) : "memory")
#define PV_D0(d0) do { s16x4 l0, l1, l2, l3, h0, h1, h2, h3; constexpr int b_ = VB * SHM_V + v_rd_off(d0, 0, 0); \
        TRRD(l0, b_); TRRD(h0, b_ + 2048); TRRD(l1, b_ + 4096); TRRD(h1, b_ + 6144); TRRD(l2, b_ + 8192); TRRD(h2, b_ + 10240); TRRD(l3, b_ + 12288); TRRD(h3, b_ + 14336); \
        asm volatile("s_waitcnt lgkmcnt(0)" ::: "memory"); SBAR();   \
        o[d0] = __builtin_amdgcn_mfma_f32_32x32x16_bf16(pa0, (bf16x8){l0[0], l0[1], l0[2], l0[3], h0[0], h0[1], h0[2], h0[3]}, o[d0], 0, 0, 0);   \
        o[d0] = __builtin_amdgcn_mfma_f32_32x32x16_bf16(pa1, (bf16x8){l1[0], l1[1], l1[2], l1[3], h1[0], h1[1], h1[2], h1[3]}, o[d0], 0, 0, 0);   \
        o[d0] = __builtin_amdgcn_mfma_f32_32x32x16_bf16(pa2, (bf16x8){l2[0], l2[1], l2[2], l2[3], h2[0], h2[1], h2[2], h2[3]}, o[d0], 0, 0, 0);   \
        o[d0] = __builtin_amdgcn_mfma_f32_32x32x16_bf16(pa3, (bf16x8){l3[0], l3[1], l3[2], l3[3], h3[0], h3[1], h3[2], h3[3]}, o[d0], 0, 0, 0); } while (0)
    PV_D0(0); PV_D0(1); PV_D0(2); PV_D0(3);
#undef PV_D0
#undef TRRD
}
struct BlockRef { const bf16* Q; const bf16* K; const bf16* V; bf16* O; int P0; unsigned char* O8; };
struct Seam { bf16x8 qr[8]; bf16x8 st_v0, st_v1, st_k0, st_k1; };
#define ROW(p, k0, rr) ((p) + (size_t)((k0) + (rr)) * LD + sc)
#define VMW() asm volatile("s_waitcnt vmcnt(0)" ::: "memory")
#define VMWN(n) asm volatile("s_waitcnt vmcnt(%0)" :: "i"(n) : "memory")
#define SLOAD_H(Kp, Vp, k0) do { S.st_v0 = load8(ROW(Vp, k0, sr)); S.st_v1 = load8(ROW(Vp, k0, 32 + sr)); S.st_k0 = load8(ROW(Kp, k0, sr)); S.st_k1 = load8(ROW(Kp, k0, 32 + sr)); } while (0)
#define SWRITE_HK(bf) do { *(bf16x8*)(K_lds + (bf) * SHM_K + kws) = S.st_k0; *(bf16x8*)(K_lds + (bf) * SHM_K + kws + 32 * 256) = S.st_k1; } while (0)
#define SWRITE_HV(bf) do { *(bf16x8*)(V_lds + (bf) * SHM_V + vst0) = S.st_v0; *(bf16x8*)(V_lds + (bf) * SHM_V + vst1) = S.st_v1; } while (0)
#define SWRITE_H(bf) do { SWRITE_HV(bf); SWRITE_HK(bf); } while (0)
__device__ __forceinline__ void prime(const BlockRef& cur, char* lds, Seam& S, int tid) {
    const int wid = __builtin_amdgcn_readfirstlane(tid >> 6), lane = tid & 63, r32 = lane & 31, hi = lane >> 5;
    const int sr = tid >> 4, sc = (tid & 15) * 8, kws = KSWZ(sr, sc * 2); char* K_lds = lds + 2 * SHM_V;
    for (int d0 = 0; d0 < 8; ++d0) S.qr[d0] = load8(cur.Q + (size_t)(wid * QBLK + r32) * LD + d0 * 16 + hi * 8);
    SLOAD_H(cur.K, cur.V, 0); VMW(); SWRITE_HK(0);
    __syncthreads();
}
__device__ __forceinline__ void block(const BlockRef& cur, const BlockRef& nxt, char* lds, Seam& S, int tid) {
    const int wid = __builtin_amdgcn_readfirstlane(tid >> 6), lane = tid & 63, r32 = lane & 31, hi = lane >> 5;
    const int NT = (cur.P0 + QB - 1) / KVBLK + 1;
    const int qlo = cur.P0 + wid * QBLK, qm = qlo + r32 - 4 * hi;
    char* V_lds = lds; char* K_lds = lds + 2 * SHM_V;
    float* ws = (float*)(lds + OFF_WS) + wid * 64; float* li_l = ws, * al_l = ws + 32;
    const LAS float* nbl = (const LAS float*)((LAS unsigned char*)lds_raw + OFF_FN) + 4 * hi;
    float m_reg = -1e30f, l_reg = 0; f32x16 o[4] = {};
    const int sr = tid >> 4, sc = (tid & 15) * 8, vst0 = v_st(sr, sc), vst1 = v_st(32 + sr, sc), kws = KSWZ(sr, sc * 2);
    const int vb0 = (int)(uintptr_t)V_lds + v_rd_base(lane);
    const bf16* Kh = cur.K; const bf16* Vh = cur.V;
#define RESC(a) do { if (__any((a) < 1.f)) { if (hi == 0) al_l[r32] = (a); asm volatile("s_waitcnt lgkmcnt(0)" ::: "memory");              \
                     for (int d_ = 0; d_ < 4; ++d_) for (int r = 0; r < 16; ++r) o[d_][r] *= al_l[crow(r, hi)]; } } while (0)
#define KBASE(t) ((t) * KVBLK)
#define MASKT(P0_, P1_, t) do { const int kb_ = KBASE(t); if (kb_ + KVBLK - 1 > qlo) mask_tile(P0_, P1_, qm - kb_); } while (0)
    constexpr int NQL = 8;
#define SEAM_K0() do { VMWN(NQL); SWRITE_HK(0); SBAR(); } while (0)
    f32x16 pA0, pA1, pB0, pB1; float mnA, mnB, alA, alB; bf16x8 pa0, pa1, pa2, pa3;
    SWRITE_HV(0); SBAR();
    if (NT > 1) { SLOAD_H(Kh, Vh, KBASE(1)); }
    SBAR(); qkt<0>(pA0, pA1, K_lds, r32, hi, S.qr, nbl);
    MASKT(pA0, pA1, 0); partialSM(pA0, pA1, m_reg, mnA, alA);
    if (NT > 1) { VMW(); SWRITE_H(1); }
    __syncthreads();
#define HALF_STEP(PX0, PX1, mnX, alX, PY0, PY1, alY, t, KB, VB, SB) do {                                                      \
        SBAR(); qkt<KB>(PX0, PX1, K_lds, r32, hi, S.qr, nbl + KBASE(t));                                             \
        finishSM(PY0, PY1, alY, l_reg, pa0, pa1, pa2, pa3); SBAR();                                                           \
        if ((t) + 1 < NT) { SLOAD_H(Kh, Vh, KBASE((t) + 1)); SBAR(); }                                               \
        pv_tile<VB>(o, vb0, pa0, pa1, pa2, pa3); MASKT(PX0, PX1, (t)); partialSM(PX0, PX1, m_reg, mnX, alX);                                        \
        __syncthreads();                                                                                                      \
        if ((t) + 1 < NT) { VMW(); SWRITE_H(SB); }                                                                          \
        RESC(alX); __syncthreads(); } while (0)
    for (int t = 1; t + 1 < NT; t += 2) {
        HALF_STEP(pB0, pB1, mnB, alB, pA0, pA1, alA, t, 1, 0, 0);
        HALF_STEP(pA0, pA1, mnA, alA, pB0, pB1, alB, t + 1, 0, 1, 1);
    }
    const bool even = (NT & 1) == 0;
    if (even) { SBAR(); qkt<1>(pB0, pB1, K_lds, r32, hi, S.qr, nbl + KBASE(NT - 1)); SBAR(); }
    SLOAD_H(nxt.K, nxt.V, 0); SBAR();
#pragma unroll
    for (int d0 = 0; d0 < 8; ++d0) S.qr[d0] = load8(nxt.Q + (size_t)(wid * QBLK + r32) * LD + d0 * 16 + hi * 8);
    SBAR();
    finishSM(pA0, pA1, alA, l_reg, pa0, pa1, pa2, pa3); SBAR();
    pv_tile<0>(o, vb0, pa0, pa1, pa2, pa3);
    if (even) { MASKT(pB0, pB1, NT - 1); partialSM(pB0, pB1, m_reg, mnB, alB); __syncthreads(); RESC(alB);
        finishSM(pB0, pB1, alB, l_reg, pa0, pa1, pa2, pa3); SBAR(); pv_tile<1>(o, vb0, pa0, pa1, pa2, pa3); }
    SBAR(); SEAM_K0();
    if (hi == 0) li_l[r32] = l_reg; asm volatile("s_waitcnt lgkmcnt(0)" ::: "memory");
    float rli[16];
#pragma unroll
    for (int r = 0; r < 16; ++r) rli[r] = __builtin_amdgcn_rcpf(li_l[crow(r, hi)]);
    bf16* Ow = cur.O + (size_t)(wid * QBLK) * LD;
#pragma unroll
    for (int r = 0; r < 16; ++r) { const int orow = crow(r, hi);
#pragma unroll
        for (int d0 = 0; d0 < 4; ++d0) { const float v = o[d0][r] * rli[r]; const float vn = __shfl_xor(v, 1);
            if ((r32 & 1) == 0) *(unsigned*)(Ow + (size_t)orow * LD + d0 * 32 + r32) = cvtpk(v, vn); } }
    __syncthreads();
#undef RESC
#undef KBASE
#undef MASKT
#undef SEAM_K0
#undef HALF_STEP
}
__device__ __forceinline__ void block_lean(const BlockRef& cur, char* lds, int tid) {
    const int wid = __builtin_amdgcn_readfirstlane(tid >> 6), lane = tid & 63, r32 = lane & 31, hi = lane >> 5;
    const int NT = (cur.P0 + QB - 1) / KVBLK + 1;
    const int qlo = cur.P0 + wid * QBLK, qm = qlo + r32 - 4 * hi;
    char* V_lds = lds; char* K_lds = lds + 2 * SHM_V;
    float* ws = (float*)(lds + OFF_WS) + wid * 64; float* li_l = ws, * al_l = ws + 32;
    const LAS float* nbl = (const LAS float*)((LAS unsigned char*)lds_raw + OFF_FN) + 4 * hi;
    const int sr = tid >> 4, sc = (tid & 15) * 8, vst0 = v_st(sr, sc), vst1 = v_st(32 + sr, sc), kws = KSWZ(sr, sc * 2);
    const int vb0 = (int)(uintptr_t)V_lds + v_rd_base(lane);
    const bf16* Kh = cur.K; const bf16* Vh = cur.V;
    Seam S;
#pragma unroll
    for (int d0 = 0; d0 < 8; ++d0) S.qr[d0] = load8(cur.Q + (size_t)(wid * QBLK + r32) * LD + d0 * 16 + hi * 8);
    SLOAD_H(Kh, Vh, 0); VMW(); SWRITE_H(0);
    if (NT > 1) { SLOAD_H(Kh, Vh, KVBLK); VMW(); SWRITE_H(1); }
    if (NT > 2) SLOAD_H(Kh, Vh, 2 * KVBLK);
    __syncthreads();
    float m_reg = -1e30f, l_reg = 0; f32x16 o[4] = {};
    f32x16 p0, p1; float mn, al; bf16x8 pa0, pa1, pa2, pa3;
#define RESC(a) do { if (__any((a) < 1.f)) { if (hi == 0) al_l[r32] = (a); asm volatile("s_waitcnt lgkmcnt(0)" ::: "memory");              \
                     for (int d_ = 0; d_ < 4; ++d_) for (int r = 0; r < 16; ++r) o[d_][r] *= al_l[crow(r, hi)]; } } while (0)
#define LSTEP(t, B) do { const int kb_ = (t) * KVBLK;                                                                      \
        SBAR(); qkt<B>(p0, p1, K_lds, r32, hi, S.qr, nbl + kb_);                                                            \
        if (kb_ + KVBLK - 1 > qlo) mask_tile(p0, p1, qm - kb_);                                                             \
        partialSM(p0, p1, m_reg, mn, al); RESC(al);                                                                         \
        finishSM(p0, p1, al, l_reg, pa0, pa1, pa2, pa3); SBAR();                                                            \
        pv_tile<B>(o, vb0, pa0, pa1, pa2, pa3);                                                                             \
        __syncthreads();                                                                                                    \
        if ((t) + 2 < NT) { VMW(); SWRITE_H(B); if ((t) + 3 < NT) SLOAD_H(Kh, Vh, ((t) + 3) * KVBLK); } } while (0)
    for (int t = 0; t < NT; t += 2) { LSTEP(t, 0); if (t + 1 < NT) LSTEP(t + 1, 1); }
    if (hi == 0) li_l[r32] = l_reg; asm volatile("s_waitcnt lgkmcnt(0)" ::: "memory");
    float rli[16];
#pragma unroll
    for (int r = 0; r < 16; ++r) rli[r] = __builtin_amdgcn_rcpf(li_l[crow(r, hi)]);
    bf16* Ow = cur.O + (size_t)(wid * QBLK) * LD;
#pragma unroll
    for (int r = 0; r < 16; ++r) { const int orow = crow(r, hi);
#pragma unroll
        for (int d0 = 0; d0 < 4; ++d0) { const float v = o[d0][r] * rli[r]; const float vn = __shfl_xor(v, 1);
            if (cur.O8) { const float v2 = __shfl_xor(v, 2), v3 = __shfl_xor(vn, 2);
                if ((r32 & 3) == 0) *(unsigned*)(cur.O8 + (size_t)(wid * QBLK + orow) * LD + d0 * 32 + r32) = pk4_fp8(v, vn, v2, v3); }
            else if ((r32 & 1) == 0) *(unsigned*)(Ow + (size_t)orow * LD + d0 * 32 + r32) = cvtpk(v, vn); } }
    __syncthreads();
#undef RESC
#undef LSTEP
}
#undef ROW
#undef VMW
#undef VMWN
#undef SLOAD_H
#undef SWRITE_HK
#undef SWRITE_HV
#undef SWRITE_H
#undef KSWZ
#undef SBAR
}

constexpr int X_FSTAGE = 90112;
__device__ __forceinline__ void attn_fast(Frame& F, bool pre = false) {
    const bf16* Q = (const bf16*)(F.ws + WS_Q); const bf16* Kp = (const bf16*)(F.ws + WS_K); const bf16* V = (const bf16*)(F.ws + WS_V); bf16* AO = (bf16*)(F.ws + WS_AO);
    char* lds = (char*)lds_raw;
    {   const int item = F.vcu;
        const int bh = item >> 2, b = bh >> 3, h = bh & 7, x = item & 3;
        __syncthreads();
        {
            LAS float* Fl = (LAS float*)(F.lds + att::OFF_FN); LAS float* tmp = (LAS float*)(F.lds + att::OFF_TMP);
            forget_cumsum(F, b, h, Fl, tmp, -1.0f / att::SCALE, pre ? (const LAS float*)(F.lds + X_FSTAGE) : (const LAS float*)nullptr);
        }
        const size_t seq0 = (size_t)b * SEQ * 1024 + h * 128;
        att::BlockRef r0, r1;
        unsigned char* AO8 = G2_FP8 ? (unsigned char*)(F.ws + WS_AO) : (unsigned char*)nullptr;
        r0.Q = Q + seq0 + (size_t)(x * 256) * 1024; r0.O = AO + seq0 + (size_t)(x * 256) * 1024; r0.K = Kp + seq0; r0.V = V + seq0; r0.P0 = x * 256; r0.O8 = AO8 ? AO8 + seq0 + (size_t)(x * 256) * 1024 : AO8;
        r1.Q = Q + seq0 + (size_t)((7 - x) * 256) * 1024; r1.O = AO + seq0 + (size_t)((7 - x) * 256) * 1024; r1.K = Kp + seq0; r1.V = V + seq0; r1.P0 = (7 - x) * 256; r1.O8 = AO8 ? AO8 + seq0 + (size_t)((7 - x) * 256) * 1024 : AO8;
#if ATTN_FAST == 2
        att::Seam S;
        att::prime(r0, lds, S, F.tid);
        att::block(r0, r1, lds, S, F.tid);
        att::block(r1, r1, lds, S, F.tid);
#else
        att::block_lean(r0, lds, F.tid);
        att::block_lean(r1, lds, F.tid);
#endif
    }
    __syncthreads();
}
#endif

#if !ATTN_FAST
__device__ __forceinline__ void attn_simple(Frame& F) {
    const bf16* Q = (const bf16*)(F.ws + WS_Q); const bf16* Kp = (const bf16*)(F.ws + WS_K); const bf16* V = (const bf16*)(F.ws + WS_V); bf16* AO = (bf16*)(F.ws + WS_AO);
    LAS float* Fl = (LAS float*)F.lds;
    LAS float* tmp = (LAS float*)(F.lds + 8192);
    LAS float* sc = (LAS float*)(F.lds + 16384 + F.wave * 8192);
    LAS float* qf = (LAS float*)(F.lds + 16384 + 65536 + F.wave * 512);
    const float L2E = 1.4426950408889634f, scale = 0.08838834764831845f;
    {   const int item = F.vcu;
        const int bh = item >> 2, b = bh >> 3, h = bh & 7, q0 = (item & 3) * 512;
        __syncthreads();
        forget_cumsum(F, b, h, Fl, tmp, 1.4426950408889634f);
        for (int t = q0 + F.wave; t < q0 + 512; t += NWAVES) {
            const size_t row = (size_t)b * SEQ + t;
            { const unsigned qw = *(const unsigned*)(Q + row * 1024 + h * 128 + 2 * F.lane); qf[2 * F.lane] = bf_lo(qw); qf[2 * F.lane + 1] = bf_hi(qw); }
            LDS_WAIT();
            float mx = -3.0e38f;
            for (int j = F.lane; j <= t; j += 64) {
                const bf16* kr = Kp + ((size_t)b * SEQ + j) * 1024 + h * 128; float d = 0.f;
#pragma unroll 2
                for (int c = 0; c < 16; ++c) { const u32x4 kw = *(const u32x4*)(kr + 8 * c); f32x4 k0, k1; pg8::unpack8(kw, k0, k1); const f32x4 q0v = *(const LAS f32x4*)(qf + 8 * c), q1v = *(const LAS f32x4*)(qf + 8 * c + 4);
                    d += (k0[0] * q0v[0] + k0[1] * q0v[1]) + (k0[2] * q0v[2] + k0[3] * q0v[3]) + (k1[0] * q1v[0] + k1[1] * q1v[1]) + (k1[2] * q1v[2] + k1[3] * q1v[3]); }
                const float s = d * scale * L2E + (Fl[t] - Fl[j]);
                sc[j] = s; mx = fmaxf(mx, s);
            }
            mx = wave_max(mx);
            float sum = 0.f;
            for (int j = F.lane; j <= t; j += 64) { const float p = __builtin_amdgcn_exp2f(sc[j] - mx); sc[j] = p; sum += p; }
            sum = wave_sum(sum);
            LDS_WAIT();
            float o0 = 0.f, o1 = 0.f;
            const bf16* vb = V + (size_t)b * SEQ * 1024 + h * 128 + 2 * F.lane;
            for (int j = 0; j <= t; ++j) { const unsigned vw = *(const unsigned*)(vb + (size_t)j * 1024); const float p = sc[j]; o0 += p * bf_lo(vw); o1 += p * bf_hi(vw); }
            const float inv = 1.0f / sum;
            *(unsigned*)(AO + row * 1024 + h * 128 + 2 * F.lane) = cvt_pk_bf16(o0 * inv, o1 * inv);
        }
    }
    __syncthreads();
}
#endif

__device__ __forceinline__ unsigned char* layer_w(const Frame& F, int l) { return F.ws + WS_W + (size_t)l * W_LAYER; }
__device__ __forceinline__ void ph_p0() { Frame F; frame_refresh(F); p0_prologue(F); }
__device__ __forceinline__ void ph_r1(int l, bool pre = false) { Frame F; frame_refresh(F); if (l == 0) rows_phase<0, false>(F, l, pre); else rows_phase<0, true>(F, l, pre); }
__device__ __forceinline__ void ph_r2(int l, bool pre = false) { Frame F; frame_refresh(F); rows_phase<1, false>(F, l, pre); }
__device__ __forceinline__ void ph_r2_dry(int l) { Frame F; frame_refresh(F); rows_phase<1, false, true>(F, l); }
__device__ __forceinline__ void ph_final() { Frame F; frame_refresh(F); rows_phase<2, true>(F, 0);
}
__device__ __forceinline__ void ph_g1(int l) {
    Frame F; frame_refresh(F);
    const LAS int* tt = (const LAS int*)(F.lds + X_TOK);
#if G1_FP8 == 2
    pg8::Gemm g{(const bf16*)(F.ws + WS_H8), (const bf16*)(layer_w(F, l) + WO_PG)};
    typedef pg8::StaticOrder<T, 8192, DM / 2, DM / 2> Order; Order S; S.init(F.G, (int)blockIdx.x);
    pg8::EpiProj E{(bf16*)(F.ws + WS_U), (bf16*)(F.ws + WS_G), ARG_IN(I_BGATE) + (size_t)l * 4096, W8_INV, 0};
    pg8::gemm_phase<pg8::EpiProj, Order, false, DM / 2, DM / 2, DM / 2, true>(F.lds, g, S, E, tt);
#elif G1_FP8 == 1
    {   pg8::Gemm g{(const bf16*)(F.ws + WS_H), (const bf16*)(layer_w(F, l) + WO_PG)};
        typedef pg8::StaticOrder<T, 4096, DM, DM> Order; Order S; S.init(F.G, (int)blockIdx.x);
        pg8::EpiProj E{(bf16*)(F.ws + WS_U), (bf16*)(F.ws + WS_G), ARG_IN(I_BGATE) + (size_t)l * 4096, 1.0f, 0};
        pg8::gemm_phase<pg8::EpiProj, Order, false, DM, DM, DM>(F.lds, g, S, E, tt); }
    {   pg8::Gemm g{(const bf16*)(F.ws + WS_H8), (const bf16*)(layer_w(F, l) + WO_PG + 16 * MiB)};
        typedef pg8::StaticOrder<T, 4096, DM / 2, DM / 2> Order; Order S; S.init(F.G, (int)blockIdx.x);
        pg8::EpiProj E{(bf16*)(F.ws + WS_U), (bf16*)(F.ws + WS_G), ARG_IN(I_BGATE) + (size_t)l * 4096, W8_INV, 16};
        pg8::gemm_phase<pg8::EpiProj, Order, false, DM / 2, DM / 2, DM / 2, true>(F.lds, g, S, E, tt); }
#else
    pg8::Gemm g{(const bf16*)(F.ws + WS_H), (const bf16*)(layer_w(F, l) + WO_PG)};
    typedef pg8::StaticOrder<T, 8192, DM, DM> Order; Order S; S.init(F.G, (int)blockIdx.x);
    pg8::EpiProj E{(bf16*)(F.ws + WS_U), (bf16*)(F.ws + WS_G), ARG_IN(I_BGATE) + (size_t)l * 4096, 1.0f, 0};
    pg8::gemm_phase<pg8::EpiProj, Order, false, DM, DM, DM>(F.lds, g, S, E, tt);
#endif
}
__device__ __forceinline__ void ph_at(int l, bool pre = false) {
    Frame F; frame_refresh(F);
#if !ATTN_FAST
    attn_simple(F);
#else
    attn_fast(F, pre);
#endif
    {
        frame_refresh(F);
        const int pu = F.vcu, pm = pu >> 2, g = pu & 3;
        pool_tile(F, pm, g);
        VM_WAIT(); __syncthreads();
    }
    {
        frame_refresh(F);
        const int pu = F.vcu, pm = pu >> 2, g = pu & 3;
        pg8::Gemm gg{(const bf16*)(F.ws + WS_PL), (const bf16*)(layer_w(F, l) + WO_POOL)};
        pg8::OneUnit S; S.u0.pm = pm; S.u0.pn = 0; S.u0.ti = 0; S.u0.aoff = (unsigned)pm * (256u * 1024u * 2u) + (unsigned)g * 512u; S.u0.boff = (unsigned)g * (256u * 256u * 2u); S.u0.aoff2 = 0u; S.u0.boff2 = 0u;
        pg8::EpiPool E{(bf16*)(F.ws + WS_PO), ARG_IN(I_PSCALE) + (size_t)l * 1024, g, G2_FP8 ? (unsigned char*)(F.ws + WS_PO) : (unsigned char*)nullptr};
        pg8::gemm_phase<pg8::EpiPool, pg8::OneUnit, false, 1024, 256, 256>(F.lds, gg, S, E, (const LAS int*)(F.lds + X_TOK));
        __syncthreads();
    }
}
__device__ __forceinline__ void ph_g2(int l) {
    Frame F; frame_refresh(F);
    unsigned char* mg8 = G3_FP8 ? (unsigned char*)(F.ws + WS_MG8) : (unsigned char*)nullptr;
    pg8::Gemm g{(const bf16*)(F.ws + WS_PO), (const bf16*)(layer_w(F, l) + WO_BR)};
#if G2_FP8
    typedef pg8::SplitOrder<pg8::StaticOrder<T, DM, 512, 512>> Order;
    Order S; S.S0.init(F.G, (int)blockIdx.x); S.a2 = (unsigned)(WS_AO - WS_PO); S.b2 = 2048u * 1024u;
    pg8::EpiMerge E{(bf16*)(F.ws + WS_MG), (const unsigned char*)(F.ws + WS_G), mg8, W8_INV};
    pg8::gemm_phase<pg8::EpiMerge, Order, false, 512, 512, 1024, true, 8>(F.lds, g, S, E, (const LAS int*)(F.lds + X_TOK));
#else
    typedef pg8::SplitOrder<pg8::StaticOrder<T, DM, 1024, 1024>> Order;
    Order S; S.S0.init(F.G, (int)blockIdx.x); S.a2 = (unsigned)(WS_AO - WS_PO); S.b2 = 2048u * 1024u * 2u;
    pg8::EpiMerge E{(bf16*)(F.ws + WS_MG), (const unsigned char*)(F.ws + WS_G), mg8, 1.0f};
    pg8::gemm_phase<pg8::EpiMerge, Order, false, 1024, 1024, 2048, false, 16>(F.lds, g, S, E, (const LAS int*)(F.lds + X_TOK));
#endif
}
__device__ __forceinline__ void ph_g3(int l) {
    Frame F; frame_refresh(F);
    const float* gate = (const float*)(F.ws + WS_MOD) + (size_t)l * 8 * MODW + 2 * DM;
#if G3_FP8
    pg8::Gemm g{(const bf16*)(F.ws + WS_MG8), (const bf16*)(layer_w(F, l) + WO_OUT)};
    typedef pg8::StaticOrder<T, DM, DM / 2, DM / 2> Order; Order S; S.init(F.G, (int)blockIdx.x);
    pg8::EpiOut E{(bf16*)(F.ws + WS_DL), gate, W8_INV};
    pg8::gemm_phase<pg8::EpiOut, Order, false, DM / 2, DM / 2, DM / 2, true>(F.lds, g, S, E, (const LAS int*)(F.lds + X_TOK));
#else
    pg8::Gemm g{(const bf16*)(F.ws + WS_MG), (const bf16*)(layer_w(F, l) + WO_OUT)};
    typedef pg8::StaticOrder<T, DM, DM, DM> Order; Order S; S.init(F.G, (int)blockIdx.x);
    pg8::EpiOut E{(bf16*)(F.ws + WS_DL), gate, 1.0f};
    pg8::gemm_phase<pg8::EpiOut, Order, false, DM, DM, DM>(F.lds, g, S, E, (const LAS int*)(F.lds + X_TOK));
#endif
}
__device__ __forceinline__ void ph_m1(int l) {
    Frame F; frame_refresh(F);
    load_expert_tables(F, l);
    const LAS int* misc = (const LAS int*)(F.lds + X_MISC);
    pg8::MoeOrder S; S.G = F.G; S.c = (int)blockIdx.x; S.NT = misc[24]; S.tpre = misc + 8; S.a_tile_bytes = 0u; S.b_exp_bytes = 2048u * 2048u * (MOE_FP8 ? 1u : 2u); S.b_tile_bytes = 256u * 2048u * (MOE_FP8 ? 1u : 2u);
    {
        LAS int* tt = (LAS int*)(F.lds + X_TOK); const int* list = (const int*)(F.ws + WS_LIST);
        pg8::Unit u;
        int tv[8];
#pragma unroll
        for (int i = 0; i < 8; ++i) { tv[i] = -1;
            if (S.next(i, u)) {
                int e = 0;
                for (int j = 1; j < 16; ++j) e += (u.pm >= misc[8 + j]) ? 1 : 0;
                const int mt = u.pm - misc[8 + e], n = misc[32 + e];
                if (F.tid < 256) { int idx = mt * 256 + F.tid; idx = idx < n ? idx : n - 1; tv[i] = list[e * LIST_CAP + idx]; } } }
        __builtin_amdgcn_sched_barrier(0);
#pragma unroll
        for (int i = 0; i < 8; ++i) if (tv[i] >= 0) tt[i * 256 + F.tid] = tv[i];
        VM_WAIT(); __syncthreads();
    }
    pg8::Gemm g{(const bf16*)(F.ws + (MOE_FP8 ? WS_H8 : WS_H)), (const bf16*)(layer_w(F, l) + WO_GU)};
#if MOE_FP8
    pg8::EpiSwiglu8 E{(unsigned char*)(F.ws + WS_ACT)};
    pg8::gemm_phase<pg8::EpiSwiglu8, pg8::MoeOrder, true, DM / 2, DM / 2, DM / 2, true>(F.lds, g, S, E, (const LAS int*)(F.lds + X_TOK));
    frame_refresh(F);
    if (l == 0) cvt_queue_drain(F, 0, Q_FIRST, Q_1); else cvt_queue_drain(F, 2, Q_FIRST + Q_A, Q_B);
#else
    pg8::EpiSwiglu E{(bf16*)(F.ws + WS_ACT)};
    pg8::gemm_phase<pg8::EpiSwiglu, pg8::MoeOrder, true, DM, DM, DM>(F.lds, g, S, E, (const LAS int*)(F.lds + X_TOK));
#endif
}
__device__ __forceinline__ void ph_m2(int l) {
    Frame F; frame_refresh(F);
    if (!MK_ONE_LAUNCH) load_expert_tables(F, l);
    const LAS int* misc = (const LAS int*)(F.lds + X_MISC);
    pg8::MoeOrder S; S.G = F.G; S.c = (int)blockIdx.x; S.NT = misc[24]; S.tpre = misc + 8; S.a_tile_bytes = 256u * 1024u * (MOE_FP8 ? 1u : 2u); S.b_exp_bytes = 2048u * 1024u * (MOE_FP8 ? 1u : 2u); S.b_tile_bytes = 256u * 1024u * (MOE_FP8 ? 1u : 2u);
    pg8::Gemm g{(const bf16*)(F.ws + WS_ACT), (const bf16*)(layer_w(F, l) + WO_D)};
    pg8::EpiDown E{(bf16*)(F.ws + WS_YB), MOE_FP8 ? W8_INV : 1.0f};
#if MOE_FP8
    pg8::gemm_phase<pg8::EpiDown, pg8::MoeOrder, false, DE / 2, DE / 2, DE / 2, true>(F.lds, g, S, E, (const LAS int*)(F.lds + X_TOK));
    if (l == 0) { frame_refresh(F); cvt_queue_drain(F, 1, Q_FIRST + Q_1, Q_A - Q_1); }
#else
    pg8::gemm_phase<pg8::EpiDown, pg8::MoeOrder, false, DE, DE, DE>(F.lds, g, S, E, (const LAS int*)(F.lds + X_TOK));
#endif
}
__device__ __forceinline__ void grid_seam() {
    XcdBarrier bar; bar.bar = (unsigned*)((unsigned char*)arg_in(21) + WS_CTL) + CW_BAR; bar.x = xb_xcc_id(); bar.st = (volatile LAS unsigned*)((LAS unsigned char*)lds_raw + X_MISC);
    xcd_barrier(bar);
}

template <int MODE>
__device__ __forceinline__ void grid_seam_fill(int l) {
    XcdBarrier b; b.bar = (unsigned*)((unsigned char*)arg_in(21) + WS_CTL) + CW_BAR; b.x = xb_xcc_id(); b.st = (volatile LAS unsigned*)((LAS unsigned char*)lds_raw + X_MISC);
    asm volatile("s_waitcnt vmcnt(0)" ::: "memory");
    __syncthreads();
    if (threadIdx.x == 0) {
        unsigned* bar = b.bar;
        __builtin_amdgcn_s_waitcnt(0);
        unsigned nloc = b.st[0], nx = b.st[1];
        if (nloc == 0u) { xcd_barrier_complete(bar, b.x, nloc, nx); b.st[0] = nloc; b.st[1] = nx; }
        const unsigned old = xb_add(&bar[XB_XSUB(b.x)], 1u);
        const unsigned gen = old / nloc;
        if (old + 1u == (gen + 1u) * nloc) {
            __builtin_amdgcn_fence(__ATOMIC_RELEASE, "agent");
            asm volatile("s_waitcnt vmcnt(0)" ::: "memory");
            const unsigned og = xb_add(&bar[XB_TOP], 1u);
            const unsigned tg = og / nx;
            if (og + 1u == (tg + 1u) * nx) xb_add(&bar[XB_TOPGEN], 1u);
            else XB_SPIN(xb_ld(&bar[XB_TOPGEN]) == tg, bar);
            __builtin_amdgcn_fence(__ATOMIC_ACQUIRE, "agent");
            xb_add(&bar[XB_XGEN(b.x)], 1u);
            asm volatile("s_waitcnt vmcnt(0)" ::: "memory");
        } else {
            XB_SPIN(xb_ld(&bar[XB_XGEN(b.x)]) == gen, bar);
            __builtin_amdgcn_fence(__ATOMIC_ACQUIRE, "agent");
            asm volatile("s_waitcnt vmcnt(0)" ::: "memory");
        }
    } else if (threadIdx.x >= 64) {
        const int t = opaque_tid() - 64;
        LAS f32x4* tab = (LAS f32x4*)lds_raw;
        if (MODE == 1) {
            const f32x4* src = (const f32x4*)ARG_IN(I_WROUTER);
            f32x4 tv[19];
#pragma unroll
            for (int k = 0; k < 19; ++k) { const int i = t + k * 448; tv[k] = src[i < DM * 4 ? i : 0]; }
            __builtin_amdgcn_sched_barrier(0);
#pragma unroll
            for (int k = 0; k < 19; ++k) { const int i = t + k * 448; if (i < DM * 4) { const int c = i >> 2, g = i & 3; tab[((g * 4 + (c & 3)) * 8 + (c >> 8)) * 64 + ((c >> 2) & 63)] = tv[k]; } }
        } else if (MODE == 2) {
            const int bx = blockIdx.x, G = gridDim.x, vcu = (G % 8 == 0) ? (bx % 8) * (G / 8) + bx / 8 : bx, bh = vcu >> 2;
            const float* LS = (const float*)((const unsigned char*)arg_in(21) + WS_LS) + (size_t)(bh >> 3) * SEQ * 8 + (bh & 7);
            LAS float* st = (LAS float*)((LAS unsigned char*)lds_raw + 90112);
            float tv[5];
#pragma unroll
            for (int k = 0; k < 5; ++k) { const int i = t + k * 448; tv[k] = LS[(size_t)(i < SEQ ? i : 0) * 8]; }
            __builtin_amdgcn_sched_barrier(0);
#pragma unroll
            for (int k = 0; k < 5; ++k) { const int i = t + k * 448; if (i < SEQ) st[i] = tv[k]; }
        } else {
            const float* src = ARG_IN(I_WIN) + (size_t)l * DM * INW + 4096;
            f32x4 tv[10];
#pragma unroll
            for (int k = 0; k < 10; ++k) { const int i = t + k * 448, ii = i < DM * 2 ? i : 0, c = ii >> 1, g = ii & 1; tv[k] = *(const f32x4*)(src + (size_t)c * INW + g * 4); }
            __builtin_amdgcn_sched_barrier(0);
#pragma unroll
            for (int k = 0; k < 10; ++k) { const int i = t + k * 448; if (i < DM * 2) { const int c = i >> 1, g = i & 1; tab[((g * 4 + (c & 3)) * 8 + (c >> 8)) * 64 + ((c >> 2) & 63)] = tv[k]; } }
        }
    }
    __syncthreads();
}

constexpr int N_PHASES = 18;
#ifndef PHMASK
#define PHMASK 0xFFFF
#endif
#define EN(j) ((PHMASK >> (j)) & 1)
#ifndef DUPMASK
#define DUPMASK 0
#endif
#define DUP(j) ((DUPMASK >> (j)) & 1)
__global__ void __launch_bounds__(NTHREADS, 2) mk_fwd(Args args) {
    {
        LAS unsigned char* lds = (LAS unsigned char*)lds_raw;
        for (int u = threadIdx.x; u < (LDS_BYTES - EXTRA_OFF) / 4; u += NTHREADS) ((LAS unsigned*)(lds + EXTRA_OFF))[u] = 0u;
        __syncthreads();
        if (args.ph_hi - args.ph_lo > 1) (void)xcd_barrier_post((unsigned*)(args.ws + WS_CTL) + CW_BAR, (volatile LAS unsigned*)(lds + X_MISC));
    }
#define IN(k) (arg_i32(176) <= (k) && (k) < arg_i32(180))
#define SEAM(k) do { if (IN(k) && IN((k) + 1)) grid_seam(); } while (0)
    if (EN(0) && IN(0)) ph_p0();
    if (DUP(0) && IN(0)) ph_p0();
    constexpr bool PRE = MK_ONE_LAUNCH != 0;
#define SEAM_FILL(k, MODE, ll) do { if (IN(k) && IN((k) + 1)) { if (PRE) grid_seam_fill<MODE>(ll); else grid_seam(); } } while (0)
    SEAM_FILL(0, 0, 0);
    for (int l = 0; l < DEPTH; ++l) {
        const int pb = 1 + 8 * l;
        if (EN(1) && IN(pb + 0)) ph_r1(l, PRE);
        if (DUP(1) && l == 0 && IN(pb + 0)) { ph_r1(l); ph_r1(l); }
        SEAM(pb + 0);
        if (EN(2) && IN(pb + 1)) ph_g1(l);
        if (DUP(2) && IN(pb + 1)) ph_g1(l);
        SEAM_FILL(pb + 1, 2, l);
        if (EN(3) && IN(pb + 2)) ph_at(l, PRE);
        if (DUP(3) && IN(pb + 2)) ph_at(l);
        SEAM(pb + 2);
        if (EN(4) && IN(pb + 3)) ph_g2(l);
        if (DUP(4) && IN(pb + 3)) ph_g2(l);
        SEAM(pb + 3);
        if (EN(5) && IN(pb + 4)) ph_g3(l);
        if (DUP(5) && l == 0 && IN(pb + 4)) { ph_g3(l); ph_g3(l); }
        SEAM_FILL(pb + 4, 1, l);
        if (EN(6) && IN(pb + 5)) ph_r2(l, PRE);
        if (DUP(6) && l == 0 && IN(pb + 5)) { ph_r2_dry(l); ph_r2_dry(l); }
        SEAM(pb + 5);
        if (EN(7) && IN(pb + 6)) ph_m1(l);
        if (DUP(7) && IN(pb + 6)) ph_m1(l);
        SEAM(pb + 6);
        if (EN(8) && IN(pb + 7)) ph_m2(l);
        if (DUP(8) && IN(pb + 7)) ph_m2(l);
        if (l + 1 < DEPTH) SEAM_FILL(pb + 7, 0, l + 1); else SEAM(pb + 7);
    }
    if (EN(9) && IN(17)) ph_final();
#undef IN
#undef SEAM
#undef SEAM_FILL
}

extern "C" void kernel_launch(void* const* d_in, const int* in_sizes, int n_in, void* d_out, int out_size, void* d_ws, size_t ws_size, hipStream_t stream) {
    static int grid = 0;
    if (grid == 0) {
        if (n_in != 20 || out_size != T * DM || ws_size < WS_END) { fprintf(stderr, "kernel_launch: unexpected shapes (n_in %d out %d ws %zu)\n", n_in, out_size, ws_size); grid = -1; return; }
        int dev = 0, cus = 0, per_cu = 0;
        if (hipGetDevice(&dev) != hipSuccess || hipDeviceGetAttribute(&cus, hipDeviceAttributeMultiprocessorCount, dev) != hipSuccess) { grid = -1; return; }
        if (hipFuncSetAttribute((const void*)mk_fwd, hipFuncAttributeMaxDynamicSharedMemorySize, LDS_BYTES) != hipSuccess) { fprintf(stderr, "kernel_launch: hipFuncSetAttribute failed\n"); grid = -1; return; }
        if (hipOccupancyMaxActiveBlocksPerMultiprocessor(&per_cu, (const void*)mk_fwd, NTHREADS, LDS_BYTES) != hipSuccess || per_cu < 1) { fprintf(stderr, "kernel_launch: occupancy query says %d\n", per_cu); }
        (void)hipGetLastError();
        grid = cus;
    }
    if (grid < 0) return;
    (void)hipMemsetAsync((char*)d_ws + WS_CTL, 0, CTL_ZERO_BYTES, stream);
    Args a{};
    for (int i = 0; i < 20; ++i) a.in[i] = (const float*)d_in[i];
    a.out = (float*)d_out; a.ws = (unsigned char*)d_ws;
#if MK_ONE_LAUNCH
    a.ph_lo = 0; a.ph_hi = N_PHASES;
    hipLaunchKernelGGL(mk_fwd, dim3(grid), dim3(NTHREADS), LDS_BYTES, stream, a);
#else
    for (int p = 0; p < N_PHASES; ++p) { a.ph_lo = p; a.ph_hi = p + 1; hipLaunchKernelGGL(mk_fwd, dim3(grid), dim3(NTHREADS), LDS_BYTES, stream, a); }
#endif
}
```
